# Optimizing an MI355X kernel written in HIP

```python
import math
import jax
import jax.numpy as jnp
from jax import lax
import numpy as np

D_MODEL = 1024
BATCH = 16
SEQ = 2048
DEPTH = 4
DEC_BATCH = 8
DEC_SEQ = 64
PAST_LEN = 1024

CHUNK = 64
D_INNER = 2 * D_MODEL
D_SSD = D_INNER // 2
D_S5 = D_INNER - D_SSD
SSD_HEADDIM = 64
SSD_HEADS = D_SSD // SSD_HEADDIM
SSD_GROUPS = 4
SSD_STATE = 128
SSD_CONV = 4
SSD_CONV_DIM = D_SSD + 2 * SSD_GROUPS * SSD_STATE
S5_GROUP_CH = 16
S5_GROUPS = D_S5 // S5_GROUP_CH
S5_STATE = 64
IN_COLS = D_SSD + SSD_CONV_DIM + SSD_HEADS + 2 * D_S5
IN_SPLITS = (D_SSD, D_SSD + SSD_CONV_DIM, D_SSD + SSD_CONV_DIM + SSD_HEADS,
             D_SSD + SSD_CONV_DIM + SSD_HEADS + D_S5)
EPS = 1e-6

kernel_name = 'hymba_ssd_s5_stream_step'


def rmsnorm(x, g):
    xf = x.astype(jnp.float32)
    y = xf * lax.rsqrt(jnp.mean(xf * xf, axis=-1, keepdims=True) + EPS)
    return (y * g.astype(jnp.float32)).astype(x.dtype)


def block_len(length):
    return CHUNK if length % CHUNK == 0 else length


def to_blocks(t, q):
    b, length = t.shape[0], t.shape[1]
    return jnp.moveaxis(t.reshape((b, length // q, q) + t.shape[2:]), 1, 0)


def from_blocks(t):
    t = jnp.moveaxis(t, 0, 1)
    return t.reshape((t.shape[0], t.shape[1] * t.shape[2]) + t.shape[3:])


def causal_dwconv(x, prev, w, bias):
    length = x.shape[1]
    xp = jnp.concatenate([prev.astype(x.dtype), x], axis=1)
    y = bias.astype(x.dtype)
    for k in range(SSD_CONV):
        y = y + w[k] * xp[:, k:k + length]
    return y, xp[:, xp.shape[1] - (SSD_CONV - 1):]


def segsum(a):
    t = a.shape[-1]
    ae = jnp.broadcast_to(a[..., :, None], a.shape + (t,))
    strict = jnp.tril(jnp.ones((t, t), dtype=bool), -1)
    cs = jnp.cumsum(jnp.where(strict, ae, 0.0), axis=-2)
    return jnp.where(jnp.tril(jnp.ones((t, t), dtype=bool)), cs, -jnp.inf)


def ssd_scan(xdt, a, bm, cm, h0):
    b, length, n_h, p = xdt.shape
    g, n = bm.shape[2], bm.shape[3]
    r = n_h // g
    q = block_len(length)
    xb = to_blocks(xdt.reshape(b, length, g, r, p), q)
    ab = to_blocks(a.reshape(b, length, g, r), q)
    bb = to_blocks(bm, q)
    cbk = to_blocks(cm, q)

    def block(h, inp):
        x_q, a_q, b_q, c_q = inp
        a_t = jnp.moveaxis(a_q, 1, -1)
        a_cs = jnp.cumsum(a_t, axis=-1)
        decay_in = jnp.exp(segsum(a_t))
        cb = jnp.einsum('blgn,bsgn->bgls', c_q, b_q)
        y = jnp.einsum('bgrls,bsgrp->blgrp', cb[:, :, None] * decay_in, x_q)
        from_h = jnp.moveaxis(jnp.exp(a_cs), -1, 1)[..., None]
        y = y + jnp.einsum('blgn,bgrpn->blgrp', c_q, h) * from_h
        to_end = jnp.moveaxis(jnp.exp(a_cs[..., -1:] - a_cs), -1, 1)[..., None]
        h_new = (h * jnp.exp(a_cs[..., -1])[..., None, None]
                 + jnp.einsum('bsgn,bsgrp->bgrpn', b_q, x_q * to_end))
        return h_new, y

    h_fin, ys = lax.scan(block, h0.reshape(b, g, r, p, n), (xb, ab, bb, cbk))
    return from_blocks(ys).reshape(b, length, n_h, p), h_fin.reshape(b, n_h, p, n)


def ssd_branch(z, xbc, dt_raw, conv_prev, h0, conv_w, conv_b, dt_bias, a_log, d_ssd, ssd_norm_g):
    f32 = jnp.float32
    b, length, _ = xbc.shape
    xbc_c, conv_new = causal_dwconv(xbc, conv_prev, conv_w, conv_b)
    xbc_c = jax.nn.silu(xbc_c.astype(f32))
    xs, bm, cm = jnp.split(xbc_c, (D_SSD, D_SSD + SSD_GROUPS * SSD_STATE), axis=-1)
    xs = xs.reshape(b, length, SSD_HEADS, SSD_HEADDIM)
    bm = bm.reshape(b, length, SSD_GROUPS, SSD_STATE)
    cm = cm.reshape(b, length, SSD_GROUPS, SSD_STATE)
    dt = jax.nn.softplus(dt_raw.astype(f32) + dt_bias.astype(f32))
    a_neg = -jnp.exp(a_log.astype(f32))
    y, h_new = ssd_scan(xs * dt[..., None], dt * a_neg, bm, cm, h0.astype(f32))
    y = y + d_ssd.astype(f32)[:, None] * xs
    y = y.reshape(b, length, D_SSD) * jax.nn.silu(z.astype(f32))
    y = rmsnorm(y.reshape(b, length, SSD_GROUPS, D_SSD // SSD_GROUPS),
                ssd_norm_g.reshape(SSD_GROUPS, D_SSD // SSD_GROUPS)).reshape(b, length, D_SSD)
    return y.astype(z.dtype), conv_new, h_new


def _lin_op(e1, e2):
    a1, b1 = e1
    a2, b2 = e2
    return a1 * a2, a2 * b1 + b2


def s5_branch(u, z, h0_re, h0_im, lam_re, lam_im, log_dt, b_re, b_im, c_re, c_im, d_s5, w_glu, b_glu):
    f32 = jnp.float32
    bsz, length, _ = u.shape
    uf = u.astype(f32).reshape(bsz, length, S5_GROUPS, S5_GROUP_CH)
    lam = lax.complex(lam_re.astype(f32), lam_im.astype(f32))
    lam_bar = jnp.exp(lam * jnp.exp(log_dt.astype(f32))[:, None])
    b_bar = ((lam_bar - 1.0) / lam)[..., None] * lax.complex(b_re.astype(f32), b_im.astype(f32))
    c_mat = lax.complex(c_re.astype(f32), c_im.astype(f32))
    q = block_len(length)
    a_blk = jnp.broadcast_to(lam_bar, (bsz, q, S5_GROUPS, S5_STATE))

    def block(h, u_q):
        bu = jnp.einsum('gpc,bqgc->bqgp', b_bar, u_q.astype(jnp.complex64))
        a_cum, h_loc = lax.associative_scan(_lin_op, (a_blk, bu), axis=1)
        hs = a_cum * h[:, None] + h_loc
        return hs[:, -1], jnp.real(jnp.einsum('gcp,bqgp->bqgc', c_mat, hs))

    h0 = lax.complex(h0_re.astype(f32), h0_im.astype(f32))
    h_fin, ys = lax.scan(block, h0, to_blocks(uf, q))
    y = from_blocks(ys) + d_s5.astype(f32).reshape(S5_GROUPS, S5_GROUP_CH) * uf
    y = jax.nn.gelu(y.reshape(bsz, length, D_S5))
    y = y * jax.nn.sigmoid(y @ w_glu.astype(f32) + b_glu.astype(f32))
    y = y * jax.nn.silu(z.astype(f32))
    return y.astype(u.dtype), jnp.real(h_fin), jnp.imag(h_fin)


def mixer_layer(x, conv_prev, ssd_h0, s5_h0_re, s5_h0_im,
                norm_g, w_in, conv_w, conv_b, dt_bias, a_log, d_ssd, ssd_norm_g,
                lam_re, lam_im, log_dt, b_re, b_im, c_re, c_im, d_s5, w_glu, b_glu, w_out):
    h = rmsnorm(x, norm_g)
    z_a, xbc, dt_raw, u_b, z_b = jnp.split(h @ w_in, IN_SPLITS, axis=-1)
    y_a, conv_new, ssd_new = ssd_branch(z_a, xbc, dt_raw, conv_prev, ssd_h0, conv_w, conv_b,
                                        dt_bias, a_log, d_ssd, ssd_norm_g)
    y_b, s5_re, s5_im = s5_branch(u_b, z_b, s5_h0_re, s5_h0_im, lam_re, lam_im, log_dt,
                                  b_re, b_im, c_re, c_im, d_s5, w_glu, b_glu)
    out = jnp.concatenate([y_a, y_b], axis=-1) @ w_out
    return x + out.astype(x.dtype), conv_new, ssd_new, s5_re, s5_im


def run_trunk(x, conv_s, ssd_s, s5re_s, s5im_s, layer_weights, final_norm_g):
    convs, ssds, res, ims = [], [], [], []
    for l in range(DEPTH):
        x, c, s, sr, si = mixer_layer(x, conv_s[l], ssd_s[l], s5re_s[l], s5im_s[l],
                                      *[w[l] for w in layer_weights])
        convs.append(c)
        ssds.append(s)
        res.append(sr)
        ims.append(si)
    return rmsnorm(x, final_norm_g), jnp.stack(convs), jnp.stack(ssds), jnp.stack(res), jnp.stack(ims)


def setup_inputs(seed: int = 0) -> dict:
    key = jax.random.key(seed)
    ks = jax.random.split(key, 26)
    f32 = jnp.float32

    def nrm(k, shape, scale):
        return scale * jax.random.normal(k, shape, f32)

    log_lo, log_hi = math.log(1e-3), math.log(1e-1)
    dt0 = jnp.exp(jax.random.uniform(ks[9], (DEPTH, SSD_HEADS), f32, log_lo, log_hi))
    return {
        'x_prompt': nrm(ks[0], (BATCH, SEQ, D_MODEL), 1.0),
        'x_sample': nrm(ks[1], (DEC_BATCH, DEC_SEQ, D_MODEL), 1.0),
        'state_ssd_conv': nrm(ks[2], (DEPTH, DEC_BATCH, SSD_CONV - 1, SSD_CONV_DIM), 1.0),
        'state_ssd': nrm(ks[3], (DEPTH, DEC_BATCH, SSD_HEADS, SSD_HEADDIM, SSD_STATE), 0.5),
        'state_s5_re': nrm(ks[4], (DEPTH, DEC_BATCH, S5_GROUPS, S5_STATE), 0.5),
        'state_s5_im': nrm(ks[5], (DEPTH, DEC_BATCH, S5_GROUPS, S5_STATE), 0.5),
        'norm_g': 1.0 + nrm(ks[6], (DEPTH, D_MODEL), 0.02),
        'w_in': nrm(ks[7], (DEPTH, D_MODEL, IN_COLS), D_MODEL ** -0.5),
        'conv_w': nrm(ks[8], (DEPTH, SSD_CONV, SSD_CONV_DIM), SSD_CONV ** -0.5),
        'conv_b': nrm(ks[10], (DEPTH, SSD_CONV_DIM), 0.02),
        'dt_bias': dt0 + jnp.log(-jnp.expm1(-dt0)),
        'a_log': jnp.log(jax.random.uniform(ks[11], (DEPTH, SSD_HEADS), f32, 1.0, 16.0)),
        'd_ssd': 1.0 + nrm(ks[12], (DEPTH, SSD_HEADS), 0.1),
        'ssd_norm_g': 1.0 + nrm(ks[13], (DEPTH, D_SSD), 0.02),
        'lam_re': -0.5 + nrm(ks[14], (DEPTH, S5_GROUPS, S5_STATE), 0.01),
        'lam_im': math.pi * jnp.arange(S5_STATE, dtype=f32) + nrm(ks[15], (DEPTH, S5_GROUPS, S5_STATE), 0.01),
        'log_dt': jax.random.uniform(ks[16], (DEPTH, S5_GROUPS), f32, log_lo, log_hi),
        'b_re': nrm(ks[17], (DEPTH, S5_GROUPS, S5_STATE, S5_GROUP_CH), (2 * S5_GROUP_CH) ** -0.5),
        'b_im': nrm(ks[18], (DEPTH, S5_GROUPS, S5_STATE, S5_GROUP_CH), (2 * S5_GROUP_CH) ** -0.5),
        'c_re': nrm(ks[19], (DEPTH, S5_GROUPS, S5_GROUP_CH, S5_STATE), S5_STATE ** -0.5),
        'c_im': nrm(ks[20], (DEPTH, S5_GROUPS, S5_GROUP_CH, S5_STATE), S5_STATE ** -0.5),
        'd_s5': nrm(ks[21], (DEPTH, D_S5), 1.0),
        'w_glu': nrm(ks[22], (DEPTH, D_S5, D_S5), D_S5 ** -0.5),
        'b_glu': nrm(ks[23], (DEPTH, D_S5), 0.02),
        'w_out': nrm(ks[24], (DEPTH, D_INNER, D_MODEL), D_INNER ** -0.5),
        'final_norm_g': 1.0 + nrm(ks[25], (D_MODEL,), 0.02),
    }


def reference(x_prompt, x_sample, state_ssd_conv, state_ssd, state_s5_re, state_s5_im,
              norm_g, w_in, conv_w, conv_b, dt_bias, a_log, d_ssd, ssd_norm_g,
              lam_re, lam_im, log_dt, b_re, b_im, c_re, c_im, d_s5, w_glu, b_glu, w_out,
              final_norm_g):
    layer_weights = (norm_g, w_in, conv_w, conv_b, dt_bias, a_log, d_ssd, ssd_norm_g,
                     lam_re, lam_im, log_dt, b_re, b_im, c_re, c_im, d_s5, w_glu, b_glu, w_out)
    bp = x_prompt.shape[0]
    zero_conv = jnp.zeros((DEPTH, bp, SSD_CONV - 1, SSD_CONV_DIM), x_prompt.dtype)
    zero_ssd = jnp.zeros((DEPTH, bp, SSD_HEADS, SSD_HEADDIM, SSD_STATE), jnp.float32)
    zero_s5 = jnp.zeros((DEPTH, bp, S5_GROUPS, S5_STATE), jnp.float32)
    y_prompt, conv_p, ssd_p, s5re_p, s5im_p = run_trunk(
        x_prompt, zero_conv, zero_ssd, zero_s5, zero_s5, layer_weights, final_norm_g)
    y_sample, conv_s, ssd_s, s5re_s, s5im_s = run_trunk(
        x_sample, state_ssd_conv, state_ssd, state_s5_re, state_s5_im, layer_weights, final_norm_g)
    return (y_prompt, y_sample, conv_p, ssd_p, s5re_p, s5im_p, conv_s, ssd_s, s5re_s, s5im_s)
```

```cpp
#include <hip/hip_runtime.h>
#include <hip/hip_cooperative_groups.h>
#include <cstdio>
namespace cg = cooperative_groups;

#define LAS __attribute__((address_space(3)))
typedef unsigned short bf16_t;
typedef short bf16x8 __attribute__((ext_vector_type(8)));
typedef float f32x4 __attribute__((ext_vector_type(4)));
typedef float f32x16 __attribute__((ext_vector_type(16)));
typedef unsigned u32x4 __attribute__((ext_vector_type(4)));
typedef unsigned u32x2 __attribute__((ext_vector_type(2)));

constexpr int T_TOK = 33280, TP = 32768, NMT = 130;
constexpr int LDP = 5376;
constexpr int C_ZA = 0, C_XBC = 1024, C_U = 3072, C_ZB = 4096, C_DT = 5120;
constexpr int NTHREADS = 512;
constexpr int LDS_BYTES = 139264;

constexpr size_t O_Y = 0, O_CONVP = 34078720, O_SSDP = 34471936, O_S5REP = 42860544, O_S5IMP = 43122688,
                 O_CONVS = 43384832, O_SSDS = 43581440, O_S5RES = 47775744, O_S5IMS = 47906816;

struct Params {
  const float *x_prompt, *x_sample, *st_conv, *st_ssd, *st_s5re, *st_s5im;
  const float *norm_g, *w_in, *conv_w, *conv_b, *dt_bias, *a_log, *d_ssd, *ssd_norm_g;
  const float *lam_re, *lam_im, *log_dt, *b_re, *b_im, *c_re, *c_im, *d_s5, *w_glu, *b_glu, *w_out, *final_g;
  float* out;
  bf16_t *xb, *proj, *WinT, *WgluT, *WoutT, *BbT, *CmT;
  float *sumsq, *ssqa, *lamb;
  unsigned* bar;
  int phase_begin, phase_end;
};

__device__ __forceinline__ float bf2f(unsigned short v) { return __uint_as_float(((unsigned)v) << 16); }
__device__ __forceinline__ float lo_f(unsigned w) { return __uint_as_float(w << 16); }
__device__ __forceinline__ float hi_f(unsigned w) { return __uint_as_float(w & 0xffff0000u); }
__device__ __forceinline__ unsigned pk2(float lo, float hi) { unsigned r; asm("v_cvt_pk_bf16_f32 %0, %1, %2" : "=v"(r) : "v"(lo), "v"(hi)); return r; }
__device__ __forceinline__ float sigm(float x) { return __builtin_amdgcn_rcpf(1.f + __expf(-x)); }
__device__ __forceinline__ float siluf(float x) { return x * sigm(x); }
__device__ __forceinline__ float gelu_tanh(float x) { const float z = 0.7978845608028654f * (x + 0.044715f * x * x * x); return x * sigm(2.f * z); }
__device__ __forceinline__ f32x4 mfma16(bf16x8 a, bf16x8 b, f32x4 c) { return __builtin_amdgcn_mfma_f32_16x16x32_bf16(a, b, c, 0, 0, 0); }
#define WAIT_V0() asm volatile("s_waitcnt vmcnt(0)" ::: "memory")
#define LDS_BARRIER() asm volatile("s_waitcnt lgkmcnt(0)\n\ts_barrier" ::: "memory")
__device__ __forceinline__ int otid() { int t = threadIdx.x; asm volatile("" : "+v"(t)); return t; }

__device__ __forceinline__ void stage_rc(int b, int& R, int& C) {
  const int st = b >> 10, sb = b & 1023, swz = sb ^ (((sb >> 9) & 1) << 5);
  R = (st >> 1) * 16 + swz / 64;
  C = (st & 1) * 32 + (swz % 64) / 2;
}

struct EpiIn {
  bf16_t* proj; const float* sumsq;
  __device__ __forceinline__ void operator()(f32x4 (&acc)[8][4], int pm, int pn, int wr, int wc, int fr, int fq) const {
    const int row0 = pm * 256 + wr * 128 + fr, col0 = pn * 256 + wc * 64 + fq * 4;
#pragma unroll
    for (int m = 0; m < 8; ++m) {
      const int row = row0 + m * 16;
      const f32x4* sp = (const f32x4*)(sumsq + (size_t)row * 16);
      const f32x4 s0 = sp[0], s1 = sp[1], s2 = sp[2], s3 = sp[3];
      const float ss = ((s0[0] + s0[1]) + (s0[2] + s0[3])) + ((s1[0] + s1[1]) + (s1[2] + s1[3])) +
                       ((s2[0] + s2[1]) + (s2[2] + s2[3])) + ((s3[0] + s3[1]) + (s3[2] + s3[3]));
      const float rs = rsqrtf(ss * (1.f / 1024.f) + 1e-6f);
      bf16_t* rp = proj + (size_t)row * LDP + col0;
#pragma unroll
      for (int n = 0; n < 4; ++n) {
        f32x4 v = acc[m][n] * rs; u32x2 o; o.x = pk2(v[0], v[1]); o.y = pk2(v[2], v[3]);
        *(u32x2*)(rp + n * 16) = o;
      }
    }
  }
};
struct EpiGlu {
  bf16_t* proj; const float* bglu; const bf16_t* ys;
  __device__ __forceinline__ void operator()(f32x4 (&acc)[8][4], int pm, int pn, int wr, int wc, int fr, int fq) const {
    const int row0 = pm * 256 + wr * 128 + fr, col0 = pn * 256 + wc * 64 + fq * 4;
#pragma unroll
    for (int m = 0; m < 8; ++m) {
      const int row = row0 + m * 16;
      bf16_t* base = proj + (size_t)row * LDP;
#pragma unroll
      for (int n = 0; n < 4; ++n) {
        const int col = col0 + n * 16;
        const f32x4 g = acc[m][n] + *(const f32x4*)(bglu + col);
        const u32x2 a = *(const u32x2*)(ys + (size_t)row * 1024 + col);
        const u32x2 z = *(const u32x2*)(base + C_ZB + col);
        const float o0 = lo_f(a.x) * sigm(g[0]) * siluf(lo_f(z.x));
        const float o1 = hi_f(a.x) * sigm(g[1]) * siluf(hi_f(z.x));
        const float o2 = lo_f(a.y) * sigm(g[2]) * siluf(lo_f(z.y));
        const float o3 = hi_f(a.y) * sigm(g[3]) * siluf(hi_f(z.y));
        u32x2 o; o.x = pk2(o0, o1); o.y = pk2(o2, o3);
        *(u32x2*)(base + C_ZB + col) = o;
      }
    }
  }
};
struct EpiOut {
  const float *xin_p, *xin_s; float* xout; bf16_t* xb; float* ssq_next;
  __device__ __forceinline__ void operator()(f32x4 (&acc)[8][4], int pm, int pn, int wr, int wc, int fr, int fq) const {
    const int row0 = pm * 256 + wr * 128 + fr, col0 = pn * 256 + wc * 64 + fq * 4;
#pragma unroll
    for (int m = 0; m < 8; ++m) {
      const int row = row0 + m * 16;
      const float* xr = (row < TP) ? (xin_p + (size_t)row * 1024) : (xin_s + (size_t)(row - TP) * 1024);
      float s = 0.f;
#pragma unroll
      for (int n = 0; n < 4; ++n) {
        const int col = col0 + n * 16;
        const f32x4 v = acc[m][n] + *(const f32x4*)(xr + col);
        *(f32x4*)(xout + (size_t)row * 1024 + col) = v;
        if (xb) { u32x2 o; o.x = pk2(v[0], v[1]); o.y = pk2(v[2], v[3]); *(u32x2*)(xb + (size_t)row * 1024 + col) = o; }
        s += v[0] * v[0] + v[1] * v[1] + v[2] * v[2] + v[3] * v[3];
      }
      s += __shfl_xor(s, 16); s += __shfl_xor(s, 32);
      if (fq == 0) ssq_next[(size_t)row * 16 + pn * 4 + wc] = s;
    }
  }
};

template <class Epi>
__device__ __forceinline__ void gemm_unit(LAS unsigned char* lds, const bf16_t* A, int lda, int segkt, int segoff,
                                          const bf16_t* Bt, int ldb, int nt, int pm, int pn, const Epi& epi,
                                          int npm = -1, int npn = 0, bool prefetched = false) {
  const int tid = otid(), wid = tid >> 6, lane = tid & 63, wr = wid >> 2, wc = wid & 3, fr = lane & 15, fq = lane >> 4;
  const bf16_t* Ab = A + (size_t)pm * 256 * lda;
  const bf16_t* Bb = Bt + (size_t)pn * 256 * ldb;
  int aoff[4], boff[4];
#pragma unroll
  for (int i = 0; i < 4; ++i) { int R, C; stage_rc(wid * 1024 + i * 8192 + lane * 16, R, C); aoff[i] = R * lda + C; boff[i] = R * ldb + C; }
  f32x4 acc[8][4];
#pragma unroll
  for (int m = 0; m < 8; ++m)
#pragma unroll
    for (int n = 0; n < 4; ++n) acc[m][n] = (f32x4){0.f, 0.f, 0.f, 0.f};
  const int ob = fr * 64 + fq * 16;
  const int sw = ob ^ (((ob >> 9) & 1) << 5);
  const int abase = wr * 16 * 1024 + sw, bbase = 32768 + wc * 8 * 1024 + sw;

#define G_STAGE(buf, kt) do { const int ac_ = (kt) * 64 + ((kt) >= segkt ? segoff : 0), bc_ = (kt) * 64; \
    _Pragma("unroll") for (int i = 0; i < 4; ++i) { \
      __builtin_amdgcn_global_load_lds((const unsigned*)(Ab + aoff[i] + ac_), (LAS unsigned*)(lds + (buf) * 65536 + wid * 1024 + i * 8192), 16, 0, 0); \
      __builtin_amdgcn_global_load_lds((const unsigned*)(Bb + boff[i] + bc_), (LAS unsigned*)(lds + (buf) * 65536 + 32768 + wid * 1024 + i * 8192), 16, 0, 0); } } while (0)

  if (!prefetched) G_STAGE(0, 0);
  WAIT_V0(); __syncthreads();
  for (int t = 0; t < nt; ++t) {
    const int cur = t & 1;
    if (t + 1 < nt) G_STAGE(cur ^ 1, t + 1);
#pragma unroll
    for (int ks = 0; ks < 2; ++ks) {
      bf16x8 At[8], Bf[4];
#pragma unroll
      for (int m = 0; m < 8; ++m) At[m] = *(const LAS bf16x8*)(lds + cur * 65536 + abase + (m * 2 + ks) * 1024);
#pragma unroll
      for (int n = 0; n < 4; ++n) Bf[n] = *(const LAS bf16x8*)(lds + cur * 65536 + bbase + (n * 2 + ks) * 1024);
#pragma unroll
      for (int m = 0; m < 8; ++m)
#pragma unroll
        for (int n = 0; n < 4; ++n) acc[m][n] = mfma16(Bf[n], At[m], acc[m][n]);
    }
    WAIT_V0(); __syncthreads();
  }
  if (npm >= 0) {
    Ab = A + (size_t)npm * 256 * lda; Bb = Bt + (size_t)npn * 256 * ldb;
    G_STAGE(0, 0);
  }
#undef G_STAGE
  epi(acc, pm, pn, wr, wc, fr, fq);
}

__device__ __forceinline__ int xcd_remap(int u) {
  const int G = gridDim.x, i = u / G, blk = u % G, per = G >> 3;
  if (G & 7) return u;
  return (i * 8 + (blk & 7)) * per + (blk >> 3);
}
__device__ __forceinline__ void tile_map(int u, int nN, int& pm, int& pn) {
  const int nig = 8 * nN, gid = u / nig, fm = gid * 8, rem = u % nig;
  const int gsz = (NMT - fm) < 8 ? (NMT - fm) : 8;
  pm = fm + rem % gsz; pn = rem / gsz;
}

namespace g8 {
constexpr int HTB = 128 * 64 * 2;
__device__ __forceinline__ int lds_byte(int r, int c) { const int st = (r >> 4) * 2 + (c >> 5), rr = r & 15, cc = c & 31, ob = rr * 64 + cc * 2; return st * 1024 + (ob ^ (((ob >> 9) & 1) << 5)); }
struct Unit { int pm, pn; };
struct Order {
  int ntiles, nN;
  __device__ __forceinline__ bool next(int i, Unit& u) const {
    const int w = xcd_remap((int)blockIdx.x + i * (int)gridDim.x);
    if (w >= ntiles) return false;
    tile_map(w, nN, u.pm, u.pn); return true;
  }
};
__device__ __forceinline__ int perm32(int rho) { const int n = rho >> 4, i = rho & 15; return 8 * (i >> 2) + 4 * n + (i & 3); }
struct EpiIn8 {
  static constexpr bool PERM = true;
  bf16_t* proj; const float* sumsq;
  __device__ __forceinline__ void operator()(const f32x4 (&acc)[2][2][4][2], const Unit& u, int wr, int wc, int fr, int fq) const {
    const int row0 = u.pm * 256 + wr * 64 + fr, col0 = u.pn * 256 + wc * 32 + fq * 8;
#pragma unroll
    for (int ai = 0; ai < 2; ++ai)
#pragma unroll
      for (int m = 0; m < 4; ++m) {
        const int row = row0 + ai * 128 + m * 16;
        const f32x4* sp = (const f32x4*)(sumsq + (size_t)row * 16);
        const f32x4 s0 = sp[0], s1 = sp[1], s2 = sp[2], s3 = sp[3];
        const float ss = ((s0[0] + s0[1]) + (s0[2] + s0[3])) + ((s1[0] + s1[1]) + (s1[2] + s1[3])) +
                         ((s2[0] + s2[1]) + (s2[2] + s2[3])) + ((s3[0] + s3[1]) + (s3[2] + s3[3]));
        const float rs = rsqrtf(ss * (1.f / 1024.f) + 1e-6f);
        bf16_t* rp = proj + (size_t)row * LDP + col0;
#pragma unroll
        for (int bj = 0; bj < 2; ++bj) {
          const f32x4 v0 = acc[ai][bj][m][0] * rs, v1 = acc[ai][bj][m][1] * rs;
          *(u32x4*)(rp + bj * 128) = (u32x4){pk2(v0[0], v0[1]), pk2(v0[2], v0[3]), pk2(v1[0], v1[1]), pk2(v1[2], v1[3])};
        }
      }
  }
};
struct EpiGlu8 {
  static constexpr bool PERM = true;
  bf16_t* proj; const float* bglu; const bf16_t* ys;
  __device__ __forceinline__ void operator()(const f32x4 (&acc)[2][2][4][2], const Unit& u, int wr, int wc, int fr, int fq) const {
    const int row0 = u.pm * 256 + wr * 64 + fr, col0 = u.pn * 256 + wc * 32 + fq * 8;
#pragma unroll
    for (int ai = 0; ai < 2; ++ai)
#pragma unroll
      for (int m = 0; m < 4; ++m) {
        const int row = row0 + ai * 128 + m * 16;
        bf16_t* base = proj + (size_t)row * LDP;
#pragma unroll
        for (int bj = 0; bj < 2; ++bj) {
          const int col = col0 + bj * 128;
          const f32x4 g0 = acc[ai][bj][m][0] + *(const f32x4*)(bglu + col), g1 = acc[ai][bj][m][1] + *(const f32x4*)(bglu + col + 4);
          const u32x4 a = *(const u32x4*)(ys + (size_t)row * 1024 + col);
          const u32x4 z = *(const u32x4*)(base + C_ZB + col);
          u32x4 o;
          o[0] = pk2(lo_f(a[0]) * sigm(g0[0]) * siluf(lo_f(z[0])), hi_f(a[0]) * sigm(g0[1]) * siluf(hi_f(z[0])));
          o[1] = pk2(lo_f(a[1]) * sigm(g0[2]) * siluf(lo_f(z[1])), hi_f(a[1]) * sigm(g0[3]) * siluf(hi_f(z[1])));
          o[2] = pk2(lo_f(a[2]) * sigm(g1[0]) * siluf(lo_f(z[2])), hi_f(a[2]) * sigm(g1[1]) * siluf(hi_f(z[2])));
          o[3] = pk2(lo_f(a[3]) * sigm(g1[2]) * siluf(lo_f(z[3])), hi_f(a[3]) * sigm(g1[3]) * siluf(hi_f(z[3])));
          *(u32x4*)(base + C_ZB + col) = o;
        }
      }
  }
};
struct EpiOut8 {
  static constexpr bool PERM = true;
  const float *xin_p, *xin_s; float* xout; bf16_t* xb; float* ssq_next;
  __device__ __forceinline__ void operator()(const f32x4 (&acc)[2][2][4][2], const Unit& u, int wr, int wc, int fr, int fq) const {
    const int row0 = u.pm * 256 + wr * 64 + fr, col0 = u.pn * 256 + wc * 32 + fq * 8;
#pragma unroll
    for (int ai = 0; ai < 2; ++ai)
#pragma unroll
      for (int m = 0; m < 4; ++m) {
        const int row = row0 + ai * 128 + m * 16;
        const float* xr = (row < TP) ? (xin_p + (size_t)row * 1024) : (xin_s + (size_t)(row - TP) * 1024);
        float s = 0.f;
#pragma unroll
        for (int bj = 0; bj < 2; ++bj) {
          const int col = col0 + bj * 128;
          const f32x4 v0 = acc[ai][bj][m][0] + *(const f32x4*)(xr + col), v1 = acc[ai][bj][m][1] + *(const f32x4*)(xr + col + 4);
          *(f32x4*)(xout + (size_t)row * 1024 + col) = v0;
          *(f32x4*)(xout + (size_t)row * 1024 + col + 4) = v1;
          if (xb) *(u32x4*)(xb + (size_t)row * 1024 + col) = (u32x4){pk2(v0[0], v0[1]), pk2(v0[2], v0[3]), pk2(v1[0], v1[1]), pk2(v1[2], v1[3])};
          s += v0[0] * v0[0] + v0[1] * v0[1] + v0[2] * v0[2] + v0[3] * v0[3] + v1[0] * v1[0] + v1[1] * v1[1] + v1[2] * v1[2] + v1[3] * v1[3];
        }
        s += __shfl_xor(s, 16); s += __shfl_xor(s, 32);
        if (fq == 0) ssq_next[(size_t)row * 16 + u.pn * 4 + wc] = s;
      }
  }
};

template <class Epi>
__device__ __forceinline__ void gemm_phase8(LAS unsigned char* lds, const bf16_t* A, int lda, int segkt, int segoff, const bf16_t* Bt, int K,
                                            const Order& S, const Epi& E) {
  const int tid = otid(), wid = __builtin_amdgcn_readfirstlane(tid >> 6), lane = tid & 63, wr = wid >> 2, wc = wid & 3, fr = lane & 15, fq = lane >> 4;
  const int nt = K / 64;
  unsigned voffA[2], voffB[2];
#pragma unroll
  for (int i = 0; i < 2; ++i) { int R, C; stage_rc(tid * 16 + i * 8192, R, C); const int Rb = Epi::PERM ? ((R & ~31) + perm32(R & 31)) : R;
    voffA[i] = (unsigned)(R * lda + C) * 2u; voffB[i] = (unsigned)(Rb * K + C) * 2u; }
  const size_t kstep = 128;
  const size_t hstepA = (size_t)128 * lda * 2, tstepA = 2 * hstepA;
  const size_t hstepB = (size_t)128 * K * 2, tstepB = 2 * hstepB;
  const size_t segB = (size_t)segoff * 2;
#define G8_AK(kt) ((size_t)(kt) * 128 + (((kt) >= segkt) ? segB : (size_t)0))
  const unsigned ldsw = (unsigned)wid * 1024u;
  const int aoff = lds_byte(wr * 64 + fr, fq * 8), boff = lds_byte(wc * 32 + fr, fq * 8);
#define G8_SA(b, h) (((b) * 2 + (h)) * HTB)
#define G8_SB(b, h) ((4 + (b) * 2 + (h)) * HTB)
#define G8_STAGE(bufoff, gbase, voff) do { _Pragma("unroll") for (int _i = 0; _i < 2; ++_i) \
    __builtin_amdgcn_global_load_lds((const unsigned*)((const char*)(gbase) + (voff)[_i]), (LAS unsigned*)(lds + (bufoff) + ldsw + _i * 8192), 16, 0, 0); } while (0)
#define G8_LDA(dst, b, h) do { _Pragma("unroll") for (int m = 0; m < 4; ++m) _Pragma("unroll") for (int k = 0; k < 2; ++k) dst[m][k] = *(const LAS bf16x8*)(lds + G8_SA(b, h) + aoff + m * 2048 + k * 1024); } while (0)
#define G8_LDB(dst, b, h) do { _Pragma("unroll") for (int n = 0; n < 2; ++n) _Pragma("unroll") for (int k = 0; k < 2; ++k) dst[n][k] = *(const LAS bf16x8*)(lds + G8_SB(b, h) + boff + n * 2048 + k * 1024); } while (0)
#define G8_MMA(ai, bj, At, Bt_) do { __builtin_amdgcn_s_setprio(1); _Pragma("unroll") for (int m = 0; m < 4; ++m) _Pragma("unroll") for (int n = 0; n < 2; ++n) _Pragma("unroll") for (int k = 0; k < 2; ++k) \
    acc[ai][bj][m][n] = __builtin_amdgcn_mfma_f32_16x16x32_bf16(Bt_[n][k], At[m][k], acc[ai][bj][m][n], 0, 0, 0); __builtin_amdgcn_s_setprio(0); } while (0)
#define G8_WAIT_V(n) asm volatile("s_waitcnt vmcnt(" #n ")" ::: "memory")
#define G8_WAIT_L(n) asm volatile("s_waitcnt lgkmcnt(" #n ")" ::: "memory")
#define G8_BAR __builtin_amdgcn_s_barrier()
#define G8_SCHED __builtin_amdgcn_sched_barrier(0)
  Unit cur, nxt; int ui = 0;
  if (!S.next(0, cur)) return;
  f32x4 acc[2][2][4][2];
#pragma unroll
  for (int a = 0; a < 2; ++a)
#pragma unroll
    for (int b = 0; b < 2; ++b)
#pragma unroll
      for (int m = 0; m < 4; ++m)
#pragma unroll
        for (int n = 0; n < 2; ++n) acc[a][b][m][n] = (f32x4){0.f, 0.f, 0.f, 0.f};
  bf16x8 At[4][2], B0[2][2], B1[2][2];
  const char* cA = (const char*)A + (size_t)cur.pm * tstepA; const char* cB = (const char*)Bt + (size_t)cur.pn * tstepB;
  G8_STAGE(G8_SB(0, 0), cB, voffB); G8_STAGE(G8_SA(0, 0), cA, voffA); G8_STAGE(G8_SB(0, 1), cB + hstepB, voffB); G8_STAGE(G8_SA(0, 1), cA + hstepA, voffA);
  if (wr == 1) G8_BAR;
  G8_WAIT_V(4); G8_BAR;
  G8_STAGE(G8_SB(1, 0), cB + kstep, voffB); G8_STAGE(G8_SA(1, 0), cA + G8_AK(1), voffA); G8_STAGE(G8_SB(1, 1), cB + hstepB + kstep, voffB);
  G8_WAIT_V(6); G8_BAR;
  for (;;) {
    const bool has_next = S.next(ui + 1, nxt);
    const char* nA = has_next ? (const char*)A + (size_t)nxt.pm * tstepA : cA; const char* nB = has_next ? (const char*)Bt + (size_t)nxt.pn * tstepB : cB;
    for (int t = 0; t < nt; t += 2) {
      const bool last = (t == nt - 2);
      const char* a1 = cA + G8_AK(t + 1);
      const char* a2 = last ? nA : cA + G8_AK(t + 2); const char* b2 = last ? nB : cB + (size_t)(t + 2) * kstep;
      const char* a3 = last ? nA + G8_AK(1) : cA + G8_AK(t + 3); const char* b3 = b2 + kstep;
      G8_LDB(B0, 0, 0); G8_SCHED; G8_LDA(At, 0, 0); G8_STAGE(G8_SA(1, 1), a1 + hstepA, voffA);
      G8_WAIT_L(8); G8_BAR; G8_WAIT_L(0); G8_MMA(0, 0, At, B0); G8_BAR; G8_SCHED;
      G8_LDB(B1, 0, 1); G8_STAGE(G8_SB(0, 0), b2, voffB);
      G8_BAR; G8_WAIT_L(0); G8_MMA(0, 1, At, B1); G8_BAR;
      G8_LDA(At, 0, 1); G8_STAGE(G8_SA(0, 0), a2, voffA);
      G8_BAR; G8_WAIT_L(0); G8_MMA(1, 0, At, B0); G8_BAR; G8_SCHED;
      G8_STAGE(G8_SB(0, 1), b2 + hstepB, voffB);
      G8_WAIT_V(6); G8_BAR; G8_MMA(1, 1, At, B1); G8_BAR;
      G8_LDB(B0, 1, 0); G8_SCHED; G8_LDA(At, 1, 0); G8_STAGE(G8_SA(0, 1), a2 + hstepA, voffA);
      G8_WAIT_L(8); G8_BAR; G8_WAIT_L(0); G8_MMA(0, 0, At, B0); G8_BAR; G8_SCHED;
      G8_LDB(B1, 1, 1); G8_STAGE(G8_SB(1, 0), b3, voffB);
      G8_BAR; G8_WAIT_L(0); G8_MMA(0, 1, At, B1); G8_BAR;
      G8_LDA(At, 1, 1); G8_STAGE(G8_SA(1, 0), a3, voffA);
      G8_BAR; G8_WAIT_L(0); G8_MMA(1, 0, At, B0); G8_BAR; G8_SCHED;
      G8_STAGE(G8_SB(1, 1), b3 + hstepB, voffB);
      G8_WAIT_V(6); G8_BAR; G8_MMA(1, 1, At, B1); G8_BAR;
    }
    E(acc, cur, wr, wc, fr, fq);
    if (!has_next) break;
#pragma unroll
    for (int a = 0; a < 2; ++a)
#pragma unroll
      for (int b = 0; b < 2; ++b)
#pragma unroll
        for (int m = 0; m < 4; ++m)
#pragma unroll
          for (int n = 0; n < 2; ++n) acc[a][b][m][n] = (f32x4){0.f, 0.f, 0.f, 0.f};
    cur = nxt; cA = nA; cB = nB; ++ui;
  }
  G8_WAIT_V(0);
  if (wr == 0) G8_BAR;
  G8_BAR;
#undef G8_AK
#undef G8_SA
#undef G8_SB
#undef G8_STAGE
#undef G8_LDA
#undef G8_LDB
#undef G8_MMA
#undef G8_WAIT_V
#undef G8_WAIT_L
#undef G8_BAR
#undef G8_SCHED
}
}

__device__ void xrow_unit(const Params& p, int unit) {
  const int tid_ = otid(); const int wid = tid_ >> 6, lane = tid_ & 63;
  f32x4 v[2][4];
#pragma unroll
  for (int r = 0; r < 2; ++r) {
    const int row = unit * 16 + r * 8 + wid;
    const float* src = (row < TP) ? (p.x_prompt + (size_t)row * 1024) : (p.x_sample + (size_t)(row - TP) * 1024);
#pragma unroll
    for (int i = 0; i < 4; ++i) v[r][i] = *(const f32x4*)(src + i * 256 + lane * 4);
  }
#pragma unroll
  for (int r = 0; r < 2; ++r) {
    const int row = unit * 16 + r * 8 + wid;
    float s = 0.f;
#pragma unroll
    for (int i = 0; i < 4; ++i) {
      const f32x4 x = v[r][i];
      s += x[0] * x[0] + x[1] * x[1] + x[2] * x[2] + x[3] * x[3];
      u32x2 o; o.x = pk2(x[0], x[1]); o.y = pk2(x[2], x[3]);
      *(u32x2*)(p.xb + (size_t)row * 1024 + i * 256 + lane * 4) = o;
    }
#pragma unroll
    for (int o = 32; o >= 1; o >>= 1) s += __shfl_xor(s, o);
    if (lane < 16) p.sumsq[(size_t)row * 16 + lane] = (lane == 0) ? s : 0.f;
  }
}

__device__ void transpose_unit(LAS unsigned char* lds, const float* src, int ldsrc, const float* scale, int nscale,
                               bf16_t* dst, int ldd, int kt, int ntile, int mode) {
  LAS float* tl = (LAS float*)lds;
  const int tid = otid();
  const int k0 = kt * 64, n0 = ntile * 64;
#pragma unroll
  for (int i = 0; i < 8; ++i) {
    const int e = tid + i * 512, kk = e >> 6, nn = e & 63;
    const int np = n0 + nn;
    int sc = np;
    if (mode == 0) { sc = (np < 3072) ? np : (np < 5120) ? (np + 16) : (np < 5136) ? (np - 5120 + 3072) : -1; }
    float v = 0.f;
    if (sc >= 0) {
      v = src[(size_t)(k0 + kk) * ldsrc + sc];
      if (scale && (k0 + kk) < nscale) v *= scale[k0 + kk];
    }
    tl[kk * 65 + nn] = v;
  }
  __syncthreads();
#pragma unroll
  for (int i = 0; i < 4; ++i) {
    const int e = tid + i * 512, nn = e >> 5, kk = (e & 31) * 2;
    const unsigned o = pk2(tl[kk * 65 + nn], tl[(kk + 1) * 65 + nn]);
    *(unsigned*)(dst + (size_t)(n0 + nn) * ldd + k0 + kk) = o;
  }
  __syncthreads();
}

__device__ __forceinline__ double exp_d(double x) {
  const double k = rint(x * 1.4426950408889634);
  const double r = fma(-k, 0.6931471805599453, x) - k * 2.3190468138462996e-17;
  double s = 1.0 / 6227020800.0;
  s = fma(s, r, 1.0 / 479001600.0); s = fma(s, r, 1.0 / 39916800.0); s = fma(s, r, 1.0 / 3628800.0);
  s = fma(s, r, 1.0 / 362880.0); s = fma(s, r, 1.0 / 40320.0); s = fma(s, r, 1.0 / 5040.0);
  s = fma(s, r, 1.0 / 720.0); s = fma(s, r, 1.0 / 120.0); s = fma(s, r, 1.0 / 24.0);
  s = fma(s, r, 1.0 / 6.0); s = fma(s, r, 0.5); s = fma(s, r, 1.0); s = fma(s, r, 1.0);
  return ldexp(s, (int)k);
}
__device__ __forceinline__ void sincos_d(double x, double& sn, double& cs) {
  const double k = rint(x * 0.6366197723675814);
  double r = fma(-k, 1.5707963267948966, x); r = fma(-k, 6.123233995736766e-17, r);
  const int q = ((int)k) & 3;
  const double r2 = r * r;
  double sp = 1.0 / 1307674368000.0;
  sp = fma(sp, r2, -1.0 / 6227020800.0); sp = fma(sp, r2, 1.0 / 39916800.0); sp = fma(sp, r2, -1.0 / 362880.0);
  sp = fma(sp, r2, 1.0 / 5040.0); sp = fma(sp, r2, -1.0 / 120.0); sp = fma(sp, r2, 1.0 / 6.0);
  sp = r - r * r2 * sp;
  double cp = 1.0 / 20922789888000.0;
  cp = fma(cp, r2, -1.0 / 87178291200.0); cp = fma(cp, r2, 1.0 / 479001600.0); cp = fma(cp, r2, -1.0 / 3628800.0);
  cp = fma(cp, r2, 1.0 / 40320.0); cp = fma(cp, r2, -1.0 / 720.0); cp = fma(cp, r2, 1.0 / 24.0); cp = fma(cp, r2, -0.5);
  cp = fma(cp, r2, 1.0);
  sn = (q == 0) ? sp : (q == 1) ? cp : (q == 2) ? -sp : -cp;
  cs = (q == 0) ? cp : (q == 1) ? -sp : (q == 2) ? -cp : sp;
}

__device__ void s5prep_unit(LAS unsigned char* lds, const Params& p, int l, int g) {
  LAS float* cf = (LAS float*)lds;
  const int tid = otid();
  const int lg = l * 64 + g;
  if (tid < 64) {
    const double dt = exp_d((double)p.log_dt[lg]);
    const double lr = (double)p.lam_re[lg * 64 + tid], li = (double)p.lam_im[lg * 64 + tid];
    const double e = exp_d(lr * dt);
    double sn, cs; sincos_d(li * dt, sn, cs);
    const double lbr = e * cs, lbi = e * sn;
    const double nr = lbr - 1.0, ni = lbi;
    const double den = lr * lr + li * li;
    const double cr = (nr * lr + ni * li) / den, ci = (ni * lr - nr * li) / den;
    p.lamb[(size_t)(lg * 64 + tid) * 2 + 0] = (float)lbr;
    p.lamb[(size_t)(lg * 64 + tid) * 2 + 1] = (float)lbi;
    cf[tid * 2 + 0] = (float)cr; cf[tid * 2 + 1] = (float)ci;
  }
  __syncthreads();
#pragma unroll
  for (int i = 0; i < 4; ++i) {
    const int idx = tid * 4 + i;
    {
      const int pp = idx >> 4, c = idx & 15, st = pp & 63;
      const float br = p.b_re[((size_t)lg * 64 + st) * 16 + c], bi = p.b_im[((size_t)lg * 64 + st) * 16 + c];
      const float cr = cf[st * 2], ci = cf[st * 2 + 1];
      const float v = (pp < 64) ? (cr * br - ci * bi) : (cr * bi + ci * br);
      p.BbT[(size_t)lg * 2048 + idx] = (bf16_t)(pk2(v, v) & 0xffffu);
    }
    {
      const int c = idx >> 7, pp = idx & 127, st = pp & 63;
      const float v = (pp < 64) ? p.c_re[((size_t)lg * 16 + c) * 64 + st] : -p.c_im[((size_t)lg * 16 + c) * 64 + st];
      p.CmT[(size_t)lg * 2048 + idx] = (bf16_t)(pk2(v, v) & 0xffffu);
    }
  }
  __syncthreads();
}

__device__ void phase_prep(LAS unsigned char* lds, const Params& p) {
  constexpr int U_X = 2080, U_WIN = 5376, U_WGLU = 1024, U_WOUT = 2048, U_S5 = 256;
  constexpr int TOTAL = U_X + U_WIN + U_WGLU + U_WOUT + U_S5;
  for (int u = blockIdx.x; u < TOTAL; u += gridDim.x) {
    int idx = u;
    if (idx < U_X) { xrow_unit(p, idx); continue; }
    idx -= U_X;
    if (idx < U_WIN) {
      const int l = idx / 1344, r = idx % 1344, ntile = r / 16, kt = r % 16;
      transpose_unit(lds, p.w_in + (size_t)l * 1024 * 5136, 5136, p.norm_g + l * 1024, 1024,
                     p.WinT + (size_t)l * 5376 * 1024, 1024, kt, ntile, 0);
      continue;
    }
    idx -= U_WIN;
    if (idx < U_WGLU) {
      const int l = idx / 256, r = idx % 256, ntile = r / 16, kt = r % 16;
      transpose_unit(lds, p.w_glu + (size_t)l * 1024 * 1024, 1024, nullptr, 0, p.WgluT + (size_t)l * 1024 * 1024, 1024, kt, ntile, 1);
      continue;
    }
    idx -= U_WGLU;
    if (idx < U_WOUT) {
      const int l = idx / 512, r = idx % 512, ntile = r / 32, kt = r % 32;
      transpose_unit(lds, p.w_out + (size_t)l * 2048 * 1024, 1024, p.ssd_norm_g + l * 1024, 1024,
                     p.WoutT + (size_t)l * 1024 * 2048, 2048, kt, ntile, 2);
      continue;
    }
    idx -= U_WOUT;
    s5prep_unit(lds, p, idx / 64, idx % 64);
  }
}

constexpr int CM_OFF = 0, BM_OFF = 17408, BMT_OFF = 34816, XDT_OFF = 53248, XW_OFF = 62464, MM_OFF = 71680,
              HB_OFF = 80896, XS_OFF = 98304, ACS_OFF = 107520, DTV_OFF = 115712, SSQ_OFF = 123904, CW_OFF = 124416;

__device__ __forceinline__ bf16x8 ldfrag(LAS unsigned char* lds, int off, int row, int stride, int col) {
  return *(const LAS bf16x8*)(lds + off + (row * stride + col) * 2);
}

template <int NCH>
__device__ __forceinline__ void conv_load_rows(unsigned (&rows)[7][NCH / 2], const bf16_t* proj, const float* stc, int tok0, int c, int s0, int ccol) {
#pragma unroll
  for (int i = 0; i < 7; ++i) {
    const int pos = c * 64 + s0 - 3 + i;
    if (pos >= 0) {
      const bf16_t* q = proj + (size_t)(tok0 + pos) * LDP + C_XBC + ccol;
      if (NCH == 8) { const u32x4 v = *(const u32x4*)q; rows[i][0] = v[0]; rows[i][1] = v[1]; rows[i][NCH / 2 - 2] = v[2]; rows[i][NCH / 2 - 1] = v[3]; }
      else rows[i][0] = *(const unsigned*)q;
    } else if (stc) {
      const float* sp = stc + (size_t)(3 + pos) * 2048 + ccol;
#pragma unroll
      for (int k = 0; k < NCH / 2; ++k) rows[i][k] = pk2(sp[2 * k], sp[2 * k + 1]);
    } else {
#pragma unroll
      for (int k = 0; k < NCH / 2; ++k) rows[i][k] = 0u;
    }
  }
}
template <int NCH>
__device__ __forceinline__ void conv_load_rows_fast(unsigned (&rows)[7][NCH / 2], const bf16_t* proj, int tok0, int c, int s0, int ccol) {
  const bf16_t* q0 = proj + (size_t)(tok0 + c * 64 + s0 - 3) * LDP + C_XBC + ccol;
#pragma unroll
  for (int i = 0; i < 7; ++i) {
    const bf16_t* q = q0 + (size_t)i * LDP;
    if (NCH == 8) { const u32x4 v = *(const u32x4*)q; rows[i][0] = v[0]; rows[i][1] = v[1]; rows[i][NCH / 2 - 2] = v[2]; rows[i][NCH / 2 - 1] = v[3]; }
    else rows[i][0] = *(const unsigned*)q;
  }
}
template <int NCH>
__device__ __forceinline__ void conv_store_row(LAS unsigned char* addr, const float* o) {
  if (NCH == 8) *(LAS u32x4*)addr = (u32x4){pk2(o[0], o[1]), pk2(o[2], o[3]), pk2(o[NCH - 4], o[NCH - 3]), pk2(o[NCH - 2], o[NCH - 1])};
  else *(LAS unsigned*)addr = pk2(o[0], o[1]);
}
template <int NCH>
__device__ __forceinline__ void conv_unit(LAS unsigned char* lds, const unsigned (&rows)[7][NCH / 2], const LAS float* wl,
                                          int oct, int chq, int s0, const LAS float* acs, const LAS float* dtv) {
  float o[4][NCH];
  float w[4][NCH], bs[NCH];
#pragma unroll
  for (int e = 0; e < NCH; ++e) { bs[e] = wl[32 + e];
#pragma unroll
    for (int k = 0; k < 4; ++k) w[k][e] = wl[k * 8 + e]; }
#pragma unroll
  for (int e = 0; e < NCH; ++e) {
    float xv[7];
#pragma unroll
    for (int i = 0; i < 7; ++i) xv[i] = (e & 1) ? hi_f(rows[i][e >> 1]) : lo_f(rows[i][e >> 1]);
#pragma unroll
    for (int j = 0; j < 4; ++j) o[j][e] = siluf(bs[e] + w[0][e] * xv[j] + w[1][e] * xv[j + 1] + w[2][e] * xv[j + 2] + w[3][e] * xv[j + 3]);
  }
  if (oct < 8) {
    float dts[4], wsc[4];
    const float aend = acs[63];
#pragma unroll
    for (int j = 0; j < 4; ++j) { dts[j] = dtv[s0 + j]; wsc[j] = dts[j] * __expf(aend - acs[s0 + j]); }
    const int p0 = oct * 8 + chq;
#pragma unroll
    for (int j = 0; j < 4; ++j) conv_store_row<NCH>(lds + XS_OFF + ((s0 + j) * 72 + p0) * 2, o[j]);
#pragma unroll
    for (int e = 0; e < NCH; ++e) {
      *(LAS u32x2*)(lds + XDT_OFF + ((p0 + e) * 72 + s0) * 2) = (u32x2){pk2(o[0][e] * dts[0], o[1][e] * dts[1]), pk2(o[2][e] * dts[2], o[3][e] * dts[3])};
      *(LAS u32x2*)(lds + XW_OFF + ((p0 + e) * 72 + s0) * 2) = (u32x2){pk2(o[0][e] * wsc[0], o[1][e] * wsc[1]), pk2(o[2][e] * wsc[2], o[3][e] * wsc[3])};
    }
  } else if (oct < 24) {
    const int n0 = (oct - 8) * 8 + chq;
#pragma unroll
    for (int j = 0; j < 4; ++j) conv_store_row<NCH>(lds + BM_OFF + ((s0 + j) * 136 + n0) * 2, o[j]);
#pragma unroll
    for (int e = 0; e < NCH; ++e) *(LAS u32x2*)(lds + BMT_OFF + ((n0 + e) * 72 + s0) * 2) = (u32x2){pk2(o[0][e], o[1][e]), pk2(o[2][e], o[3][e])};
  } else {
    const int n0 = (oct - 24) * 8 + chq;
#pragma unroll
    for (int j = 0; j < 4; ++j) conv_store_row<NCH>(lds + CM_OFF + ((s0 + j) * 136 + n0) * 2, o[j]);
  }
}

__device__ void ssd_item(LAS unsigned char* lds, const Params& p, int l, int b, int h, bool smp) {
  const int tid = otid(), wid = tid >> 6, lane = tid & 63, fr = lane & 15, fq = lane >> 4;
  const int g = h >> 2;
  const int tok0 = smp ? (TP + b * 64) : (b * 2048);
  const int nchunk = smp ? 1 : 32;
  const int NB = smp ? 8 : 16;
  bf16_t* proj = p.proj;
  LAS float* acs_all = (LAS float*)(lds + ACS_OFF);
  LAS float* dtv_all = (LAS float*)(lds + DTV_OFF);
  LAS float* ssq = (LAS float*)(lds + SSQ_OFF);
  const float dtb = p.dt_bias[l * 16 + h];
  const float Aneg = -__expf(p.a_log[l * 16 + h]);
  const float Dh = p.d_ssd[l * 16 + h];

  f32x4 hacc[4];
#pragma unroll
  for (int pt = 0; pt < 4; ++pt) {
    if (smp) hacc[pt] = *(const f32x4*)(p.st_ssd + ((((size_t)l * 8 + b) * 16 + h) * 64 + pt * 16 + fr) * 128 + wid * 16 + fq * 4);
    else hacc[pt] = (f32x4){0.f, 0.f, 0.f, 0.f};
  }

  const float* stc = smp ? (p.st_conv + ((size_t)l * 8 + b) * 3 * 2048) : nullptr;
  int octA, s0A;
  if (tid < 128) { octA = tid & 7; s0A = (tid >> 3) * 4; }
  else if (tid < 384) { const int i = tid - 128; octA = 8 + (i & 15); s0A = (i >> 4) * 4; }
  else { const int i = tid - 384; octA = 24 + (i & 15); s0A = (i >> 4) * 4; }
  const int jB = tid >> 2, octB = 24 + (jB & 15), s0B = (8 + (jB >> 4)) * 4, chqB = (tid & 3) * 2;
  const int cchA = (octA < 8) ? (h * 64 + octA * 8) : (octA < 24) ? (1024 + g * 128 + (octA - 8) * 8) : (1536 + g * 128 + (octA - 24) * 8);
  const int cchB = ((octB < 8) ? (h * 64 + octB * 8) : (octB < 24) ? (1024 + g * 128 + (octB - 8) * 8) : (1536 + g * 128 + (octB - 24) * 8)) + chqB;
  LAS float* cwl = (LAS float*)(lds + CW_OFF);
  {
    const float* cw = p.conv_w + (size_t)l * 4 * 2048;
    const float* cb = p.conv_b + (size_t)l * 2048;
    for (int idx = tid; idx < 1600; idx += 512) {
      const int oc = idx / 40, r = idx % 40, k = r >> 3, e = r & 7;
      const int cc = ((oc < 8) ? (h * 64 + oc * 8) : (oc < 24) ? (1024 + g * 128 + (oc - 8) * 8) : (1536 + g * 128 + (oc - 24) * 8)) + e;
      cwl[idx] = (k < 4) ? cw[k * 2048 + cc] : cb[cc];
    }
  }
  unsigned rowsA[7][4], rowsB[7][1];
  conv_load_rows<8>(rowsA, proj, stc, tok0, 0, s0A, cchA);
  conv_load_rows<2>(rowsB, proj, stc, tok0, 0, s0B, cchB);
  for (int c = wid; c < nchunk; c += 8) {
    const float dtr = bf2f(proj[(size_t)(tok0 + c * 64 + lane) * LDP + C_DT + h]);
    const float xx = dtr + dtb;
    const float dt = xx > 20.f ? xx : log1pf(__expf(xx));
    float cs = dt * Aneg;
#pragma unroll
    for (int o = 1; o < 64; o <<= 1) { const float v = __shfl_up(cs, o); if (lane >= o) cs += v; }
    acs_all[c * 64 + lane] = cs; dtv_all[c * 64 + lane] = dt;
  }
  LDS_BARRIER();
  for (int c = 0; c < nchunk; ++c) {
    const int ctok = tok0 + c * 64;
    const LAS float* acs = acs_all + c * 64;
    const LAS float* dtv = dtv_all + c * 64;
    u32x2 z4v[2];
    {
      const int lt_ = wid >> 1, ptb_ = (wid & 1) * 2;
#pragma unroll
      for (int q = 0; q < 2; ++q) z4v[q] = *(const u32x2*)(proj + (size_t)(ctok + lt_ * 16 + fr) * LDP + C_ZA + h * 64 + (ptb_ + q) * 16 + fq * 4);
    }
    conv_unit<8>(lds, rowsA, cwl + octA * 40, octA, 0, s0A, acs, dtv);
    conv_unit<2>(lds, rowsB, cwl + octB * 40 + chqB, octB, chqB, s0B, acs, dtv);
    if (c + 1 < nchunk) {
      conv_load_rows_fast<8>(rowsA, proj, tok0, c + 1, s0A, cchA);
      conv_load_rows_fast<2>(rowsB, proj, tok0, c + 1, s0B, cchB);
    }
#pragma unroll
    for (int pt = 0; pt < 4; ++pt)
      *(LAS u32x2*)(lds + HB_OFF + ((pt * 16 + fr) * 136 + wid * 16 + fq * 4) * 2) =
          (u32x2){pk2(hacc[pt][0], hacc[pt][1]), pk2(hacc[pt][2], hacc[pt][3])};
    LDS_BARRIER();
    const int lt = wid >> 1, ptb = (wid & 1) * 2;
    {
      const int st = wid >> 1, ltb = (wid & 1) * 2;
      bf16x8 bfr[4];
#pragma unroll
      for (int ks = 0; ks < 4; ++ks) bfr[ks] = ldfrag(lds, BM_OFF, st * 16 + fr, 136, ks * 32 + fq * 8);
#pragma unroll
      for (int q = 0; q < 2; ++q) {
        const int ltq = ltb + q;
        f32x4 a = (f32x4){0.f, 0.f, 0.f, 0.f};
#pragma unroll
        for (int ks = 0; ks < 4; ++ks) a = mfma16(bfr[ks], ldfrag(lds, CM_OFF, ltq * 16 + fr, 136, ks * 32 + fq * 8), a);
        const int l_ = ltq * 16 + fr;
        const float al = acs[l_];
        float mv[4];
#pragma unroll
        for (int r = 0; r < 4; ++r) { const int s_ = st * 16 + fq * 4 + r; const float ex = __expf(al - acs[s_]); mv[r] = (s_ <= l_) ? a[r] * ex : 0.f; }
        *(LAS u32x2*)(lds + MM_OFF + (l_ * 72 + st * 16 + fq * 4) * 2) = (u32x2){pk2(mv[0], mv[1]), pk2(mv[2], mv[3])};
      }
    }
    f32x4 accI[2];
    accI[0] = (f32x4){0.f, 0.f, 0.f, 0.f}; accI[1] = accI[0];
#pragma unroll
    for (int ks = 0; ks < 4; ++ks) {
      const bf16x8 cfr = ldfrag(lds, CM_OFF, lt * 16 + fr, 136, ks * 32 + fq * 8);
#pragma unroll
      for (int q = 0; q < 2; ++q) accI[q] = mfma16(ldfrag(lds, HB_OFF, (ptb + q) * 16 + fr, 136, ks * 32 + fq * 8), cfr, accI[q]);
    }
    {
      const float dec = __expf(acs[63]);
      bf16x8 bt[2];
#pragma unroll
      for (int ks = 0; ks < 2; ++ks) bt[ks] = ldfrag(lds, BMT_OFF, wid * 16 + fr, 72, ks * 32 + fq * 8);
#pragma unroll
      for (int pt = 0; pt < 4; ++pt) {
        hacc[pt] = hacc[pt] * dec;
#pragma unroll
        for (int ks = 0; ks < 2; ++ks) hacc[pt] = mfma16(bt[ks], ldfrag(lds, XW_OFF, pt * 16 + fr, 72, ks * 32 + fq * 8), hacc[pt]);
      }
    }
    LDS_BARRIER();
    {
      f32x4 accY[2];
      accY[0] = (f32x4){0.f, 0.f, 0.f, 0.f}; accY[1] = accY[0];
#pragma unroll
      for (int ks = 0; ks < 2; ++ks) {
        const bf16x8 mf = ldfrag(lds, MM_OFF, lt * 16 + fr, 72, ks * 32 + fq * 8);
#pragma unroll
        for (int q = 0; q < 2; ++q) accY[q] = mfma16(ldfrag(lds, XDT_OFF, (ptb + q) * 16 + fr, 72, ks * 32 + fq * 8), mf, accY[q]);
      }
      const int l_ = lt * 16 + fr;
      const float el = __expf(acs[l_]);
      float sq = 0.f;
#pragma unroll
      for (int q = 0; q < 2; ++q) {
        const int p0 = (ptb + q) * 16 + fq * 4;
        const u32x2 xs4 = *(const LAS u32x2*)(lds + XS_OFF + (l_ * 72 + p0) * 2);
        bf16_t* zp = proj + (size_t)(ctok + l_) * LDP + C_ZA + h * 64 + p0;
        const u32x2 z4 = z4v[q];
        const float y0 = (accY[q][0] + el * accI[q][0] + Dh * lo_f(xs4.x)) * siluf(lo_f(z4.x));
        const float y1 = (accY[q][1] + el * accI[q][1] + Dh * hi_f(xs4.x)) * siluf(hi_f(z4.x));
        const float y2 = (accY[q][2] + el * accI[q][2] + Dh * lo_f(xs4.y)) * siluf(lo_f(z4.y));
        const float y3 = (accY[q][3] + el * accI[q][3] + Dh * hi_f(xs4.y)) * siluf(hi_f(z4.y));
        sq += y0 * y0 + y1 * y1 + y2 * y2 + y3 * y3;
        *(u32x2*)zp = (u32x2){pk2(y0, y1), pk2(y2, y3)};
      }
      sq += __shfl_xor(sq, 16); sq += __shfl_xor(sq, 32);
      if (fq == 0) ssq[(wid & 1) * 64 + l_] = sq;
    }
    LDS_BARRIER();
    if (tid < 64) p.ssqa[(size_t)(ctok + tid) * 16 + h] = ssq[tid] + ssq[64 + tid];
  }
  {
    float* so = p.out + (smp ? O_SSDS : O_SSDP);
#pragma unroll
    for (int pt = 0; pt < 4; ++pt)
      *(f32x4*)(so + ((((size_t)l * NB + b) * 16 + h) * 64 + pt * 16 + fr) * 128 + wid * 16 + fq * 4) = hacc[pt];
    float* co = p.out + (smp ? O_CONVS : O_CONVP);
    const int L = smp ? 64 : 2048;
    for (int i = tid; i < 3 * 320; i += 512) {
      const int r = i / 320, cc = i % 320;
      if (cc >= 64 && (h & 3)) continue;
      const int ch = (cc < 64) ? (h * 64 + cc) : (cc < 192) ? (1024 + g * 128 + (cc - 64)) : (1536 + g * 128 + (cc - 192));
      co[(((size_t)l * NB + b) * 3 + r) * 2048 + ch] = bf2f(proj[(size_t)(tok0 + L - 3 + r) * LDP + C_XBC + ch]);
    }
  }
  __syncthreads();
}

__device__ __forceinline__ float fma_asm(float a, float b, float c) { float d; asm volatile("v_fma_f32 %0, %1, %2, %3" : "=v"(d) : "v"(a), "v"(b), "v"(c)); return d; }
__device__ void s5_seq(LAS unsigned char* lds, const Params& p, int l, int b, int g, bool smp) {
  const int tid_ = otid(); const int wid = tid_ >> 6, lane = tid_ & 63, fr = lane & 15, fq = lane >> 4;
  LAS float* buf = (LAS float*)(lds + wid * 16896);
  const int tok0 = smp ? (TP + b * 64) : (b * 2048);
  const int nblk = smp ? 2 : 64;
  const int NB = smp ? 8 : 16;
  const int lg = l * 64 + g;
  bf16x8 Bfrag[4], Cfrag[4];
#pragma unroll
  for (int nt = 0; nt < 4; ++nt) Bfrag[nt] = *(const bf16x8*)(p.BbT + ((size_t)lg * 128 + nt * 32 + (lane & 31)) * 16 + 8 * (lane >> 5));
#pragma unroll
  for (int ks = 0; ks < 4; ++ks) Cfrag[ks] = *(const bf16x8*)(p.CmT + ((size_t)lg * 16 + fr) * 128 + ks * 32 + fq * 8);
  const float lr = p.lamb[(size_t)(lg * 64 + lane) * 2], li = p.lamb[(size_t)(lg * 64 + lane) * 2 + 1];
  const float nli = -li;
  float hr = 0.f, hi = 0.f;
  if (smp) { hr = p.st_s5re[(((size_t)l * 8 + b) * 64 + g) * 64 + lane]; hi = p.st_s5im[(((size_t)l * 8 + b) * 64 + g) * 64 + lane]; }
  const f32x4 d4 = *(const f32x4*)(p.d_s5 + l * 1024 + g * 16 + fq * 4);
  const bf16_t* ubase = p.proj + C_U + g * 16;
  bf16x8 a_next = *(const bf16x8*)(ubase + (size_t)(tok0 + (lane & 31)) * LDP + 8 * (lane >> 5));
  for (int blk = 0; blk < nblk; ++blk) {
    const bf16x8 a = a_next;
    if (blk + 1 < nblk) a_next = *(const bf16x8*)(ubase + (size_t)(tok0 + (blk + 1) * 32 + (lane & 31)) * LDP + 8 * (lane >> 5));
    u32x2 u4v[2];
#pragma unroll
    for (int mt = 0; mt < 2; ++mt) u4v[mt] = *(const u32x2*)(ubase + (size_t)(tok0 + blk * 32 + mt * 16 + fr) * LDP + fq * 4);
    float bre[32], bim[32];
    {
      f32x16 d[4];
#pragma unroll
      for (int nt = 0; nt < 4; ++nt) {
        f32x16 z = {0.f, 0.f, 0.f, 0.f, 0.f, 0.f, 0.f, 0.f, 0.f, 0.f, 0.f, 0.f, 0.f, 0.f, 0.f, 0.f};
        d[nt] = __builtin_amdgcn_mfma_f32_32x32x16_bf16(a, Bfrag[nt], z, 0, 0, 0);
      }
#pragma unroll
      for (int r = 0; r < 16; ++r) {
        const int tA = (r & 3) + 8 * (r >> 2);
        const auto sr = __builtin_amdgcn_permlane32_swap(__float_as_uint(d[0][r]), __float_as_uint(d[1][r]), false, false);
        bre[tA] = __uint_as_float(sr[0]); bre[tA + 4] = __uint_as_float(sr[1]);
        const auto si = __builtin_amdgcn_permlane32_swap(__float_as_uint(d[2][r]), __float_as_uint(d[3][r]), false, false);
        bim[tA] = __uint_as_float(si[0]); bim[tA + 4] = __uint_as_float(si[1]);
      }
    }
#pragma unroll
    for (int t = 0; t < 32; ++t) {
      float nr = fma_asm(lr, hr, bre[t]); nr = fma_asm(nli, hi, nr);
      float ni = fma_asm(lr, hi, bim[t]); ni = fma_asm(li, hr, ni);
      hr = nr; hi = ni;
      buf[t * 132 + lane] = hr; buf[t * 132 + 64 + lane] = hi;
    }
    asm volatile("s_waitcnt lgkmcnt(0)" ::: "memory");
#pragma unroll
    for (int mt = 0; mt < 2; ++mt) {
      f32x4 acc = (f32x4){0.f, 0.f, 0.f, 0.f};
#pragma unroll
      for (int ks = 0; ks < 4; ++ks) {
        const LAS float* hp = buf + (mt * 16 + fr) * 132 + ks * 32 + fq * 8;
        const f32x4 h0 = *(const LAS f32x4*)hp, h1 = *(const LAS f32x4*)(hp + 4);
        u32x4 hw = (u32x4){pk2(h0[0], h0[1]), pk2(h0[2], h0[3]), pk2(h1[0], h1[1]), pk2(h1[2], h1[3])};
        bf16x8 hf = __builtin_bit_cast(bf16x8, hw);
        acc = mfma16(Cfrag[ks], hf, acc);
      }
      const size_t trow = (size_t)(tok0 + blk * 32 + mt * 16 + fr);
      const u32x2 u4 = u4v[mt];
      const float y0 = gelu_tanh(acc[0] + d4[0] * lo_f(u4.x));
      const float y1 = gelu_tanh(acc[1] + d4[1] * hi_f(u4.x));
      const float y2 = gelu_tanh(acc[2] + d4[2] * lo_f(u4.y));
      const float y3 = gelu_tanh(acc[3] + d4[3] * hi_f(u4.y));
      *(u32x2*)(p.xb + trow * 1024 + g * 16 + fq * 4) = (u32x2){pk2(y0, y1), pk2(y2, y3)};
    }
    asm volatile("" ::: "memory");
  }
  p.out[(smp ? O_S5RES : O_S5REP) + (((size_t)l * NB + b) * 64 + g) * 64 + lane] = hr;
  p.out[(smp ? O_S5IMS : O_S5IMP) + (((size_t)l * NB + b) * 64 + g) * 64 + lane] = hi;
}

__device__ void phase_mixer(LAS unsigned char* lds, const Params& p, int l) {
  const int wid = otid() >> 6;
  for (int u = blockIdx.x; u < 768; u += gridDim.x) {
    if (u < 256) ssd_item(lds, p, l, u >> 4, u & 15, false);
    else if (u < 512) { if (wid < 4) { const int seq = (u - 256) * 4 + wid; s5_seq(lds, p, l, seq >> 6, seq & 63, false); } }
    else if (u < 640) { const int v = u - 512; ssd_item(lds, p, l, v >> 4, v & 15, true); }
    else { if (wid < 4) { const int seq = (u - 640) * 4 + wid; s5_seq(lds, p, l, seq >> 6, seq & 63, true); } }
    __syncthreads();
  }
}

__device__ void norm_unit(const Params& p, int nu) {
  const int tid = otid();
  const int tok = nu * 32 + (tid >> 4), hh = tid & 15, gg = hh >> 2;
  const f32x4 s4 = *(const f32x4*)(p.ssqa + (size_t)tok * 16 + gg * 4);
  const float rs = rsqrtf((s4[0] + s4[1] + s4[2] + s4[3]) * (1.f / 256.f) + 1e-6f);
  bf16_t* q = p.proj + (size_t)tok * LDP + C_ZA + hh * 64;
#pragma unroll
  for (int i = 0; i < 8; ++i) {
    u32x4 v = *(u32x4*)(q + i * 8);
#pragma unroll
    for (int k = 0; k < 4; ++k) v[k] = pk2(lo_f(v[k]) * rs, hi_f(v[k]) * rs);
    *(u32x4*)(q + i * 8) = v;
  }
}

__device__ void final_unit(const Params& p, int unit) {
  const int tid_ = otid(); const int wid = tid_ >> 6, lane = tid_ & 63;
  const int row = unit * 8 + wid;
  const f32x4* sp = (const f32x4*)(p.sumsq + ((size_t)4 * T_TOK + row) * 16);
  const f32x4 s0 = sp[0], s1 = sp[1], s2 = sp[2], s3 = sp[3];
  const float ss = ((s0[0] + s0[1]) + (s0[2] + s0[3])) + ((s1[0] + s1[1]) + (s1[2] + s1[3])) +
                   ((s2[0] + s2[1]) + (s2[2] + s2[3])) + ((s3[0] + s3[1]) + (s3[2] + s3[3]));
  const float rs = rsqrtf(ss * (1.f / 1024.f) + 1e-6f);
  float* xr = p.out + (size_t)row * 1024;
#pragma unroll
  for (int i = 0; i < 4; ++i) {
    const int c = i * 256 + lane * 4;
    const f32x4 v = *(const f32x4*)(xr + c);
    const f32x4 gv = *(const f32x4*)(p.final_g + c);
    *(f32x4*)(xr + c) = v * rs * gv;
  }
}

__device__ __forceinline__ void grid_barrier(cg::grid_group& grid, unsigned* ctr, unsigned target) {
  asm volatile("s_waitcnt vmcnt(0) lgkmcnt(0)" ::: "memory");
  __syncthreads();
  if (target == gridDim.x) grid.sync();
  if (threadIdx.x == 0) {
    __builtin_amdgcn_fence(__ATOMIC_RELEASE, "agent");
    asm volatile("s_waitcnt vmcnt(0)" ::: "memory");
    __hip_atomic_fetch_add(ctr, 1u, __ATOMIC_RELAXED, __HIP_MEMORY_SCOPE_AGENT);
    while (__hip_atomic_load(ctr, __ATOMIC_RELAXED, __HIP_MEMORY_SCOPE_AGENT) < target) __builtin_amdgcn_s_sleep(1);
    __builtin_amdgcn_fence(__ATOMIC_ACQUIRE, "agent");
    asm volatile("s_waitcnt vmcnt(0)" ::: "memory");
  }
  __syncthreads();
}

__global__ void __launch_bounds__(NTHREADS) mega(Params p) {
  __shared__ __attribute__((aligned(1024))) unsigned char shm[LDS_BYTES];
  LAS unsigned char* lds = (LAS unsigned char*)shm;
  cg::grid_group grid = cg::this_grid();
  phase_prep(lds, p);
  grid_barrier(grid, p.bar, gridDim.x);
  for (int ph = 1; ph < p.phase_end; ++ph) {
    if (ph == 17) {
      for (int u = blockIdx.x; u < 4160; u += gridDim.x) final_unit(p, u);
    } else {
      const int l = (ph - 1) >> 2, sub = (ph - 1) & 3;
      if (sub == 0) {
        g8::EpiIn8 e{p.proj, p.sumsq + (size_t)l * T_TOK * 16};
        g8::Order S{NMT * 21, 21};
        g8::gemm_phase8(lds, p.xb, 1024, 1 << 30, 0, p.WinT + (size_t)l * 5376 * 1024, 1024, S, e);
      } else if (sub == 1) {
        phase_mixer(lds, p, l);
      } else if (sub == 2) {
        g8::EpiGlu8 e{p.proj, p.b_glu + l * 1024, p.xb};
        g8::Order S{NMT * 4, 4};
        g8::gemm_phase8(lds, p.xb, 1024, 1 << 30, 0, p.WgluT + (size_t)l * 1024 * 1024, 1024, S, e);
        for (int u = gridDim.x - 1 - blockIdx.x; u < 1040; u += gridDim.x) norm_unit(p, u);
      } else {
        g8::EpiOut8 e{l == 0 ? p.x_prompt : p.out, l == 0 ? p.x_sample : (p.out + (size_t)TP * 1024), p.out,
                      l == 3 ? (bf16_t*)nullptr : p.xb, p.sumsq + (size_t)(l + 1) * T_TOK * 16};
        g8::Order S{NMT * 4, 4};
        g8::gemm_phase8(lds, p.proj, LDP, 16, 3072, p.WoutT + (size_t)l * 1024 * 2048, 2048, S, e);
      }
    }
    if (ph + 1 < p.phase_end) grid_barrier(grid, p.bar, (unsigned)(ph - p.phase_begin + 1) * gridDim.x);
  }
}

extern "C" void kernel_launch(void* const* d_in, const int* in_sizes, int n_in, void* d_out, int out_size, void* d_ws, size_t ws_size,
                              hipStream_t stream) {
  static int grid_blocks = 0;
  if (!grid_blocks) {
    int dev = 0, cus = 0, per_cu = 0;
    hipGetDevice(&dev);
    hipDeviceGetAttribute(&cus, hipDeviceAttributeMultiprocessorCount, dev);
    hipOccupancyMaxActiveBlocksPerMultiprocessor(&per_cu, mega, NTHREADS, 0);
    if (per_cu < 1) per_cu = 1;
    if (per_cu > 1) per_cu = 1;
    grid_blocks = cus * per_cu;
  }
  Params p{};
  const float* const* in = (const float* const*)d_in;
  p.x_prompt = in[0]; p.x_sample = in[1]; p.st_conv = in[2]; p.st_ssd = in[3]; p.st_s5re = in[4]; p.st_s5im = in[5];
  p.norm_g = in[6]; p.w_in = in[7]; p.conv_w = in[8]; p.conv_b = in[9]; p.dt_bias = in[10]; p.a_log = in[11]; p.d_ssd = in[12];
  p.ssd_norm_g = in[13]; p.lam_re = in[14]; p.lam_im = in[15]; p.log_dt = in[16]; p.b_re = in[17]; p.b_im = in[18];
  p.c_re = in[19]; p.c_im = in[20]; p.d_s5 = in[21]; p.w_glu = in[22]; p.b_glu = in[23]; p.w_out = in[24]; p.final_g = in[25];
  p.out = (float*)d_out;
  unsigned char* ws = (unsigned char*)d_ws;
  size_t off = 0;
  auto take = [&](size_t bytes) { unsigned char* r = ws + off; off += (bytes + 1023) & ~(size_t)1023; return r; };
  p.xb = (bf16_t*)take((size_t)T_TOK * 1024 * 2);
  p.proj = (bf16_t*)take((size_t)T_TOK * LDP * 2);
  p.WinT = (bf16_t*)take((size_t)4 * 5376 * 1024 * 2);
  p.WgluT = (bf16_t*)take((size_t)4 * 1024 * 1024 * 2);
  p.WoutT = (bf16_t*)take((size_t)4 * 1024 * 2048 * 2);
  p.BbT = (bf16_t*)take((size_t)256 * 2048 * 2);
  p.CmT = (bf16_t*)take((size_t)256 * 2048 * 2);
  p.sumsq = (float*)take((size_t)5 * T_TOK * 16 * 4);
  p.ssqa = (float*)take((size_t)T_TOK * 16 * 4);
  p.lamb = (float*)take((size_t)256 * 64 * 2 * 4);
  p.bar = (unsigned*)take(1024);
  hipMemsetAsync(p.bar, 0, 1024, stream);
  if (off > ws_size) { fprintf(stderr, "workspace too small: need %zu have %zu\n", off, ws_size); return; }
  p.phase_begin = 0; p.phase_end = 18;
  void* args[] = {&p};
  hipError_t e = hipLaunchCooperativeKernel((void*)mega, dim3(grid_blocks), dim3(NTHREADS), args, 0, stream);
  if (e != hipSuccess) fprintf(stderr, "cooperative launch failed: %s (grid %d)\n", hipGetErrorString(e), grid_blocks);
}
```

```cpp
#include <hip/hip_runtime.h>
#include <hip/hip_cooperative_groups.h>
#include <cstdio>
namespace cg = cooperative_groups;

#define LAS __attribute__((address_space(3)))
typedef unsigned short bf16_t;
typedef short bf16x8 __attribute__((ext_vector_type(8)));
typedef float f32x4 __attribute__((ext_vector_type(4)));
typedef float f32x16 __attribute__((ext_vector_type(16)));
typedef unsigned u32x4 __attribute__((ext_vector_type(4)));
typedef unsigned u32x2 __attribute__((ext_vector_type(2)));

constexpr int T_TOK = 33280, TP = 32768, NMT = 130;
constexpr int LDP = 5376;
constexpr int C_ZA = 0, C_XBC = 1024, C_U = 3072, C_ZB = 4096, C_DT = 5120;
constexpr int NTHREADS = 512;
constexpr int LDS_BYTES = 139264;

constexpr size_t O_Y = 0, O_CONVP = 34078720, O_SSDP = 34471936, O_S5REP = 42860544, O_S5IMP = 43122688,
                 O_CONVS = 43384832, O_SSDS = 43581440, O_S5RES = 47775744, O_S5IMS = 47906816;

struct Params {
  const float *x_prompt, *x_sample, *st_conv, *st_ssd, *st_s5re, *st_s5im;
  const float *norm_g, *w_in, *conv_w, *conv_b, *dt_bias, *a_log, *d_ssd, *ssd_norm_g;
  const float *lam_re, *lam_im, *log_dt, *b_re, *b_im, *c_re, *c_im, *d_s5, *w_glu, *b_glu, *w_out, *final_g;
  float* out;
  bf16_t *xb, *proj, *WinT, *WgluT, *WoutT, *BbT, *CmT;
  float *sumsq, *ssqa, *lamb;
  unsigned* bar;
  int phase_begin, phase_end;
};

__device__ __forceinline__ float bf2f(unsigned short v) { return __uint_as_float(((unsigned)v) << 16); }
__device__ __forceinline__ float lo_f(unsigned w) { return __uint_as_float(w << 16); }
__device__ __forceinline__ float hi_f(unsigned w) { return __uint_as_float(w & 0xffff0000u); }
__device__ __forceinline__ unsigned pk2(float lo, float hi) { unsigned r; asm("v_cvt_pk_bf16_f32 %0, %1, %2" : "=v"(r) : "v"(lo), "v"(hi)); return r; }
__device__ __forceinline__ float sigm(float x) { return __builtin_amdgcn_rcpf(1.f + __expf(-x)); }
__device__ __forceinline__ float siluf(float x) { return x * sigm(x); }
__device__ __forceinline__ float gelu_tanh(float x) { const float z = 0.7978845608028654f * (x + 0.044715f * x * x * x); return x * sigm(2.f * z); }
__device__ __forceinline__ f32x4 mfma16(bf16x8 a, bf16x8 b, f32x4 c) { return __builtin_amdgcn_mfma_f32_16x16x32_bf16(a, b, c, 0, 0, 0); }
#define WAIT_V0() asm volatile("s_waitcnt vmcnt(0)" ::: "memory")
#define LDS_BARRIER() asm volatile("s_waitcnt lgkmcnt(0)\n\ts_barrier" ::: "memory")
__device__ __forceinline__ int otid() { int t = threadIdx.x; asm volatile("" : "+v"(t)); return t; }

__device__ __forceinline__ void stage_rc(int b, int& R, int& C) {
  const int st = b >> 10, sb = b & 1023, swz = sb ^ (((sb >> 9) & 1) << 5);
  R = (st >> 1) * 16 + swz / 64;
  C = (st & 1) * 32 + (swz % 64) / 2;
}

__device__ __forceinline__ int xcd_remap(int u) {
  const int G = gridDim.x, i = u / G, blk = u % G, per = G >> 3;
  if (G & 7) return u;
  return (i * 8 + (blk & 7)) * per + (blk >> 3);
}
__device__ __forceinline__ void tile_map(int u, int nN, int& pm, int& pn) {
  const int nig = 8 * nN, gid = u / nig, fm = gid * 8, rem = u % nig;
  const int gsz = (NMT - fm) < 8 ? (NMT - fm) : 8;
  pm = fm + rem % gsz; pn = rem / gsz;
}

namespace g8 {
constexpr int HTB = 128 * 64 * 2;
__device__ __forceinline__ int lds_byte(int r, int c) { const int st = (r >> 4) * 2 + (c >> 5), rr = r & 15, cc = c & 31, ob = rr * 64 + cc * 2; return st * 1024 + (ob ^ (((ob >> 9) & 1) << 5)); }
struct Unit { int pm, pn; };
struct Order {
  int ntiles, nN;
  __device__ __forceinline__ bool next(int i, Unit& u) const {
    const int w = xcd_remap((int)blockIdx.x + i * (int)gridDim.x);
    if (w >= ntiles) return false;
    tile_map(w, nN, u.pm, u.pn); return true;
  }
};
__device__ __forceinline__ int perm32(int rho) { const int n = rho >> 4, i = rho & 15; return 8 * (i >> 2) + 4 * n + (i & 3); }
struct EpiIn8 {
  static constexpr bool PERM = true;
  bf16_t* proj; const float* sumsq;
  __device__ __forceinline__ void operator()(const f32x4 (&acc)[2][2][4][2], const Unit& u, int wr, int wc, int fr, int fq) const {
    const int row0 = u.pm * 256 + wr * 64 + fr, col0 = u.pn * 256 + wc * 32 + fq * 8;
#pragma unroll
    for (int ai = 0; ai < 2; ++ai)
#pragma unroll
      for (int m = 0; m < 4; ++m) {
        asm volatile("" ::: "memory");
        const int row = row0 + ai * 128 + m * 16;
        const f32x4* sp = (const f32x4*)(sumsq + (size_t)row * 16);
        const f32x4 s0 = sp[0], s1 = sp[1], s2 = sp[2], s3 = sp[3];
        const float ss = ((s0[0] + s0[1]) + (s0[2] + s0[3])) + ((s1[0] + s1[1]) + (s1[2] + s1[3])) +
                         ((s2[0] + s2[1]) + (s2[2] + s2[3])) + ((s3[0] + s3[1]) + (s3[2] + s3[3]));
        const float rs = rsqrtf(ss * (1.f / 1024.f) + 1e-6f);
        bf16_t* rp = proj + (size_t)row * LDP + col0;
#pragma unroll
        for (int bj = 0; bj < 2; ++bj) {
          const f32x4 v0 = acc[ai][bj][m][0] * rs, v1 = acc[ai][bj][m][1] * rs;
          *(u32x4*)(rp + bj * 128) = (u32x4){pk2(v0[0], v0[1]), pk2(v0[2], v0[3]), pk2(v1[0], v1[1]), pk2(v1[2], v1[3])};
        }
      }
  }
};
struct EpiGlu8 {
  static constexpr bool PERM = true;
  bf16_t* proj; const float* bglu; const bf16_t* ys;
  __device__ __forceinline__ void operator()(const f32x4 (&acc)[2][2][4][2], const Unit& u, int wr, int wc, int fr, int fq) const {
    const int row0 = u.pm * 256 + wr * 64 + fr, col0 = u.pn * 256 + wc * 32 + fq * 8;
#pragma unroll
    for (int ai = 0; ai < 2; ++ai)
#pragma unroll
      for (int m = 0; m < 4; ++m) {
        asm volatile("" ::: "memory");
        const int row = row0 + ai * 128 + m * 16;
        bf16_t* base = proj + (size_t)row * LDP;
#pragma unroll
        for (int bj = 0; bj < 2; ++bj) {
          const int col = col0 + bj * 128;
          const f32x4 g0 = acc[ai][bj][m][0] + *(const f32x4*)(bglu + col), g1 = acc[ai][bj][m][1] + *(const f32x4*)(bglu + col + 4);
          const u32x4 a = *(const u32x4*)(ys + (size_t)row * 1024 + col);
          const u32x4 z = *(const u32x4*)(base + C_ZB + col);
          u32x4 o;
          o[0] = pk2(lo_f(a[0]) * sigm(g0[0]) * siluf(lo_f(z[0])), hi_f(a[0]) * sigm(g0[1]) * siluf(hi_f(z[0])));
          o[1] = pk2(lo_f(a[1]) * sigm(g0[2]) * siluf(lo_f(z[1])), hi_f(a[1]) * sigm(g0[3]) * siluf(hi_f(z[1])));
          o[2] = pk2(lo_f(a[2]) * sigm(g1[0]) * siluf(lo_f(z[2])), hi_f(a[2]) * sigm(g1[1]) * siluf(hi_f(z[2])));
          o[3] = pk2(lo_f(a[3]) * sigm(g1[2]) * siluf(lo_f(z[3])), hi_f(a[3]) * sigm(g1[3]) * siluf(hi_f(z[3])));
          *(u32x4*)(base + C_ZB + col) = o;
        }
      }
  }
};
struct EpiOut8 {
  static constexpr bool PERM = true;
  const float *xin_p, *xin_s; float* xout; bf16_t* xb; float* ssq_next;
  __device__ __forceinline__ void operator()(const f32x4 (&acc)[2][2][4][2], const Unit& u, int wr, int wc, int fr, int fq) const {
    const int row0 = u.pm * 256 + wr * 64 + fr, col0 = u.pn * 256 + wc * 32 + fq * 8;
#pragma unroll
    for (int ai = 0; ai < 2; ++ai)
#pragma unroll
      for (int m = 0; m < 4; ++m) {
        asm volatile("" ::: "memory");
        const int row = row0 + ai * 128 + m * 16;
        const float* xr = (row < TP) ? (xin_p + (size_t)row * 1024) : (xin_s + (size_t)(row - TP) * 1024);
        float s = 0.f;
#pragma unroll
        for (int bj = 0; bj < 2; ++bj) {
          const int col = col0 + bj * 128;
          const f32x4 v0 = acc[ai][bj][m][0] + *(const f32x4*)(xr + col), v1 = acc[ai][bj][m][1] + *(const f32x4*)(xr + col + 4);
          *(f32x4*)(xout + (size_t)row * 1024 + col) = v0;
          *(f32x4*)(xout + (size_t)row * 1024 + col + 4) = v1;
          if (xb) *(u32x4*)(xb + (size_t)row * 1024 + col) = (u32x4){pk2(v0[0], v0[1]), pk2(v0[2], v0[3]), pk2(v1[0], v1[1]), pk2(v1[2], v1[3])};
          s += v0[0] * v0[0] + v0[1] * v0[1] + v0[2] * v0[2] + v0[3] * v0[3] + v1[0] * v1[0] + v1[1] * v1[1] + v1[2] * v1[2] + v1[3] * v1[3];
        }
        s += __shfl_xor(s, 16); s += __shfl_xor(s, 32);
        if (fq == 0) ssq_next[(size_t)row * 16 + u.pn * 4 + wc] = s;
      }
  }
};

template <class Epi>
__device__ __forceinline__ void gemm_phase8(LAS unsigned char* lds, const bf16_t* A, int lda, int segkt, int segoff, const bf16_t* Bt, int K,
                                            const Order& S, const Epi& E) {
  const int tid = otid(), wid = __builtin_amdgcn_readfirstlane(tid >> 6), lane = tid & 63, wr = wid >> 2, wc = wid & 3, fr = lane & 15, fq = lane >> 4;
  const int nt = K / 64;
  unsigned voffA[2], voffB[2];
#pragma unroll
  for (int i = 0; i < 2; ++i) { int R, C; stage_rc(tid * 16 + i * 8192, R, C); const int Rb = Epi::PERM ? ((R & ~31) + perm32(R & 31)) : R;
    voffA[i] = (unsigned)(R * lda + C) * 2u; voffB[i] = (unsigned)(Rb * K + C) * 2u; }
  const size_t kstep = 128;
  const size_t hstepA = (size_t)128 * lda * 2, tstepA = 2 * hstepA;
  const size_t hstepB = (size_t)128 * K * 2, tstepB = 2 * hstepB;
  const size_t segB = (size_t)segoff * 2;
#define G8_AK(kt) ((size_t)(kt) * 128 + (((kt) >= segkt) ? segB : (size_t)0))
  const unsigned ldsw = (unsigned)wid * 1024u;
  const int aoff = lds_byte(wr * 64 + fr, fq * 8), boff = lds_byte(wc * 32 + fr, fq * 8);
#define G8_SA(b, h) (((b) * 2 + (h)) * HTB)
#define G8_SB(b, h) ((4 + (b) * 2 + (h)) * HTB)
#define G8_STAGE(bufoff, gbase, voff) do { _Pragma("unroll") for (int _i = 0; _i < 2; ++_i) \
    __builtin_amdgcn_global_load_lds((const unsigned*)((const char*)(gbase) + (voff)[_i]), (LAS unsigned*)(lds + (bufoff) + ldsw + _i * 8192), 16, 0, 0); } while (0)
#define G8_LDA(dst, b, h) do { _Pragma("unroll") for (int m = 0; m < 4; ++m) _Pragma("unroll") for (int k = 0; k < 2; ++k) dst[m][k] = *(const LAS bf16x8*)(lds + G8_SA(b, h) + aoff + m * 2048 + k * 1024); } while (0)
#define G8_LDB(dst, b, h) do { _Pragma("unroll") for (int n = 0; n < 2; ++n) _Pragma("unroll") for (int k = 0; k < 2; ++k) dst[n][k] = *(const LAS bf16x8*)(lds + G8_SB(b, h) + boff + n * 2048 + k * 1024); } while (0)
#define G8_MMA(ai, bj, At, Bt_) do { __builtin_amdgcn_s_setprio(1); _Pragma("unroll") for (int m = 0; m < 4; ++m) _Pragma("unroll") for (int n = 0; n < 2; ++n) _Pragma("unroll") for (int k = 0; k < 2; ++k) \
    acc[ai][bj][m][n] = __builtin_amdgcn_mfma_f32_16x16x32_bf16(Bt_[n][k], At[m][k], acc[ai][bj][m][n], 0, 0, 0); __builtin_amdgcn_s_setprio(0); } while (0)
#define G8_WAIT_V(n) asm volatile("s_waitcnt vmcnt(" #n ")" ::: "memory")
#define G8_WAIT_L(n) asm volatile("s_waitcnt lgkmcnt(" #n ")" ::: "memory")
#define G8_BAR __builtin_amdgcn_s_barrier()
#define G8_SCHED __builtin_amdgcn_sched_barrier(0)
  Unit cur, nxt; int ui = 0;
  if (!S.next(0, cur)) return;
  f32x4 acc[2][2][4][2];
#pragma unroll
  for (int a = 0; a < 2; ++a)
#pragma unroll
    for (int b = 0; b < 2; ++b)
#pragma unroll
      for (int m = 0; m < 4; ++m)
#pragma unroll
        for (int n = 0; n < 2; ++n) acc[a][b][m][n] = (f32x4){0.f, 0.f, 0.f, 0.f};
  bf16x8 At[4][2], B0[2][2], B1[2][2];
  const char* cA = (const char*)A + (size_t)cur.pm * tstepA; const char* cB = (const char*)Bt + (size_t)cur.pn * tstepB;
  G8_STAGE(G8_SB(0, 0), cB, voffB); G8_STAGE(G8_SA(0, 0), cA, voffA); G8_STAGE(G8_SB(0, 1), cB + hstepB, voffB); G8_STAGE(G8_SA(0, 1), cA + hstepA, voffA);
  if (wr == 1) G8_BAR;
  G8_WAIT_V(4); G8_BAR;
  G8_STAGE(G8_SB(1, 0), cB + kstep, voffB); G8_STAGE(G8_SA(1, 0), cA + G8_AK(1), voffA); G8_STAGE(G8_SB(1, 1), cB + hstepB + kstep, voffB);
  G8_WAIT_V(6); G8_BAR;
  for (;;) {
    const bool has_next = S.next(ui + 1, nxt);
    const char* nA = has_next ? (const char*)A + (size_t)nxt.pm * tstepA : cA; const char* nB = has_next ? (const char*)Bt + (size_t)nxt.pn * tstepB : cB;
    for (int t = 0; t < nt; t += 2) {
      const bool last = (t == nt - 2);
      const char* a1 = cA + G8_AK(t + 1);
      const char* a2 = last ? nA : cA + G8_AK(t + 2); const char* b2 = last ? nB : cB + (size_t)(t + 2) * kstep;
      const char* a3 = last ? nA + G8_AK(1) : cA + G8_AK(t + 3); const char* b3 = b2 + kstep;
      G8_LDB(B0, 0, 0); G8_SCHED; G8_LDA(At, 0, 0); G8_STAGE(G8_SA(1, 1), a1 + hstepA, voffA);
      G8_WAIT_L(8); G8_BAR; G8_WAIT_L(0); G8_MMA(0, 0, At, B0); G8_BAR; G8_SCHED;
      G8_LDB(B1, 0, 1); G8_STAGE(G8_SB(0, 0), b2, voffB);
      G8_BAR; G8_WAIT_L(0); G8_MMA(0, 1, At, B1); G8_BAR;
      G8_LDA(At, 0, 1); G8_STAGE(G8_SA(0, 0), a2, voffA);
      G8_BAR; G8_WAIT_L(0); G8_MMA(1, 0, At, B0); G8_BAR; G8_SCHED;
      G8_STAGE(G8_SB(0, 1), b2 + hstepB, voffB);
      G8_WAIT_V(6); G8_BAR; G8_MMA(1, 1, At, B1); G8_BAR;
      G8_LDB(B0, 1, 0); G8_SCHED; G8_LDA(At, 1, 0); G8_STAGE(G8_SA(0, 1), a2 + hstepA, voffA);
      G8_WAIT_L(8); G8_BAR; G8_WAIT_L(0); G8_MMA(0, 0, At, B0); G8_BAR; G8_SCHED;
      G8_LDB(B1, 1, 1); G8_STAGE(G8_SB(1, 0), b3, voffB);
      G8_BAR; G8_WAIT_L(0); G8_MMA(0, 1, At, B1); G8_BAR;
      G8_LDA(At, 1, 1); G8_STAGE(G8_SA(1, 0), a3, voffA);
      G8_BAR; G8_WAIT_L(0); G8_MMA(1, 0, At, B0); G8_BAR; G8_SCHED;
      G8_STAGE(G8_SB(1, 1), b3 + hstepB, voffB);
      G8_WAIT_V(6); G8_BAR; G8_MMA(1, 1, At, B1); G8_BAR;
    }
    E(acc, cur, wr, wc, fr, fq);
    if (!has_next) break;
#pragma unroll
    for (int a = 0; a < 2; ++a)
#pragma unroll
      for (int b = 0; b < 2; ++b)
#pragma unroll
        for (int m = 0; m < 4; ++m)
#pragma unroll
          for (int n = 0; n < 2; ++n) acc[a][b][m][n] = (f32x4){0.f, 0.f, 0.f, 0.f};
    cur = nxt; cA = nA; cB = nB; ++ui;
  }
  G8_WAIT_V(0);
  if (wr == 0) G8_BAR;
  G8_BAR;
#undef G8_AK
#undef G8_SA
#undef G8_SB
#undef G8_STAGE
#undef G8_LDA
#undef G8_LDB
#undef G8_MMA
#undef G8_WAIT_V
#undef G8_WAIT_L
#undef G8_BAR
#undef G8_SCHED
}
}

__device__ void xrow_unit(const Params& p, int unit) {
  const int tid_ = otid(); const int wid = tid_ >> 6, lane = tid_ & 63;
  f32x4 v[2][4];
#pragma unroll
  for (int r = 0; r < 2; ++r) {
    const int row = unit * 16 + r * 8 + wid;
    const float* src = (row < TP) ? (p.x_prompt + (size_t)row * 1024) : (p.x_sample + (size_t)(row - TP) * 1024);
#pragma unroll
    for (int i = 0; i < 4; ++i) v[r][i] = *(const f32x4*)(src + i * 256 + lane * 4);
  }
#pragma unroll
  for (int r = 0; r < 2; ++r) {
    const int row = unit * 16 + r * 8 + wid;
    float s = 0.f;
#pragma unroll
    for (int i = 0; i < 4; ++i) {
      const f32x4 x = v[r][i];
      s += x[0] * x[0] + x[1] * x[1] + x[2] * x[2] + x[3] * x[3];
      u32x2 o; o.x = pk2(x[0], x[1]); o.y = pk2(x[2], x[3]);
      *(u32x2*)(p.xb + (size_t)row * 1024 + i * 256 + lane * 4) = o;
    }
#pragma unroll
    for (int o = 32; o >= 1; o >>= 1) s += __shfl_xor(s, o);
    if (lane < 16) p.sumsq[(size_t)row * 16 + lane] = (lane == 0) ? s : 0.f;
  }
}

__device__ void transpose_unit(LAS unsigned char* lds, const float* src, int ldsrc, const float* scale, int nscale,
                               bf16_t* dst, int ldd, int kt, int ntile, int mode) {
  LAS float* tl = (LAS float*)lds;
  const int tid = otid();
  const int k0 = kt * 64, n0 = ntile * 64;
#pragma unroll
  for (int i = 0; i < 8; ++i) {
    const int e = tid + i * 512, kk = e >> 6, nn = e & 63;
    const int np = n0 + nn;
    int sc = np;
    if (mode == 0) { sc = (np < 3072) ? np : (np < 5120) ? (np + 16) : (np < 5136) ? (np - 5120 + 3072) : -1; }
    float v = 0.f;
    if (sc >= 0) {
      v = src[(size_t)(k0 + kk) * ldsrc + sc];
      if (scale && (k0 + kk) < nscale) v *= scale[k0 + kk];
    }
    tl[kk * 65 + nn] = v;
  }
  __syncthreads();
#pragma unroll
  for (int i = 0; i < 4; ++i) {
    const int e = tid + i * 512, nn = e >> 5, kk = (e & 31) * 2;
    const unsigned o = pk2(tl[kk * 65 + nn], tl[(kk + 1) * 65 + nn]);
    *(unsigned*)(dst + (size_t)(n0 + nn) * ldd + k0 + kk) = o;
  }
  __syncthreads();
}

__device__ __forceinline__ double exp_d(double x) {
  const double k = rint(x * 1.4426950408889634);
  const double r = fma(-k, 0.6931471805599453, x) - k * 2.3190468138462996e-17;
  double s = 1.0 / 6227020800.0;
  s = fma(s, r, 1.0 / 479001600.0); s = fma(s, r, 1.0 / 39916800.0); s = fma(s, r, 1.0 / 3628800.0);
  s = fma(s, r, 1.0 / 362880.0); s = fma(s, r, 1.0 / 40320.0); s = fma(s, r, 1.0 / 5040.0);
  s = fma(s, r, 1.0 / 720.0); s = fma(s, r, 1.0 / 120.0); s = fma(s, r, 1.0 / 24.0);
  s = fma(s, r, 1.0 / 6.0); s = fma(s, r, 0.5); s = fma(s, r, 1.0); s = fma(s, r, 1.0);
  return ldexp(s, (int)k);
}
__device__ __forceinline__ void sincos_d(double x, double& sn, double& cs) {
  const double k = rint(x * 0.6366197723675814);
  double r = fma(-k, 1.5707963267948966, x); r = fma(-k, 6.123233995736766e-17, r);
  const int q = ((int)k) & 3;
  const double r2 = r * r;
  double sp = 1.0 / 1307674368000.0;
  sp = fma(sp, r2, -1.0 / 6227020800.0); sp = fma(sp, r2, 1.0 / 39916800.0); sp = fma(sp, r2, -1.0 / 362880.0);
  sp = fma(sp, r2, 1.0 / 5040.0); sp = fma(sp, r2, -1.0 / 120.0); sp = fma(sp, r2, 1.0 / 6.0);
  sp = r - r * r2 * sp;
  double cp = 1.0 / 20922789888000.0;
  cp = fma(cp, r2, -1.0 / 87178291200.0); cp = fma(cp, r2, 1.0 / 479001600.0); cp = fma(cp, r2, -1.0 / 3628800.0);
  cp = fma(cp, r2, 1.0 / 40320.0); cp = fma(cp, r2, -1.0 / 720.0); cp = fma(cp, r2, 1.0 / 24.0); cp = fma(cp, r2, -0.5);
  cp = fma(cp, r2, 1.0);
  sn = (q == 0) ? sp : (q == 1) ? cp : (q == 2) ? -sp : -cp;
  cs = (q == 0) ? cp : (q == 1) ? -sp : (q == 2) ? -cp : sp;
}

__device__ void s5prep_unit(LAS unsigned char* lds, const Params& p, int l, int g) {
  LAS float* cf = (LAS float*)lds;
  const int tid = otid();
  const int lg = l * 64 + g;
  if (tid < 64) {
    const double dt = exp_d((double)p.log_dt[lg]);
    const double lr = (double)p.lam_re[lg * 64 + tid], li = (double)p.lam_im[lg * 64 + tid];
    const double e = exp_d(lr * dt);
    double sn, cs; sincos_d(li * dt, sn, cs);
    const double lbr = e * cs, lbi = e * sn;
    const double nr = lbr - 1.0, ni = lbi;
    const double den = lr * lr + li * li;
    const double cr = (nr * lr + ni * li) / den, ci = (ni * lr - nr * li) / den;
    p.lamb[(size_t)(lg * 64 + tid) * 2 + 0] = (float)lbr;
    p.lamb[(size_t)(lg * 64 + tid) * 2 + 1] = (float)lbi;
    cf[tid * 2 + 0] = (float)cr; cf[tid * 2 + 1] = (float)ci;
  }
  __syncthreads();
#pragma unroll
  for (int i = 0; i < 4; ++i) {
    const int idx = tid * 4 + i;
    {
      const int pp = idx >> 4, c = idx & 15, st = pp & 63;
      const float br = p.b_re[((size_t)lg * 64 + st) * 16 + c], bi = p.b_im[((size_t)lg * 64 + st) * 16 + c];
      const float cr = cf[st * 2], ci = cf[st * 2 + 1];
      const float v = (pp < 64) ? (cr * br - ci * bi) : (cr * bi + ci * br);
      p.BbT[(size_t)lg * 2048 + idx] = (bf16_t)(pk2(v, v) & 0xffffu);
    }
    {
      const int c = idx >> 7, pp = idx & 127, st = pp & 63;
      const float v = (pp < 64) ? p.c_re[((size_t)lg * 16 + c) * 64 + st] : -p.c_im[((size_t)lg * 16 + c) * 64 + st];
      p.CmT[(size_t)lg * 2048 + idx] = (bf16_t)(pk2(v, v) & 0xffffu);
    }
  }
  __syncthreads();
}

__device__ void phase_prep(LAS unsigned char* lds, const Params& p) {
  constexpr int U_X = 2080, U_WIN = 5376, U_WGLU = 1024, U_WOUT = 2048, U_S5 = 256;
  constexpr int TOTAL = U_X + U_WIN + U_WGLU + U_WOUT + U_S5;
  for (int u = blockIdx.x; u < TOTAL; u += gridDim.x) {
    int idx = u;
    if (idx < U_X) { xrow_unit(p, idx); continue; }
    idx -= U_X;
    if (idx < U_WIN) {
      const int l = idx / 1344, r = idx % 1344, ntile = r / 16, kt = r % 16;
      transpose_unit(lds, p.w_in + (size_t)l * 1024 * 5136, 5136, p.norm_g + l * 1024, 1024,
                     p.WinT + (size_t)l * 5376 * 1024, 1024, kt, ntile, 0);
      continue;
    }
    idx -= U_WIN;
    if (idx < U_WGLU) {
      const int l = idx / 256, r = idx % 256, ntile = r / 16, kt = r % 16;
      transpose_unit(lds, p.w_glu + (size_t)l * 1024 * 1024, 1024, nullptr, 0, p.WgluT + (size_t)l * 1024 * 1024, 1024, kt, ntile, 1);
      continue;
    }
    idx -= U_WGLU;
    if (idx < U_WOUT) {
      const int l = idx / 512, r = idx % 512, ntile = r / 32, kt = r % 32;
      transpose_unit(lds, p.w_out + (size_t)l * 2048 * 1024, 1024, p.ssd_norm_g + l * 1024, 1024,
                     p.WoutT + (size_t)l * 1024 * 2048, 2048, kt, ntile, 2);
      continue;
    }
    idx -= U_WOUT;
    s5prep_unit(lds, p, idx / 64, idx % 64);
  }
}

constexpr int CM_OFF = 0, BM_OFF = 17408, BMT_OFF = 34816, XDT_OFF = 53248, XW_OFF = 62464, MM_OFF = 71680,
              HB_OFF = 80896, XS_OFF = 98304, ACS_OFF = 107520, DTV_OFF = 115712, SSQ_OFF = 123904, CW_OFF = 124416;

__device__ __forceinline__ bf16x8 ldfrag(LAS unsigned char* lds, int off, int row, int stride, int col) {
  return *(const LAS bf16x8*)(lds + off + (row * stride + col) * 2);
}

template <int NCH>
__device__ __forceinline__ void conv_load_rows(unsigned (&rows)[7][NCH / 2], const bf16_t* proj, const float* stc, int tok0, int c, int s0, int ccol) {
#pragma unroll
  for (int i = 0; i < 7; ++i) {
    const int pos = c * 64 + s0 - 3 + i;
    if (pos >= 0) {
      const bf16_t* q = proj + (size_t)(tok0 + pos) * LDP + C_XBC + ccol;
      if (NCH == 8) { const u32x4 v = *(const u32x4*)q; rows[i][0] = v[0]; rows[i][1] = v[1]; rows[i][NCH / 2 - 2] = v[2]; rows[i][NCH / 2 - 1] = v[3]; }
      else rows[i][0] = *(const unsigned*)q;
    } else if (stc) {
      const float* sp = stc + (size_t)(3 + pos) * 2048 + ccol;
#pragma unroll
      for (int k = 0; k < NCH / 2; ++k) rows[i][k] = pk2(sp[2 * k], sp[2 * k + 1]);
    } else {
#pragma unroll
      for (int k = 0; k < NCH / 2; ++k) rows[i][k] = 0u;
    }
  }
}
template <int NCH>
__device__ __forceinline__ void conv_load_rows_fast(unsigned (&rows)[7][NCH / 2], const bf16_t* proj, int tok0, int c, int s0, int ccol) {
  const bf16_t* q0 = proj + (size_t)(tok0 + c * 64 + s0 - 3) * LDP + C_XBC + ccol;
#pragma unroll
  for (int i = 0; i < 7; ++i) {
    const bf16_t* q = q0 + (size_t)i * LDP;
    if (NCH == 8) { const u32x4 v = *(const u32x4*)q; rows[i][0] = v[0]; rows[i][1] = v[1]; rows[i][NCH / 2 - 2] = v[2]; rows[i][NCH / 2 - 1] = v[3]; }
    else rows[i][0] = *(const unsigned*)q;
  }
}
template <int NCH>
__device__ __forceinline__ void conv_store_row(LAS unsigned char* addr, const float* o) {
  if (NCH == 8) *(LAS u32x4*)addr = (u32x4){pk2(o[0], o[1]), pk2(o[2], o[3]), pk2(o[NCH - 4], o[NCH - 3]), pk2(o[NCH - 2], o[NCH - 1])};
  else *(LAS unsigned*)addr = pk2(o[0], o[1]);
}
template <int NCH>
__device__ __forceinline__ void conv_unit(LAS unsigned char* lds, const unsigned (&rows)[7][NCH / 2], const LAS float* wl,
                                          int oct, int chq, int s0, const LAS float* acs, const LAS float* dtv) {
  float o[4][NCH];
  float w[4][NCH], bs[NCH];
#pragma unroll
  for (int e = 0; e < NCH; ++e) { bs[e] = wl[32 + e];
#pragma unroll
    for (int k = 0; k < 4; ++k) w[k][e] = wl[k * 8 + e]; }
#pragma unroll
  for (int e = 0; e < NCH; ++e) {
    float xv[7];
#pragma unroll
    for (int i = 0; i < 7; ++i) xv[i] = (e & 1) ? hi_f(rows[i][e >> 1]) : lo_f(rows[i][e >> 1]);
#pragma unroll
    for (int j = 0; j < 4; ++j) o[j][e] = siluf(bs[e] + w[0][e] * xv[j] + w[1][e] * xv[j + 1] + w[2][e] * xv[j + 2] + w[3][e] * xv[j + 3]);
  }
  if (oct < 8) {
    float dts[4], wsc[4];
    const float aend = acs[63];
#pragma unroll
    for (int j = 0; j < 4; ++j) { dts[j] = dtv[s0 + j]; wsc[j] = dts[j] * __expf(aend - acs[s0 + j]); }
    const int p0 = oct * 8 + chq;
#pragma unroll
    for (int j = 0; j < 4; ++j) conv_store_row<NCH>(lds + XS_OFF + ((s0 + j) * 72 + p0) * 2, o[j]);
#pragma unroll
    for (int e = 0; e < NCH; ++e) {
      *(LAS u32x2*)(lds + XDT_OFF + ((p0 + e) * 72 + s0) * 2) = (u32x2){pk2(o[0][e] * dts[0], o[1][e] * dts[1]), pk2(o[2][e] * dts[2], o[3][e] * dts[3])};
      *(LAS u32x2*)(lds + XW_OFF + ((p0 + e) * 72 + s0) * 2) = (u32x2){pk2(o[0][e] * wsc[0], o[1][e] * wsc[1]), pk2(o[2][e] * wsc[2], o[3][e] * wsc[3])};
    }
  } else if (oct < 24) {
    const int n0 = (oct - 8) * 8 + chq;
#pragma unroll
    for (int j = 0; j < 4; ++j) conv_store_row<NCH>(lds + BM_OFF + ((s0 + j) * 136 + n0) * 2, o[j]);
#pragma unroll
    for (int e = 0; e < NCH; ++e) *(LAS u32x2*)(lds + BMT_OFF + ((n0 + e) * 72 + s0) * 2) = (u32x2){pk2(o[0][e], o[1][e]), pk2(o[2][e], o[3][e])};
  } else {
    const int n0 = (oct - 24) * 8 + chq;
#pragma unroll
    for (int j = 0; j < 4; ++j) conv_store_row<NCH>(lds + CM_OFF + ((s0 + j) * 136 + n0) * 2, o[j]);
  }
}

__device__ void ssd_item(LAS unsigned char* lds, const Params& p, int l, int b, int h, bool smp) {
  const int tid = otid(), wid = tid >> 6, lane = tid & 63, fr = lane & 15, fq = lane >> 4;
  const int g = h >> 2;
  const int tok0 = smp ? (TP + b * 64) : (b * 2048);
  const int nchunk = smp ? 1 : 32;
  const int NB = smp ? 8 : 16;
  bf16_t* proj = p.proj;
  LAS float* acs_all = (LAS float*)(lds + ACS_OFF);
  LAS float* dtv_all = (LAS float*)(lds + DTV_OFF);
  LAS float* ssq = (LAS float*)(lds + SSQ_OFF);
  const float dtb = p.dt_bias[l * 16 + h];
  const float Aneg = -__expf(p.a_log[l * 16 + h]);
  const float Dh = p.d_ssd[l * 16 + h];

  f32x4 hacc[4];
#pragma unroll
  for (int pt = 0; pt < 4; ++pt) {
    if (smp) hacc[pt] = *(const f32x4*)(p.st_ssd + ((((size_t)l * 8 + b) * 16 + h) * 64 + pt * 16 + fr) * 128 + wid * 16 + fq * 4);
    else hacc[pt] = (f32x4){0.f, 0.f, 0.f, 0.f};
  }

  const float* stc = smp ? (p.st_conv + ((size_t)l * 8 + b) * 3 * 2048) : nullptr;
  int octA, s0A;
  if (tid < 128) { octA = tid & 7; s0A = (tid >> 3) * 4; }
  else if (tid < 384) { const int i = tid - 128; octA = 8 + (i & 15); s0A = (i >> 4) * 4; }
  else { const int i = tid - 384; octA = 24 + (i & 15); s0A = (i >> 4) * 4; }
  const int jB = tid >> 2, octB = 24 + (jB & 15), s0B = (8 + (jB >> 4)) * 4, chqB = (tid & 3) * 2;
  const int cchA = (octA < 8) ? (h * 64 + octA * 8) : (octA < 24) ? (1024 + g * 128 + (octA - 8) * 8) : (1536 + g * 128 + (octA - 24) * 8);
  const int cchB = ((octB < 8) ? (h * 64 + octB * 8) : (octB < 24) ? (1024 + g * 128 + (octB - 8) * 8) : (1536 + g * 128 + (octB - 24) * 8)) + chqB;
  LAS float* cwl = (LAS float*)(lds + CW_OFF);
  {
    const float* cw = p.conv_w + (size_t)l * 4 * 2048;
    const float* cb = p.conv_b + (size_t)l * 2048;
    for (int idx = tid; idx < 1600; idx += 512) {
      const int oc = idx / 40, r = idx % 40, k = r >> 3, e = r & 7;
      const int cc = ((oc < 8) ? (h * 64 + oc * 8) : (oc < 24) ? (1024 + g * 128 + (oc - 8) * 8) : (1536 + g * 128 + (oc - 24) * 8)) + e;
      cwl[idx] = (k < 4) ? cw[k * 2048 + cc] : cb[cc];
    }
  }
  unsigned rowsA[7][4], rowsB[7][1];
  conv_load_rows<8>(rowsA, proj, stc, tok0, 0, s0A, cchA);
  conv_load_rows<2>(rowsB, proj, stc, tok0, 0, s0B, cchB);
  for (int c = wid; c < nchunk; c += 8) {
    const float dtr = bf2f(proj[(size_t)(tok0 + c * 64 + lane) * LDP + C_DT + h]);
    const float xx = dtr + dtb;
    const float dt = xx > 20.f ? xx : log1pf(__expf(xx));
    float cs = dt * Aneg;
#pragma unroll
    for (int o = 1; o < 64; o <<= 1) { const float v = __shfl_up(cs, o); if (lane >= o) cs += v; }
    acs_all[c * 64 + lane] = cs; dtv_all[c * 64 + lane] = dt;
  }
  LDS_BARRIER();
  for (int c = 0; c < nchunk; ++c) {
    const int ctok = tok0 + c * 64;
    const LAS float* acs = acs_all + c * 64;
    const LAS float* dtv = dtv_all + c * 64;
    u32x2 z4v[2];
    {
      const int lt_ = wid >> 1, ptb_ = (wid & 1) * 2;
#pragma unroll
      for (int q = 0; q < 2; ++q) z4v[q] = *(const u32x2*)(proj + (size_t)(ctok + lt_ * 16 + fr) * LDP + C_ZA + h * 64 + (ptb_ + q) * 16 + fq * 4);
    }
    conv_unit<8>(lds, rowsA, cwl + octA * 40, octA, 0, s0A, acs, dtv);
    conv_unit<2>(lds, rowsB, cwl + octB * 40 + chqB, octB, chqB, s0B, acs, dtv);
    if (c + 1 < nchunk) {
      conv_load_rows_fast<8>(rowsA, proj, tok0, c + 1, s0A, cchA);
      conv_load_rows_fast<2>(rowsB, proj, tok0, c + 1, s0B, cchB);
    }
#pragma unroll
    for (int pt = 0; pt < 4; ++pt)
      *(LAS u32x2*)(lds + HB_OFF + ((pt * 16 + fr) * 136 + wid * 16 + fq * 4) * 2) =
          (u32x2){pk2(hacc[pt][0], hacc[pt][1]), pk2(hacc[pt][2], hacc[pt][3])};
    LDS_BARRIER();
    const int lt = wid >> 1, ptb = (wid & 1) * 2;
    {
      const int st = wid >> 1, ltb = (wid & 1) * 2;
      bf16x8 bfr[4];
#pragma unroll
      for (int ks = 0; ks < 4; ++ks) bfr[ks] = ldfrag(lds, BM_OFF, st * 16 + fr, 136, ks * 32 + fq * 8);
#pragma unroll
      for (int q = 0; q < 2; ++q) {
        const int ltq = ltb + q;
        f32x4 a = (f32x4){0.f, 0.f, 0.f, 0.f};
#pragma unroll
        for (int ks = 0; ks < 4; ++ks) a = mfma16(bfr[ks], ldfrag(lds, CM_OFF, ltq * 16 + fr, 136, ks * 32 + fq * 8), a);
        const int l_ = ltq * 16 + fr;
        const float al = acs[l_];
        float mv[4];
#pragma unroll
        for (int r = 0; r < 4; ++r) { const int s_ = st * 16 + fq * 4 + r; const float ex = __expf(al - acs[s_]); mv[r] = (s_ <= l_) ? a[r] * ex : 0.f; }
        *(LAS u32x2*)(lds + MM_OFF + (l_ * 72 + st * 16 + fq * 4) * 2) = (u32x2){pk2(mv[0], mv[1]), pk2(mv[2], mv[3])};
      }
    }
    f32x4 accI[2];
    accI[0] = (f32x4){0.f, 0.f, 0.f, 0.f}; accI[1] = accI[0];
#pragma unroll
    for (int ks = 0; ks < 4; ++ks) {
      const bf16x8 cfr = ldfrag(lds, CM_OFF, lt * 16 + fr, 136, ks * 32 + fq * 8);
#pragma unroll
      for (int q = 0; q < 2; ++q) accI[q] = mfma16(ldfrag(lds, HB_OFF, (ptb + q) * 16 + fr, 136, ks * 32 + fq * 8), cfr, accI[q]);
    }
    {
      const float dec = __expf(acs[63]);
      bf16x8 bt[2];
#pragma unroll
      for (int ks = 0; ks < 2; ++ks) bt[ks] = ldfrag(lds, BMT_OFF, wid * 16 + fr, 72, ks * 32 + fq * 8);
#pragma unroll
      for (int pt = 0; pt < 4; ++pt) {
        hacc[pt] = hacc[pt] * dec;
#pragma unroll
        for (int ks = 0; ks < 2; ++ks) hacc[pt] = mfma16(bt[ks], ldfrag(lds, XW_OFF, pt * 16 + fr, 72, ks * 32 + fq * 8), hacc[pt]);
      }
    }
    LDS_BARRIER();
    {
      f32x4 accY[2];
      accY[0] = (f32x4){0.f, 0.f, 0.f, 0.f}; accY[1] = accY[0];
#pragma unroll
      for (int ks = 0; ks < 2; ++ks) {
        const bf16x8 mf = ldfrag(lds, MM_OFF, lt * 16 + fr, 72, ks * 32 + fq * 8);
#pragma unroll
        for (int q = 0; q < 2; ++q) accY[q] = mfma16(ldfrag(lds, XDT_OFF, (ptb + q) * 16 + fr, 72, ks * 32 + fq * 8), mf, accY[q]);
      }
      const int l_ = lt * 16 + fr;
      const float el = __expf(acs[l_]);
      float sq = 0.f;
#pragma unroll
      for (int q = 0; q < 2; ++q) {
        const int p0 = (ptb + q) * 16 + fq * 4;
        const u32x2 xs4 = *(const LAS u32x2*)(lds + XS_OFF + (l_ * 72 + p0) * 2);
        bf16_t* zp = proj + (size_t)(ctok + l_) * LDP + C_ZA + h * 64 + p0;
        const u32x2 z4 = z4v[q];
        const float y0 = (accY[q][0] + el * accI[q][0] + Dh * lo_f(xs4.x)) * siluf(lo_f(z4.x));
        const float y1 = (accY[q][1] + el * accI[q][1] + Dh * hi_f(xs4.x)) * siluf(hi_f(z4.x));
        const float y2 = (accY[q][2] + el * accI[q][2] + Dh * lo_f(xs4.y)) * siluf(lo_f(z4.y));
        const float y3 = (accY[q][3] + el * accI[q][3] + Dh * hi_f(xs4.y)) * siluf(hi_f(z4.y));
        sq += y0 * y0 + y1 * y1 + y2 * y2 + y3 * y3;
        *(u32x2*)zp = (u32x2){pk2(y0, y1), pk2(y2, y3)};
      }
      sq += __shfl_xor(sq, 16); sq += __shfl_xor(sq, 32);
      if (fq == 0) ssq[(wid & 1) * 64 + l_] = sq;
    }
    LDS_BARRIER();
    if (tid < 64) p.ssqa[(size_t)(ctok + tid) * 16 + h] = ssq[tid] + ssq[64 + tid];
  }
  {
    float* so = p.out + (smp ? O_SSDS : O_SSDP);
#pragma unroll
    for (int pt = 0; pt < 4; ++pt)
      *(f32x4*)(so + ((((size_t)l * NB + b) * 16 + h) * 64 + pt * 16 + fr) * 128 + wid * 16 + fq * 4) = hacc[pt];
    float* co = p.out + (smp ? O_CONVS : O_CONVP);
    const int L = smp ? 64 : 2048;
    for (int i = tid; i < 3 * 320; i += 512) {
      const int r = i / 320, cc = i % 320;
      if (cc >= 64 && (h & 3)) continue;
      const int ch = (cc < 64) ? (h * 64 + cc) : (cc < 192) ? (1024 + g * 128 + (cc - 64)) : (1536 + g * 128 + (cc - 192));
      co[(((size_t)l * NB + b) * 3 + r) * 2048 + ch] = bf2f(proj[(size_t)(tok0 + L - 3 + r) * LDP + C_XBC + ch]);
    }
  }
  __syncthreads();
}

__device__ __forceinline__ float fma_asm(float a, float b, float c) { float d; asm volatile("v_fma_f32 %0, %1, %2, %3" : "=v"(d) : "v"(a), "v"(b), "v"(c)); return d; }
__device__ void s5_seq(LAS unsigned char* lds, const Params& p, int l, int b, int g, bool smp) {
  const int tid_ = otid(); const int wid = tid_ >> 6, lane = tid_ & 63, fr = lane & 15, fq = lane >> 4;
  LAS float* buf = (LAS float*)(lds + wid * 16896);
  const int tok0 = smp ? (TP + b * 64) : (b * 2048);
  const int nblk = smp ? 2 : 64;
  const int NB = smp ? 8 : 16;
  const int lg = l * 64 + g;
  bf16x8 Bfrag[4], Cfrag[4];
#pragma unroll
  for (int nt = 0; nt < 4; ++nt) Bfrag[nt] = *(const bf16x8*)(p.BbT + ((size_t)lg * 128 + nt * 32 + (lane & 31)) * 16 + 8 * (lane >> 5));
#pragma unroll
  for (int ks = 0; ks < 4; ++ks) Cfrag[ks] = *(const bf16x8*)(p.CmT + ((size_t)lg * 16 + fr) * 128 + ks * 32 + fq * 8);
  const float lr = p.lamb[(size_t)(lg * 64 + lane) * 2], li = p.lamb[(size_t)(lg * 64 + lane) * 2 + 1];
  const float nli = -li;
  float hr = 0.f, hi = 0.f;
  if (smp) { hr = p.st_s5re[(((size_t)l * 8 + b) * 64 + g) * 64 + lane]; hi = p.st_s5im[(((size_t)l * 8 + b) * 64 + g) * 64 + lane]; }
  const f32x4 d4 = *(const f32x4*)(p.d_s5 + l * 1024 + g * 16 + fq * 4);
  const bf16_t* ubase = p.proj + C_U + g * 16;
  bf16x8 a_next = *(const bf16x8*)(ubase + (size_t)(tok0 + (lane & 31)) * LDP + 8 * (lane >> 5));
  for (int blk = 0; blk < nblk; ++blk) {
    const bf16x8 a = a_next;
    if (blk + 1 < nblk) a_next = *(const bf16x8*)(ubase + (size_t)(tok0 + (blk + 1) * 32 + (lane & 31)) * LDP + 8 * (lane >> 5));
    u32x2 u4v[2];
#pragma unroll
    for (int mt = 0; mt < 2; ++mt) u4v[mt] = *(const u32x2*)(ubase + (size_t)(tok0 + blk * 32 + mt * 16 + fr) * LDP + fq * 4);
    float bre[32], bim[32];
    {
      f32x16 d[4];
#pragma unroll
      for (int nt = 0; nt < 4; ++nt) {
        f32x16 z = {0.f, 0.f, 0.f, 0.f, 0.f, 0.f, 0.f, 0.f, 0.f, 0.f, 0.f, 0.f, 0.f, 0.f, 0.f, 0.f};
        d[nt] = __builtin_amdgcn_mfma_f32_32x32x16_bf16(a, Bfrag[nt], z, 0, 0, 0);
      }
#pragma unroll
      for (int r = 0; r < 16; ++r) {
        const int tA = (r & 3) + 8 * (r >> 2);
        const auto sr = __builtin_amdgcn_permlane32_swap(__float_as_uint(d[0][r]), __float_as_uint(d[1][r]), false, false);
        bre[tA] = __uint_as_float(sr[0]); bre[tA + 4] = __uint_as_float(sr[1]);
        const auto si = __builtin_amdgcn_permlane32_swap(__float_as_uint(d[2][r]), __float_as_uint(d[3][r]), false, false);
        bim[tA] = __uint_as_float(si[0]); bim[tA + 4] = __uint_as_float(si[1]);
      }
    }
#pragma unroll
    for (int t = 0; t < 32; ++t) {
      float nr = fma_asm(lr, hr, bre[t]); nr = fma_asm(nli, hi, nr);
      float ni = fma_asm(lr, hi, bim[t]); ni = fma_asm(li, hr, ni);
      hr = nr; hi = ni;
      buf[t * 132 + lane] = hr; buf[t * 132 + 64 + lane] = hi;
    }
    asm volatile("s_waitcnt lgkmcnt(0)" ::: "memory");
#pragma unroll
    for (int mt = 0; mt < 2; ++mt) {
      f32x4 acc = (f32x4){0.f, 0.f, 0.f, 0.f};
#pragma unroll
      for (int ks = 0; ks < 4; ++ks) {
        const LAS float* hp = buf + (mt * 16 + fr) * 132 + ks * 32 + fq * 8;
        const f32x4 h0 = *(const LAS f32x4*)hp, h1 = *(const LAS f32x4*)(hp + 4);
        u32x4 hw = (u32x4){pk2(h0[0], h0[1]), pk2(h0[2], h0[3]), pk2(h1[0], h1[1]), pk2(h1[2], h1[3])};
        bf16x8 hf = __builtin_bit_cast(bf16x8, hw);
        acc = mfma16(Cfrag[ks], hf, acc);
      }
      const size_t trow = (size_t)(tok0 + blk * 32 + mt * 16 + fr);
      const u32x2 u4 = u4v[mt];
      const float y0 = gelu_tanh(acc[0] + d4[0] * lo_f(u4.x));
      const float y1 = gelu_tanh(acc[1] + d4[1] * hi_f(u4.x));
      const float y2 = gelu_tanh(acc[2] + d4[2] * lo_f(u4.y));
      const float y3 = gelu_tanh(acc[3] + d4[3] * hi_f(u4.y));
      *(u32x2*)(p.xb + trow * 1024 + g * 16 + fq * 4) = (u32x2){pk2(y0, y1), pk2(y2, y3)};
    }
    asm volatile("" ::: "memory");
  }
  p.out[(smp ? O_S5RES : O_S5REP) + (((size_t)l * NB + b) * 64 + g) * 64 + lane] = hr;
  p.out[(smp ? O_S5IMS : O_S5IMP) + (((size_t)l * NB + b) * 64 + g) * 64 + lane] = hi;
}

__device__ void phase_mixer(LAS unsigned char* lds, const Params& p, int l) {
  const int wid = otid() >> 6;
  for (int u = blockIdx.x; u < 768; u += gridDim.x) {
    if (u < 256) ssd_item(lds, p, l, u >> 4, u & 15, false);
    else if (u < 512) { if (wid < 4) { const int seq = (u - 256) * 4 + wid; s5_seq(lds, p, l, seq >> 6, seq & 63, false); } }
    else if (u < 640) { const int v = u - 512; ssd_item(lds, p, l, v >> 4, v & 15, true); }
    else { if (wid < 4) { const int seq = (u - 640) * 4 + wid; s5_seq(lds, p, l, seq >> 6, seq & 63, true); } }
    __syncthreads();
  }
}

__device__ void norm_unit(const Params& p, int nu) {
  const int tid = otid();
  const int tok = nu * 32 + (tid >> 4), hh = tid & 15, gg = hh >> 2;
  const f32x4 s4 = *(const f32x4*)(p.ssqa + (size_t)tok * 16 + gg * 4);
  const float rs = rsqrtf((s4[0] + s4[1] + s4[2] + s4[3]) * (1.f / 256.f) + 1e-6f);
  bf16_t* q = p.proj + (size_t)tok * LDP + C_ZA + hh * 64;
#pragma unroll
  for (int i = 0; i < 8; ++i) {
    u32x4 v = *(u32x4*)(q + i * 8);
#pragma unroll
    for (int k = 0; k < 4; ++k) v[k] = pk2(lo_f(v[k]) * rs, hi_f(v[k]) * rs);
    *(u32x4*)(q + i * 8) = v;
  }
}

__device__ void final_unit(const Params& p, int unit) {
  const int tid_ = otid(); const int wid = tid_ >> 6, lane = tid_ & 63;
  const int row = unit * 8 + wid;
  const f32x4* sp = (const f32x4*)(p.sumsq + ((size_t)4 * T_TOK + row) * 16);
  const f32x4 s0 = sp[0], s1 = sp[1], s2 = sp[2], s3 = sp[3];
  const float ss = ((s0[0] + s0[1]) + (s0[2] + s0[3])) + ((s1[0] + s1[1]) + (s1[2] + s1[3])) +
                   ((s2[0] + s2[1]) + (s2[2] + s2[3])) + ((s3[0] + s3[1]) + (s3[2] + s3[3]));
  const float rs = rsqrtf(ss * (1.f / 1024.f) + 1e-6f);
  float* xr = p.out + (size_t)row * 1024;
#pragma unroll
  for (int i = 0; i < 4; ++i) {
    const int c = i * 256 + lane * 4;
    const f32x4 v = *(const f32x4*)(xr + c);
    const f32x4 gv = *(const f32x4*)(p.final_g + c);
    *(f32x4*)(xr + c) = v * rs * gv;
  }
}

__device__ __forceinline__ void grid_barrier(cg::grid_group& grid, unsigned* ctr, unsigned target) {
  asm volatile("s_waitcnt vmcnt(0) lgkmcnt(0)" ::: "memory");
  __syncthreads();
  if (target == gridDim.x) grid.sync();
  if (threadIdx.x == 0) {
    __builtin_amdgcn_fence(__ATOMIC_RELEASE, "agent");
    asm volatile("s_waitcnt vmcnt(0)" ::: "memory");
    __hip_atomic_fetch_add(ctr, 1u, __ATOMIC_RELAXED, __HIP_MEMORY_SCOPE_AGENT);
    while (__hip_atomic_load(ctr, __ATOMIC_RELAXED, __HIP_MEMORY_SCOPE_AGENT) < target) __builtin_amdgcn_s_sleep(1);
    __builtin_amdgcn_fence(__ATOMIC_ACQUIRE, "agent");
    asm volatile("s_waitcnt vmcnt(0)" ::: "memory");
  }
  __syncthreads();
}

__global__ void __launch_bounds__(NTHREADS) mega(Params p) {
  __shared__ __attribute__((aligned(1024))) unsigned char shm[LDS_BYTES];
  LAS unsigned char* lds = (LAS unsigned char*)shm;
  cg::grid_group grid = cg::this_grid();
  phase_prep(lds, p);
  grid_barrier(grid, p.bar, gridDim.x);
  for (int ph = 1; ph < p.phase_end; ++ph) {
    if (ph == 17) {
      for (int u = blockIdx.x; u < 4160; u += gridDim.x) final_unit(p, u);
    } else {
      const int l = (ph - 1) >> 2, sub = (ph - 1) & 3;
      if (sub == 0) {
        g8::EpiIn8 e{p.proj, p.sumsq + (size_t)l * T_TOK * 16};
        g8::Order S{NMT * 21, 21};
        g8::gemm_phase8(lds, p.xb, 1024, 1 << 30, 0, p.WinT + (size_t)l * 5376 * 1024, 1024, S, e);
      } else if (sub == 1) {
        phase_mixer(lds, p, l);
      } else if (sub == 2) {
        g8::EpiGlu8 e{p.proj, p.b_glu + l * 1024, p.xb};
        g8::Order S{NMT * 4, 4};
        g8::gemm_phase8(lds, p.xb, 1024, 1 << 30, 0, p.WgluT + (size_t)l * 1024 * 1024, 1024, S, e);
        for (int u = gridDim.x - 1 - blockIdx.x; u < 1040; u += gridDim.x) norm_unit(p, u);
      } else {
        g8::EpiOut8 e{l == 0 ? p.x_prompt : p.out, l == 0 ? p.x_sample : (p.out + (size_t)TP * 1024), p.out,
                      l == 3 ? (bf16_t*)nullptr : p.xb, p.sumsq + (size_t)(l + 1) * T_TOK * 16};
        g8::Order S{NMT * 4, 4};
        g8::gemm_phase8(lds, p.proj, LDP, 16, 3072, p.WoutT + (size_t)l * 1024 * 2048, 2048, S, e);
      }
    }
    if (ph + 1 < p.phase_end) grid_barrier(grid, p.bar, (unsigned)(ph - p.phase_begin + 1) * gridDim.x);
  }
}

extern "C" void kernel_launch(void* const* d_in, const int* in_sizes, int n_in, void* d_out, int out_size, void* d_ws, size_t ws_size,
                              hipStream_t stream) {
  static int grid_blocks = 0;
  if (!grid_blocks) {
    int dev = 0, cus = 0, per_cu = 0;
    hipGetDevice(&dev);
    hipDeviceGetAttribute(&cus, hipDeviceAttributeMultiprocessorCount, dev);
    hipOccupancyMaxActiveBlocksPerMultiprocessor(&per_cu, mega, NTHREADS, 0);
    if (per_cu < 1) per_cu = 1;
    if (per_cu > 1) per_cu = 1;
    grid_blocks = cus * per_cu;
  }
  Params p{};
  const float* const* in = (const float* const*)d_in;
  p.x_prompt = in[0]; p.x_sample = in[1]; p.st_conv = in[2]; p.st_ssd = in[3]; p.st_s5re = in[4]; p.st_s5im = in[5];
  p.norm_g = in[6]; p.w_in = in[7]; p.conv_w = in[8]; p.conv_b = in[9]; p.dt_bias = in[10]; p.a_log = in[11]; p.d_ssd = in[12];
  p.ssd_norm_g = in[13]; p.lam_re = in[14]; p.lam_im = in[15]; p.log_dt = in[16]; p.b_re = in[17]; p.b_im = in[18];
  p.c_re = in[19]; p.c_im = in[20]; p.d_s5 = in[21]; p.w_glu = in[22]; p.b_glu = in[23]; p.w_out = in[24]; p.final_g = in[25];
  p.out = (float*)d_out;
  unsigned char* ws = (unsigned char*)d_ws;
  size_t off = 0;
  auto take = [&](size_t bytes) { unsigned char* r = ws + off; off += (bytes + 1023) & ~(size_t)1023; return r; };
  p.xb = (bf16_t*)take((size_t)T_TOK * 1024 * 2);
  p.proj = (bf16_t*)take((size_t)T_TOK * LDP * 2);
  p.WinT = (bf16_t*)take((size_t)4 * 5376 * 1024 * 2);
  p.WgluT = (bf16_t*)take((size_t)4 * 1024 * 1024 * 2);
  p.WoutT = (bf16_t*)take((size_t)4 * 1024 * 2048 * 2);
  p.BbT = (bf16_t*)take((size_t)256 * 2048 * 2);
  p.CmT = (bf16_t*)take((size_t)256 * 2048 * 2);
  p.sumsq = (float*)take((size_t)5 * T_TOK * 16 * 4);
  p.ssqa = (float*)take((size_t)T_TOK * 16 * 4);
  p.lamb = (float*)take((size_t)256 * 64 * 2 * 4);
  p.bar = (unsigned*)take(1024);
  hipMemsetAsync(p.bar, 0, 1024, stream);
  if (off > ws_size) { fprintf(stderr, "workspace too small: need %zu have %zu\n", off, ws_size); return; }
  p.phase_begin = 0; p.phase_end = 18;
  void* args[] = {&p};
  hipError_t e = hipLaunchCooperativeKernel((void*)mega, dim3(grid_blocks), dim3(NTHREADS), args, 0, stream);
  if (e != hipSuccess) fprintf(stderr, "cooperative launch failed: %s (grid %d)\n", hipGetErrorString(e), grid_blocks);
}
```

```cpp
#include <hip/hip_runtime.h>
#include <hip/hip_cooperative_groups.h>
#include <cstdio>
namespace cg = cooperative_groups;

#define LAS __attribute__((address_space(3)))
typedef unsigned short bf16_t;
typedef short bf16x8 __attribute__((ext_vector_type(8)));
typedef float f32x4 __attribute__((ext_vector_type(4)));
typedef float f32x16 __attribute__((ext_vector_type(16)));
typedef unsigned u32x4 __attribute__((ext_vector_type(4)));
typedef unsigned u32x2 __attribute__((ext_vector_type(2)));

constexpr int T_TOK = 33280, TP = 32768, NMT = 130;
constexpr int LDP = 5376;
constexpr int C_ZA = 0, C_XBC = 1024, C_U = 3072, C_ZB = 4096, C_DT = 5120;
constexpr int NTHREADS = 512;
constexpr int LDS_BYTES = 139264;

constexpr size_t O_Y = 0, O_CONVP = 34078720, O_SSDP = 34471936, O_S5REP = 42860544, O_S5IMP = 43122688,
                 O_CONVS = 43384832, O_SSDS = 43581440, O_S5RES = 47775744, O_S5IMS = 47906816;

struct Params {
  const float *x_prompt, *x_sample, *st_conv, *st_ssd, *st_s5re, *st_s5im;
  const float *norm_g, *w_in, *conv_w, *conv_b, *dt_bias, *a_log, *d_ssd, *ssd_norm_g;
  const float *lam_re, *lam_im, *log_dt, *b_re, *b_im, *c_re, *c_im, *d_s5, *w_glu, *b_glu, *w_out, *final_g;
  float* out;
  bf16_t *xb, *proj, *WinT, *WgluT, *WoutT, *BbT, *CmT;
  float *sumsq, *ssqa, *lamb;
  unsigned* bar;
  int phase_begin, phase_end;
};

__device__ __forceinline__ float bf2f(unsigned short v) { return __uint_as_float(((unsigned)v) << 16); }
__device__ __forceinline__ float lo_f(unsigned w) { return __uint_as_float(w << 16); }
__device__ __forceinline__ float hi_f(unsigned w) { return __uint_as_float(w & 0xffff0000u); }
__device__ __forceinline__ unsigned pk2(float lo, float hi) { unsigned r; asm("v_cvt_pk_bf16_f32 %0, %1, %2" : "=v"(r) : "v"(lo), "v"(hi)); return r; }
__device__ __forceinline__ float sigm(float x) { return __builtin_amdgcn_rcpf(1.f + __expf(-x)); }
__device__ __forceinline__ float siluf(float x) { return x * sigm(x); }
__device__ __forceinline__ float gelu_tanh(float x) { const float z = 0.7978845608028654f * (x + 0.044715f * x * x * x); return x * sigm(2.f * z); }
__device__ __forceinline__ f32x4 mfma16(bf16x8 a, bf16x8 b, f32x4 c) { return __builtin_amdgcn_mfma_f32_16x16x32_bf16(a, b, c, 0, 0, 0); }
#define WAIT_V0() asm volatile("s_waitcnt vmcnt(0)" ::: "memory")
#define LDS_BARRIER() asm volatile("s_waitcnt lgkmcnt(0)\n\ts_barrier" ::: "memory")
__device__ __forceinline__ int otid() { int t = threadIdx.x; asm volatile("" : "+v"(t)); return t; }

__device__ __forceinline__ void stage_rc(int b, int& R, int& C) {
  const int st = b >> 10, sb = b & 1023, swz = sb ^ (((sb >> 9) & 1) << 5);
  R = (st >> 1) * 16 + swz / 64;
  C = (st & 1) * 32 + (swz % 64) / 2;
}

__device__ __forceinline__ int xcd_remap(int u) {
  const int G = gridDim.x, i = u / G, blk = u % G, per = G >> 3;
  if (G & 7) return u;
  return (i * 8 + (blk & 7)) * per + (blk >> 3);
}
__device__ __forceinline__ void tile_map(int u, int nN, int& pm, int& pn) {
  const int nig = 8 * nN, gid = u / nig, fm = gid * 8, rem = u % nig;
  const int gsz = (NMT - fm) < 8 ? (NMT - fm) : 8;
  pm = fm + rem % gsz; pn = rem / gsz;
}

namespace g8 {
constexpr int HTB = 128 * 64 * 2;
__device__ __forceinline__ int lds_byte(int r, int c) { const int st = (r >> 4) * 2 + (c >> 5), rr = r & 15, cc = c & 31, ob = rr * 64 + cc * 2; return st * 1024 + (ob ^ (((ob >> 9) & 1) << 5)); }
struct Unit { int pm, pn; };
struct Order {
  int ntiles, nN;
  __device__ __forceinline__ bool next(int i, Unit& u) const {
    const int w = xcd_remap((int)blockIdx.x + i * (int)gridDim.x);
    if (w >= ntiles) return false;
    tile_map(w, nN, u.pm, u.pn); return true;
  }
};
__device__ __forceinline__ int perm32(int rho) { const int n = rho >> 4, i = rho & 15; return 8 * (i >> 2) + 4 * n + (i & 3); }
struct EpiIn8 {
  static constexpr bool PERM = true;
  bf16_t* proj; const float* sumsq;
  __device__ __forceinline__ void operator()(const f32x4 (&acc)[2][2][4][2], const Unit& u, int wr, int wc, int fr, int fq) const {
    const int row0 = u.pm * 256 + wr * 64 + fr, col0 = u.pn * 256 + wc * 32 + fq * 8;
#pragma unroll
    for (int ai = 0; ai < 2; ++ai)
#pragma unroll
      for (int m = 0; m < 4; ++m) {
        asm volatile("" ::: "memory");
        const int row = row0 + ai * 128 + m * 16;
        const f32x4* sp = (const f32x4*)(sumsq + (size_t)row * 16);
        const f32x4 s0 = sp[0], s1 = sp[1], s2 = sp[2], s3 = sp[3];
        const float ss = ((s0[0] + s0[1]) + (s0[2] + s0[3])) + ((s1[0] + s1[1]) + (s1[2] + s1[3])) +
                         ((s2[0] + s2[1]) + (s2[2] + s2[3])) + ((s3[0] + s3[1]) + (s3[2] + s3[3]));
        const float rs = rsqrtf(ss * (1.f / 1024.f) + 1e-6f);
        bf16_t* rp = proj + (size_t)row * LDP + col0;
#pragma unroll
        for (int bj = 0; bj < 2; ++bj) {
          const f32x4 v0 = acc[ai][bj][m][0] * rs, v1 = acc[ai][bj][m][1] * rs;
          *(u32x4*)(rp + bj * 128) = (u32x4){pk2(v0[0], v0[1]), pk2(v0[2], v0[3]), pk2(v1[0], v1[1]), pk2(v1[2], v1[3])};
        }
      }
  }
};
struct EpiGlu8 {
  static constexpr bool PERM = true;
  bf16_t* proj; const float* bglu; const bf16_t* ys;
  __device__ __forceinline__ void operator()(const f32x4 (&acc)[2][2][4][2], const Unit& u, int wr, int wc, int fr, int fq) const {
    const int row0 = u.pm * 256 + wr * 64 + fr, col0 = u.pn * 256 + wc * 32 + fq * 8;
#pragma unroll
    for (int ai = 0; ai < 2; ++ai)
#pragma unroll
      for (int m = 0; m < 4; ++m) {
        asm volatile("" ::: "memory");
        const int row = row0 + ai * 128 + m * 16;
        bf16_t* base = proj + (size_t)row * LDP;
#pragma unroll
        for (int bj = 0; bj < 2; ++bj) {
          const int col = col0 + bj * 128;
          const f32x4 g0 = acc[ai][bj][m][0] + *(const f32x4*)(bglu + col), g1 = acc[ai][bj][m][1] + *(const f32x4*)(bglu + col + 4);
          const u32x4 a = *(const u32x4*)(ys + (size_t)row * 1024 + col);
          const u32x4 z = *(const u32x4*)(base + C_ZB + col);
          u32x4 o;
          o[0] = pk2(lo_f(a[0]) * sigm(g0[0]) * siluf(lo_f(z[0])), hi_f(a[0]) * sigm(g0[1]) * siluf(hi_f(z[0])));
          o[1] = pk2(lo_f(a[1]) * sigm(g0[2]) * siluf(lo_f(z[1])), hi_f(a[1]) * sigm(g0[3]) * siluf(hi_f(z[1])));
          o[2] = pk2(lo_f(a[2]) * sigm(g1[0]) * siluf(lo_f(z[2])), hi_f(a[2]) * sigm(g1[1]) * siluf(hi_f(z[2])));
          o[3] = pk2(lo_f(a[3]) * sigm(g1[2]) * siluf(lo_f(z[3])), hi_f(a[3]) * sigm(g1[3]) * siluf(hi_f(z[3])));
          *(u32x4*)(base + C_ZB + col) = o;
        }
      }
  }
};
struct EpiOut8 {
  static constexpr bool PERM = true;
  const float *xin_p, *xin_s; float* xout; bf16_t* xb; float* ssq_next;
  __device__ __forceinline__ void operator()(const f32x4 (&acc)[2][2][4][2], const Unit& u, int wr, int wc, int fr, int fq) const {
    const int row0 = u.pm * 256 + wr * 64 + fr, col0 = u.pn * 256 + wc * 32 + fq * 8;
#pragma unroll
    for (int ai = 0; ai < 2; ++ai)
#pragma unroll
      for (int m = 0; m < 4; ++m) {
        asm volatile("" ::: "memory");
        const int row = row0 + ai * 128 + m * 16;
        const float* xr = (row < TP) ? (xin_p + (size_t)row * 1024) : (xin_s + (size_t)(row - TP) * 1024);
        float s = 0.f;
#pragma unroll
        for (int bj = 0; bj < 2; ++bj) {
          const int col = col0 + bj * 128;
          const f32x4 v0 = acc[ai][bj][m][0] + *(const f32x4*)(xr + col), v1 = acc[ai][bj][m][1] + *(const f32x4*)(xr + col + 4);
          *(f32x4*)(xout + (size_t)row * 1024 + col) = v0;
          *(f32x4*)(xout + (size_t)row * 1024 + col + 4) = v1;
          if (xb) *(u32x4*)(xb + (size_t)row * 1024 + col) = (u32x4){pk2(v0[0], v0[1]), pk2(v0[2], v0[3]), pk2(v1[0], v1[1]), pk2(v1[2], v1[3])};
          s += v0[0] * v0[0] + v0[1] * v0[1] + v0[2] * v0[2] + v0[3] * v0[3] + v1[0] * v1[0] + v1[1] * v1[1] + v1[2] * v1[2] + v1[3] * v1[3];
        }
        s += __shfl_xor(s, 16); s += __shfl_xor(s, 32);
        if (fq == 0) ssq_next[(size_t)row * 16 + u.pn * 4 + wc] = s;
      }
  }
};

template <class Epi>
__device__ __forceinline__ void gemm_phase8(LAS unsigned char* lds, const bf16_t* A, int lda, int segkt, int segoff, const bf16_t* Bt, int K,
                                            const Order& S, const Epi& E) {
  const int tid = otid(), wid = __builtin_amdgcn_readfirstlane(tid >> 6), lane = tid & 63, wr = wid >> 2, wc = wid & 3, fr = lane & 15, fq = lane >> 4;
  const int nt = K / 64;
  unsigned voffA[2], voffB[2];
#pragma unroll
  for (int i = 0; i < 2; ++i) { int R, C; stage_rc(tid * 16 + i * 8192, R, C); const int Rb = Epi::PERM ? ((R & ~31) + perm32(R & 31)) : R;
    voffA[i] = (unsigned)(R * lda + C) * 2u; voffB[i] = (unsigned)(Rb * K + C) * 2u; }
  const size_t kstep = 128;
  const size_t hstepA = (size_t)128 * lda * 2, tstepA = 2 * hstepA;
  const size_t hstepB = (size_t)128 * K * 2, tstepB = 2 * hstepB;
  const size_t segB = (size_t)segoff * 2;
#define G8_AK(kt) ((size_t)(kt) * 128 + (((kt) >= segkt) ? segB : (size_t)0))
  const unsigned ldsw = (unsigned)wid * 1024u;
  const int aoff = lds_byte(wr * 64 + fr, fq * 8), boff = lds_byte(wc * 32 + fr, fq * 8);
#define G8_SA(b, h) (((b) * 2 + (h)) * HTB)
#define G8_SB(b, h) ((4 + (b) * 2 + (h)) * HTB)
#define G8_STAGE(bufoff, gbase, voff) do { _Pragma("unroll") for (int _i = 0; _i < 2; ++_i) \
    __builtin_amdgcn_global_load_lds((const unsigned*)((const char*)(gbase) + (voff)[_i]), (LAS unsigned*)(lds + (bufoff) + ldsw + _i * 8192), 16, 0, 0); } while (0)
#define G8_LDA(dst, b, h) do { _Pragma("unroll") for (int m = 0; m < 4; ++m) _Pragma("unroll") for (int k = 0; k < 2; ++k) dst[m][k] = *(const LAS bf16x8*)(lds + G8_SA(b, h) + aoff + m * 2048 + k * 1024); } while (0)
#define G8_LDB(dst, b, h) do { _Pragma("unroll") for (int n = 0; n < 2; ++n) _Pragma("unroll") for (int k = 0; k < 2; ++k) dst[n][k] = *(const LAS bf16x8*)(lds + G8_SB(b, h) + boff + n * 2048 + k * 1024); } while (0)
#define G8_MMA(ai, bj, At, Bt_) do { __builtin_amdgcn_s_setprio(1); _Pragma("unroll") for (int m = 0; m < 4; ++m) _Pragma("unroll") for (int n = 0; n < 2; ++n) _Pragma("unroll") for (int k = 0; k < 2; ++k) \
    acc[ai][bj][m][n] = __builtin_amdgcn_mfma_f32_16x16x32_bf16(Bt_[n][k], At[m][k], acc[ai][bj][m][n], 0, 0, 0); __builtin_amdgcn_s_setprio(0); } while (0)
#define G8_WAIT_V(n) asm volatile("s_waitcnt vmcnt(" #n ")" ::: "memory")
#define G8_WAIT_L(n) asm volatile("s_waitcnt lgkmcnt(" #n ")" ::: "memory")
#define G8_BAR __builtin_amdgcn_s_barrier()
#define G8_SCHED __builtin_amdgcn_sched_barrier(0)
  Unit cur, nxt; int ui = 0;
  if (!S.next(0, cur)) return;
  f32x4 acc[2][2][4][2];
#pragma unroll
  for (int a = 0; a < 2; ++a)
#pragma unroll
    for (int b = 0; b < 2; ++b)
#pragma unroll
      for (int m = 0; m < 4; ++m)
#pragma unroll
        for (int n = 0; n < 2; ++n) acc[a][b][m][n] = (f32x4){0.f, 0.f, 0.f, 0.f};
  bf16x8 At[4][2], B0[2][2], B1[2][2];
  const char* cA = (const char*)A + (size_t)cur.pm * tstepA; const char* cB = (const char*)Bt + (size_t)cur.pn * tstepB;
  G8_STAGE(G8_SB(0, 0), cB, voffB); G8_STAGE(G8_SA(0, 0), cA, voffA); G8_STAGE(G8_SB(0, 1), cB + hstepB, voffB); G8_STAGE(G8_SA(0, 1), cA + hstepA, voffA);
  if (wr == 1) G8_BAR;
  G8_WAIT_V(4); G8_BAR;
  G8_STAGE(G8_SB(1, 0), cB + kstep, voffB); G8_STAGE(G8_SA(1, 0), cA + G8_AK(1), voffA); G8_STAGE(G8_SB(1, 1), cB + hstepB + kstep, voffB);
  G8_WAIT_V(6); G8_BAR;
  for (;;) {
    const bool has_next = S.next(ui + 1, nxt);
    const char* nA = has_next ? (const char*)A + (size_t)nxt.pm * tstepA : cA; const char* nB = has_next ? (const char*)Bt + (size_t)nxt.pn * tstepB : cB;
    for (int t = 0; t < nt; t += 2) {
      const bool last = (t == nt - 2);
      const char* a1 = cA + G8_AK(t + 1);
      const char* a2 = last ? nA : cA + G8_AK(t + 2); const char* b2 = last ? nB : cB + (size_t)(t + 2) * kstep;
      const char* a3 = last ? nA + G8_AK(1) : cA + G8_AK(t + 3); const char* b3 = b2 + kstep;
      G8_LDB(B0, 0, 0); G8_SCHED; G8_LDA(At, 0, 0); G8_STAGE(G8_SA(1, 1), a1 + hstepA, voffA);
      G8_WAIT_L(8); G8_BAR; G8_WAIT_L(0); G8_MMA(0, 0, At, B0); G8_BAR; G8_SCHED;
      G8_LDB(B1, 0, 1); G8_STAGE(G8_SB(0, 0), b2, voffB);
      G8_BAR; G8_WAIT_L(0); G8_MMA(0, 1, At, B1); G8_BAR;
      G8_LDA(At, 0, 1); G8_STAGE(G8_SA(0, 0), a2, voffA);
      G8_BAR; G8_WAIT_L(0); G8_MMA(1, 0, At, B0); G8_BAR; G8_SCHED;
      G8_STAGE(G8_SB(0, 1), b2 + hstepB, voffB);
      G8_WAIT_V(6); G8_BAR; G8_MMA(1, 1, At, B1); G8_BAR;
      G8_LDB(B0, 1, 0); G8_SCHED; G8_LDA(At, 1, 0); G8_STAGE(G8_SA(0, 1), a2 + hstepA, voffA);
      G8_WAIT_L(8); G8_BAR; G8_WAIT_L(0); G8_MMA(0, 0, At, B0); G8_BAR; G8_SCHED;
      G8_LDB(B1, 1, 1); G8_STAGE(G8_SB(1, 0), b3, voffB);
      G8_BAR; G8_WAIT_L(0); G8_MMA(0, 1, At, B1); G8_BAR;
      G8_LDA(At, 1, 1); G8_STAGE(G8_SA(1, 0), a3, voffA);
      G8_BAR; G8_WAIT_L(0); G8_MMA(1, 0, At, B0); G8_BAR; G8_SCHED;
      G8_STAGE(G8_SB(1, 1), b3 + hstepB, voffB);
      G8_WAIT_V(6); G8_BAR; G8_MMA(1, 1, At, B1); G8_BAR;
    }
    E(acc, cur, wr, wc, fr, fq);
    if (!has_next) break;
#pragma unroll
    for (int a = 0; a < 2; ++a)
#pragma unroll
      for (int b = 0; b < 2; ++b)
#pragma unroll
        for (int m = 0; m < 4; ++m)
#pragma unroll
          for (int n = 0; n < 2; ++n) acc[a][b][m][n] = (f32x4){0.f, 0.f, 0.f, 0.f};
    cur = nxt; cA = nA; cB = nB; ++ui;
  }
  G8_WAIT_V(0);
  if (wr == 0) G8_BAR;
  G8_BAR;
#undef G8_AK
#undef G8_SA
#undef G8_SB
#undef G8_STAGE
#undef G8_LDA
#undef G8_LDB
#undef G8_MMA
#undef G8_WAIT_V
#undef G8_WAIT_L
#undef G8_BAR
#undef G8_SCHED
}
}

__device__ void xrow_unit(const Params& p, int unit) {
  const int tid_ = otid(); const int wid = tid_ >> 6, lane = tid_ & 63;
  f32x4 v[2][4];
#pragma unroll
  for (int r = 0; r < 2; ++r) {
    const int row = unit * 16 + r * 8 + wid;
    const float* src = (row < TP) ? (p.x_prompt + (size_t)row * 1024) : (p.x_sample + (size_t)(row - TP) * 1024);
#pragma unroll
    for (int i = 0; i < 4; ++i) v[r][i] = *(const f32x4*)(src + i * 256 + lane * 4);
  }
#pragma unroll
  for (int r = 0; r < 2; ++r) {
    const int row = unit * 16 + r * 8 + wid;
    float s = 0.f;
#pragma unroll
    for (int i = 0; i < 4; ++i) {
      const f32x4 x = v[r][i];
      s += x[0] * x[0] + x[1] * x[1] + x[2] * x[2] + x[3] * x[3];
      u32x2 o; o.x = pk2(x[0], x[1]); o.y = pk2(x[2], x[3]);
      *(u32x2*)(p.xb + (size_t)row * 1024 + i * 256 + lane * 4) = o;
    }
#pragma unroll
    for (int o = 32; o >= 1; o >>= 1) s += __shfl_xor(s, o);
    if (lane < 16) p.sumsq[(size_t)row * 16 + lane] = (lane == 0) ? s : 0.f;
  }
}

__device__ void transpose_unit(LAS unsigned char* lds, const float* src, int ldsrc, const float* scale, int nscale,
                               bf16_t* dst, int ldd, int kt, int ntile, int mode) {
  LAS float* tl = (LAS float*)lds;
  const int tid = otid();
  const int k0 = kt * 64, n0 = ntile * 64;
#pragma unroll
  for (int i = 0; i < 8; ++i) {
    const int e = tid + i * 512, kk = e >> 6, nn = e & 63;
    const int np = n0 + nn;
    int sc = np;
    if (mode == 0) { sc = (np < 3072) ? np : (np < 5120) ? (np + 16) : (np < 5136) ? (np - 5120 + 3072) : -1; }
    float v = 0.f;
    if (sc >= 0) {
      v = src[(size_t)(k0 + kk) * ldsrc + sc];
      if (scale && (k0 + kk) < nscale) v *= scale[k0 + kk];
    }
    tl[kk * 65 + nn] = v;
  }
  __syncthreads();
#pragma unroll
  for (int i = 0; i < 4; ++i) {
    const int e = tid + i * 512, nn = e >> 5, kk = (e & 31) * 2;
    const unsigned o = pk2(tl[kk * 65 + nn], tl[(kk + 1) * 65 + nn]);
    *(unsigned*)(dst + (size_t)(n0 + nn) * ldd + k0 + kk) = o;
  }
  __syncthreads();
}

__device__ __forceinline__ double exp_d(double x) {
  const double k = rint(x * 1.4426950408889634);
  const double r = fma(-k, 0.6931471805599453, x) - k * 2.3190468138462996e-17;
  double s = 1.0 / 6227020800.0;
  s = fma(s, r, 1.0 / 479001600.0); s = fma(s, r, 1.0 / 39916800.0); s = fma(s, r, 1.0 / 3628800.0);
  s = fma(s, r, 1.0 / 362880.0); s = fma(s, r, 1.0 / 40320.0); s = fma(s, r, 1.0 / 5040.0);
  s = fma(s, r, 1.0 / 720.0); s = fma(s, r, 1.0 / 120.0); s = fma(s, r, 1.0 / 24.0);
  s = fma(s, r, 1.0 / 6.0); s = fma(s, r, 0.5); s = fma(s, r, 1.0); s = fma(s, r, 1.0);
  return ldexp(s, (int)k);
}
__device__ __forceinline__ void sincos_d(double x, double& sn, double& cs) {
  const double k = rint(x * 0.6366197723675814);
  double r = fma(-k, 1.5707963267948966, x); r = fma(-k, 6.123233995736766e-17, r);
  const int q = ((int)k) & 3;
  const double r2 = r * r;
  double sp = 1.0 / 1307674368000.0;
  sp = fma(sp, r2, -1.0 / 6227020800.0); sp = fma(sp, r2, 1.0 / 39916800.0); sp = fma(sp, r2, -1.0 / 362880.0);
  sp = fma(sp, r2, 1.0 / 5040.0); sp = fma(sp, r2, -1.0 / 120.0); sp = fma(sp, r2, 1.0 / 6.0);
  sp = r - r * r2 * sp;
  double cp = 1.0 / 20922789888000.0;
  cp = fma(cp, r2, -1.0 / 87178291200.0); cp = fma(cp, r2, 1.0 / 479001600.0); cp = fma(cp, r2, -1.0 / 3628800.0);
  cp = fma(cp, r2, 1.0 / 40320.0); cp = fma(cp, r2, -1.0 / 720.0); cp = fma(cp, r2, 1.0 / 24.0); cp = fma(cp, r2, -0.5);
  cp = fma(cp, r2, 1.0);
  sn = (q == 0) ? sp : (q == 1) ? cp : (q == 2) ? -sp : -cp;
  cs = (q == 0) ? cp : (q == 1) ? -sp : (q == 2) ? -cp : sp;
}

__device__ void s5prep_unit(LAS unsigned char* lds, const Params& p, int l, int g) {
  LAS float* cf = (LAS float*)lds;
  const int tid = otid();
  const int lg = l * 64 + g;
  if (tid < 64) {
    const double dt = exp_d((double)p.log_dt[lg]);
    const double lr = (double)p.lam_re[lg * 64 + tid], li = (double)p.lam_im[lg * 64 + tid];
    const double e = exp_d(lr * dt);
    double sn, cs; sincos_d(li * dt, sn, cs);
    const double lbr = e * cs, lbi = e * sn;
    const double nr = lbr - 1.0, ni = lbi;
    const double den = lr * lr + li * li;
    const double cr = (nr * lr + ni * li) / den, ci = (ni * lr - nr * li) / den;
    p.lamb[(size_t)(lg * 64 + tid) * 2 + 0] = (float)lbr;
    p.lamb[(size_t)(lg * 64 + tid) * 2 + 1] = (float)lbi;
    cf[tid * 2 + 0] = (float)cr; cf[tid * 2 + 1] = (float)ci;
  }
  __syncthreads();
#pragma unroll
  for (int i = 0; i < 4; ++i) {
    const int idx = tid * 4 + i;
    {
      const int pp = idx >> 4, c = idx & 15, st = pp & 63;
      const float br = p.b_re[((size_t)lg * 64 + st) * 16 + c], bi = p.b_im[((size_t)lg * 64 + st) * 16 + c];
      const float cr = cf[st * 2], ci = cf[st * 2 + 1];
      const float v = (pp < 64) ? (cr * br - ci * bi) : (cr * bi + ci * br);
      p.BbT[(size_t)lg * 2048 + idx] = (bf16_t)(pk2(v, v) & 0xffffu);
    }
    {
      const int c = idx >> 7, pp = idx & 127, st = pp & 63;
      const float v = (pp < 64) ? p.c_re[((size_t)lg * 16 + c) * 64 + st] : -p.c_im[((size_t)lg * 16 + c) * 64 + st];
      p.CmT[(size_t)lg * 2048 + idx] = (bf16_t)(pk2(v, v) & 0xffffu);
    }
  }
  __syncthreads();
}

__device__ void phase_prep(LAS unsigned char* lds, const Params& p) {
  constexpr int U_X = 2080, U_WIN = 5376, U_WGLU = 1024, U_WOUT = 2048, U_S5 = 256;
  constexpr int TOTAL = U_X + U_WIN + U_WGLU + U_WOUT + U_S5;
  for (int u = blockIdx.x; u < TOTAL; u += gridDim.x) {
    int idx = u;
    if (idx < U_X) { xrow_unit(p, idx); continue; }
    idx -= U_X;
    if (idx < U_WIN) {
      const int l = idx / 1344, r = idx % 1344, ntile = r / 16, kt = r % 16;
      transpose_unit(lds, p.w_in + (size_t)l * 1024 * 5136, 5136, p.norm_g + l * 1024, 1024,
                     p.WinT + (size_t)l * 5376 * 1024, 1024, kt, ntile, 0);
      continue;
    }
    idx -= U_WIN;
    if (idx < U_WGLU) {
      const int l = idx / 256, r = idx % 256, ntile = r / 16, kt = r % 16;
      transpose_unit(lds, p.w_glu + (size_t)l * 1024 * 1024, 1024, nullptr, 0, p.WgluT + (size_t)l * 1024 * 1024, 1024, kt, ntile, 1);
      continue;
    }
    idx -= U_WGLU;
    if (idx < U_WOUT) {
      const int l = idx / 512, r = idx % 512, ntile = r / 32, kt = r % 32;
      transpose_unit(lds, p.w_out + (size_t)l * 2048 * 1024, 1024, p.ssd_norm_g + l * 1024, 1024,
                     p.WoutT + (size_t)l * 1024 * 2048, 2048, kt, ntile, 2);
      continue;
    }
    idx -= U_WOUT;
    s5prep_unit(lds, p, idx / 64, idx % 64);
  }
}

constexpr int CM_OFF = 0, BM_OFF = 17408, BMT_OFF = 34816, XDT_OFF = 53248, XW_OFF = 62464, MM_OFF = 71680,
              HB_OFF = 80896, XS_OFF = 98304, ACS_OFF = 107520, DTV_OFF = 115712, SSQ_OFF = 123904, CW_OFF = 124416;

__device__ __forceinline__ bf16x8 ldfrag(LAS unsigned char* lds, int off, int row, int stride, int col) {
  return *(const LAS bf16x8*)(lds + off + (row * stride + col) * 2);
}

template <int NCH>
__device__ __forceinline__ void conv_load_rows(unsigned (&rows)[7][NCH / 2], const bf16_t* proj, const float* stc, int tok0, int c, int s0, int ccol) {
#pragma unroll
  for (int i = 0; i < 7; ++i) {
    const int pos = c * 64 + s0 - 3 + i;
    if (pos >= 0) {
      const bf16_t* q = proj + (size_t)(tok0 + pos) * LDP + C_XBC + ccol;
      if (NCH == 8) { const u32x4 v = *(const u32x4*)q; rows[i][0] = v[0]; rows[i][1] = v[1]; rows[i][NCH / 2 - 2] = v[2]; rows[i][NCH / 2 - 1] = v[3]; }
      else rows[i][0] = *(const unsigned*)q;
    } else if (stc) {
      const float* sp = stc + (size_t)(3 + pos) * 2048 + ccol;
#pragma unroll
      for (int k = 0; k < NCH / 2; ++k) rows[i][k] = pk2(sp[2 * k], sp[2 * k + 1]);
    } else {
#pragma unroll
      for (int k = 0; k < NCH / 2; ++k) rows[i][k] = 0u;
    }
  }
}
template <int NCH>
__device__ __forceinline__ void conv_load_rows_fast(unsigned (&rows)[7][NCH / 2], const bf16_t* proj, int tok0, int c, int s0, int ccol) {
  const bf16_t* q0 = proj + (size_t)(tok0 + c * 64 + s0 - 3) * LDP + C_XBC + ccol;
#pragma unroll
  for (int i = 0; i < 7; ++i) {
    const bf16_t* q = q0 + (size_t)i * LDP;
    if (NCH == 8) { const u32x4 v = *(const u32x4*)q; rows[i][0] = v[0]; rows[i][1] = v[1]; rows[i][NCH / 2 - 2] = v[2]; rows[i][NCH / 2 - 1] = v[3]; }
    else rows[i][0] = *(const unsigned*)q;
  }
}
template <int NCH>
__device__ __forceinline__ void conv_store_row(LAS unsigned char* addr, const float* o) {
  if (NCH == 8) *(LAS u32x4*)addr = (u32x4){pk2(o[0], o[1]), pk2(o[2], o[3]), pk2(o[NCH - 4], o[NCH - 3]), pk2(o[NCH - 2], o[NCH - 1])};
  else *(LAS unsigned*)addr = pk2(o[0], o[1]);
}
template <int NCH>
__device__ __forceinline__ void conv_unit(LAS unsigned char* lds, const unsigned (&rows)[7][NCH / 2], const LAS float* wl,
                                          int oct, int chq, int s0, const LAS float* acs, const LAS float* dtv) {
  float o[4][NCH];
  float w[4][NCH], bs[NCH];
#pragma unroll
  for (int e = 0; e < NCH; ++e) { bs[e] = wl[32 + e];
#pragma unroll
    for (int k = 0; k < 4; ++k) w[k][e] = wl[k * 8 + e]; }
#pragma unroll
  for (int e = 0; e < NCH; ++e) {
    float xv[7];
#pragma unroll
    for (int i = 0; i < 7; ++i) xv[i] = (e & 1) ? hi_f(rows[i][e >> 1]) : lo_f(rows[i][e >> 1]);
#pragma unroll
    for (int j = 0; j < 4; ++j) o[j][e] = siluf(bs[e] + w[0][e] * xv[j] + w[1][e] * xv[j + 1] + w[2][e] * xv[j + 2] + w[3][e] * xv[j + 3]);
  }
  if (oct < 8) {
    float dts[4], wsc[4];
    const float aend = acs[63];
#pragma unroll
    for (int j = 0; j < 4; ++j) { dts[j] = dtv[s0 + j]; wsc[j] = dts[j] * __expf(aend - acs[s0 + j]); }
    const int p0 = oct * 8 + chq;
#pragma unroll
    for (int j = 0; j < 4; ++j) conv_store_row<NCH>(lds + XS_OFF + ((s0 + j) * 72 + p0) * 2, o[j]);
#pragma unroll
    for (int e = 0; e < NCH; ++e) {
      *(LAS u32x2*)(lds + XDT_OFF + ((p0 + e) * 72 + s0) * 2) = (u32x2){pk2(o[0][e] * dts[0], o[1][e] * dts[1]), pk2(o[2][e] * dts[2], o[3][e] * dts[3])};
      *(LAS u32x2*)(lds + XW_OFF + ((p0 + e) * 72 + s0) * 2) = (u32x2){pk2(o[0][e] * wsc[0], o[1][e] * wsc[1]), pk2(o[2][e] * wsc[2], o[3][e] * wsc[3])};
    }
  } else if (oct < 24) {
    const int n0 = (oct - 8) * 8 + chq;
#pragma unroll
    for (int j = 0; j < 4; ++j) conv_store_row<NCH>(lds + BM_OFF + ((s0 + j) * 136 + n0) * 2, o[j]);
#pragma unroll
    for (int e = 0; e < NCH; ++e) *(LAS u32x2*)(lds + BMT_OFF + ((n0 + e) * 72 + s0) * 2) = (u32x2){pk2(o[0][e], o[1][e]), pk2(o[2][e], o[3][e])};
  } else {
    const int n0 = (oct - 24) * 8 + chq;
#pragma unroll
    for (int j = 0; j < 4; ++j) conv_store_row<NCH>(lds + CM_OFF + ((s0 + j) * 136 + n0) * 2, o[j]);
  }
}

__device__ void ssd_item(LAS unsigned char* lds, const Params& p, int l, int b, int h, bool smp) {
  const int tid = otid(), wid = tid >> 6, lane = tid & 63, fr = lane & 15, fq = lane >> 4;
  const int g = h >> 2;
  const int tok0 = smp ? (TP + b * 64) : (b * 2048);
  const int nchunk = smp ? 1 : 32;
  const int NB = smp ? 8 : 16;
  bf16_t* proj = p.proj;
  LAS float* acs_all = (LAS float*)(lds + ACS_OFF);
  LAS float* dtv_all = (LAS float*)(lds + DTV_OFF);
  LAS float* ssq = (LAS float*)(lds + SSQ_OFF);
  const float dtb = p.dt_bias[l * 16 + h];
  const float Aneg = -__expf(p.a_log[l * 16 + h]);
  const float Dh = p.d_ssd[l * 16 + h];

  f32x4 hacc[4];
#pragma unroll
  for (int pt = 0; pt < 4; ++pt) {
    if (smp) hacc[pt] = *(const f32x4*)(p.st_ssd + ((((size_t)l * 8 + b) * 16 + h) * 64 + pt * 16 + fr) * 128 + wid * 16 + fq * 4);
    else hacc[pt] = (f32x4){0.f, 0.f, 0.f, 0.f};
  }

  const float* stc = smp ? (p.st_conv + ((size_t)l * 8 + b) * 3 * 2048) : nullptr;
  int octA, s0A;
  if (tid < 128) { octA = tid & 7; s0A = (tid >> 3) * 4; }
  else if (tid < 384) { const int i = tid - 128; octA = 8 + (i & 15); s0A = (i >> 4) * 4; }
  else { const int i = tid - 384; octA = 24 + (i & 15); s0A = (i >> 4) * 4; }
  const int jB = tid >> 2, octB = 24 + (jB & 15), s0B = (8 + (jB >> 4)) * 4, chqB = (tid & 3) * 2;
  const int cchA = (octA < 8) ? (h * 64 + octA * 8) : (octA < 24) ? (1024 + g * 128 + (octA - 8) * 8) : (1536 + g * 128 + (octA - 24) * 8);
  const int cchB = ((octB < 8) ? (h * 64 + octB * 8) : (octB < 24) ? (1024 + g * 128 + (octB - 8) * 8) : (1536 + g * 128 + (octB - 24) * 8)) + chqB;
  LAS float* cwl = (LAS float*)(lds + CW_OFF);
  {
    const float* cw = p.conv_w + (size_t)l * 4 * 2048;
    const float* cb = p.conv_b + (size_t)l * 2048;
    for (int idx = tid; idx < 1600; idx += 512) {
      const int oc = idx / 40, r = idx % 40, k = r >> 3, e = r & 7;
      const int cc = ((oc < 8) ? (h * 64 + oc * 8) : (oc < 24) ? (1024 + g * 128 + (oc - 8) * 8) : (1536 + g * 128 + (oc - 24) * 8)) + e;
      cwl[idx] = (k < 4) ? cw[k * 2048 + cc] : cb[cc];
    }
  }
  unsigned rowsA[7][4], rowsB[7][1];
  conv_load_rows<8>(rowsA, proj, stc, tok0, 0, s0A, cchA);
  conv_load_rows<2>(rowsB, proj, stc, tok0, 0, s0B, cchB);
  for (int c = wid; c < nchunk; c += 8) {
    const float dtr = bf2f(proj[(size_t)(tok0 + c * 64 + lane) * LDP + C_DT + h]);
    const float xx = dtr + dtb;
    const float dt = xx > 20.f ? xx : log1pf(__expf(xx));
    float cs = dt * Aneg;
#pragma unroll
    for (int o = 1; o < 64; o <<= 1) { const float v = __shfl_up(cs, o); if (lane >= o) cs += v; }
    acs_all[c * 64 + lane] = cs; dtv_all[c * 64 + lane] = dt;
  }
  LDS_BARRIER();
  for (int c = 0; c < nchunk; ++c) {
    const int ctok = tok0 + c * 64;
    const LAS float* acs = acs_all + c * 64;
    const LAS float* dtv = dtv_all + c * 64;
    u32x2 z4v[2];
    {
      const int lt_ = wid >> 1, ptb_ = (wid & 1) * 2;
#pragma unroll
      for (int q = 0; q < 2; ++q) z4v[q] = *(const u32x2*)(proj + (size_t)(ctok + lt_ * 16 + fr) * LDP + C_ZA + h * 64 + (ptb_ + q) * 16 + fq * 4);
    }
    conv_unit<8>(lds, rowsA, cwl + octA * 40, octA, 0, s0A, acs, dtv);
    conv_unit<2>(lds, rowsB, cwl + octB * 40 + chqB, octB, chqB, s0B, acs, dtv);
    if (c + 1 < nchunk) {
      conv_load_rows_fast<8>(rowsA, proj, tok0, c + 1, s0A, cchA);
      conv_load_rows_fast<2>(rowsB, proj, tok0, c + 1, s0B, cchB);
    }
#pragma unroll
    for (int pt = 0; pt < 4; ++pt)
      *(LAS u32x2*)(lds + HB_OFF + ((pt * 16 + fr) * 136 + wid * 16 + fq * 4) * 2) =
          (u32x2){pk2(hacc[pt][0], hacc[pt][1]), pk2(hacc[pt][2], hacc[pt][3])};
    LDS_BARRIER();
    const int lt = wid >> 1, ptb = (wid & 1) * 2;
    {
      const int st = wid >> 1, ltb = (wid & 1) * 2;
      bf16x8 bfr[4];
#pragma unroll
      for (int ks = 0; ks < 4; ++ks) bfr[ks] = ldfrag(lds, BM_OFF, st * 16 + fr, 136, ks * 32 + fq * 8);
#pragma unroll
      for (int q = 0; q < 2; ++q) {
        const int ltq = ltb + q;
        f32x4 a = (f32x4){0.f, 0.f, 0.f, 0.f};
#pragma unroll
        for (int ks = 0; ks < 4; ++ks) a = mfma16(bfr[ks], ldfrag(lds, CM_OFF, ltq * 16 + fr, 136, ks * 32 + fq * 8), a);
        const int l_ = ltq * 16 + fr;
        const float al = acs[l_];
        float mv[4];
#pragma unroll
        for (int r = 0; r < 4; ++r) { const int s_ = st * 16 + fq * 4 + r; const float ex = __expf(al - acs[s_]); mv[r] = (s_ <= l_) ? a[r] * ex : 0.f; }
        *(LAS u32x2*)(lds + MM_OFF + (l_ * 72 + st * 16 + fq * 4) * 2) = (u32x2){pk2(mv[0], mv[1]), pk2(mv[2], mv[3])};
      }
    }
    f32x4 accI[2];
    accI[0] = (f32x4){0.f, 0.f, 0.f, 0.f}; accI[1] = accI[0];
#pragma unroll
    for (int ks = 0; ks < 4; ++ks) {
      const bf16x8 cfr = ldfrag(lds, CM_OFF, lt * 16 + fr, 136, ks * 32 + fq * 8);
#pragma unroll
      for (int q = 0; q < 2; ++q) accI[q] = mfma16(ldfrag(lds, HB_OFF, (ptb + q) * 16 + fr, 136, ks * 32 + fq * 8), cfr, accI[q]);
    }
    {
      const float dec = __expf(acs[63]);
      bf16x8 bt[2];
#pragma unroll
      for (int ks = 0; ks < 2; ++ks) bt[ks] = ldfrag(lds, BMT_OFF, wid * 16 + fr, 72, ks * 32 + fq * 8);
#pragma unroll
      for (int pt = 0; pt < 4; ++pt) {
        hacc[pt] = hacc[pt] * dec;
#pragma unroll
        for (int ks = 0; ks < 2; ++ks) hacc[pt] = mfma16(bt[ks], ldfrag(lds, XW_OFF, pt * 16 + fr, 72, ks * 32 + fq * 8), hacc[pt]);
      }
    }
    LDS_BARRIER();
    {
      f32x4 accY[2];
      accY[0] = (f32x4){0.f, 0.f, 0.f, 0.f}; accY[1] = accY[0];
#pragma unroll
      for (int ks = 0; ks < 2; ++ks) {
        const bf16x8 mf = ldfrag(lds, MM_OFF, lt * 16 + fr, 72, ks * 32 + fq * 8);
#pragma unroll
        for (int q = 0; q < 2; ++q) accY[q] = mfma16(ldfrag(lds, XDT_OFF, (ptb + q) * 16 + fr, 72, ks * 32 + fq * 8), mf, accY[q]);
      }
      const int l_ = lt * 16 + fr;
      const float el = __expf(acs[l_]);
      float sq = 0.f;
#pragma unroll
      for (int q = 0; q < 2; ++q) {
        const int p0 = (ptb + q) * 16 + fq * 4;
        const u32x2 xs4 = *(const LAS u32x2*)(lds + XS_OFF + (l_ * 72 + p0) * 2);
        bf16_t* zp = proj + (size_t)(ctok + l_) * LDP + C_ZA + h * 64 + p0;
        const u32x2 z4 = z4v[q];
        const float y0 = (accY[q][0] + el * accI[q][0] + Dh * lo_f(xs4.x)) * siluf(lo_f(z4.x));
        const float y1 = (accY[q][1] + el * accI[q][1] + Dh * hi_f(xs4.x)) * siluf(hi_f(z4.x));
        const float y2 = (accY[q][2] + el * accI[q][2] + Dh * lo_f(xs4.y)) * siluf(lo_f(z4.y));
        const float y3 = (accY[q][3] + el * accI[q][3] + Dh * hi_f(xs4.y)) * siluf(hi_f(z4.y));
        sq += y0 * y0 + y1 * y1 + y2 * y2 + y3 * y3;
        *(u32x2*)zp = (u32x2){pk2(y0, y1), pk2(y2, y3)};
      }
      sq += __shfl_xor(sq, 16); sq += __shfl_xor(sq, 32);
      if (fq == 0) ssq[(wid & 1) * 64 + l_] = sq;
    }
    LDS_BARRIER();
    if (tid < 64) p.ssqa[(size_t)(ctok + tid) * 16 + h] = ssq[tid] + ssq[64 + tid];
  }
  {
    float* so = p.out + (smp ? O_SSDS : O_SSDP);
#pragma unroll
    for (int pt = 0; pt < 4; ++pt)
      *(f32x4*)(so + ((((size_t)l * NB + b) * 16 + h) * 64 + pt * 16 + fr) * 128 + wid * 16 + fq * 4) = hacc[pt];
    float* co = p.out + (smp ? O_CONVS : O_CONVP);
    const int L = smp ? 64 : 2048;
    for (int i = tid; i < 3 * 320; i += 512) {
      const int r = i / 320, cc = i % 320;
      if (cc >= 64 && (h & 3)) continue;
      const int ch = (cc < 64) ? (h * 64 + cc) : (cc < 192) ? (1024 + g * 128 + (cc - 64)) : (1536 + g * 128 + (cc - 192));
      co[(((size_t)l * NB + b) * 3 + r) * 2048 + ch] = bf2f(proj[(size_t)(tok0 + L - 3 + r) * LDP + C_XBC + ch]);
    }
  }
  __syncthreads();
}

__device__ __forceinline__ float fma_asm(float a, float b, float c) { float d; asm volatile("v_fma_f32 %0, %1, %2, %3" : "=v"(d) : "v"(a), "v"(b), "v"(c)); return d; }
__device__ void s5_seq(LAS unsigned char* lds, const Params& p, int l, int b, int g, bool smp) {
  const int tid_ = otid(); const int wid = tid_ >> 6, lane = tid_ & 63, fr = lane & 15, fq = lane >> 4;
  LAS float* buf = (LAS float*)(lds + wid * 16896);
  const int tok0 = smp ? (TP + b * 64) : (b * 2048);
  const int nblk = smp ? 2 : 64;
  const int NB = smp ? 8 : 16;
  const int lg = l * 64 + g;
  bf16x8 Bfrag[4], Cfrag[4];
#pragma unroll
  for (int nt = 0; nt < 4; ++nt) Bfrag[nt] = *(const bf16x8*)(p.BbT + ((size_t)lg * 128 + nt * 32 + (lane & 31)) * 16 + 8 * (lane >> 5));
#pragma unroll
  for (int ks = 0; ks < 4; ++ks) Cfrag[ks] = *(const bf16x8*)(p.CmT + ((size_t)lg * 16 + fr) * 128 + ks * 32 + fq * 8);
  const float lr = p.lamb[(size_t)(lg * 64 + lane) * 2], li = p.lamb[(size_t)(lg * 64 + lane) * 2 + 1];
  const float nli = -li;
  float hr = 0.f, hi = 0.f;
  if (smp) { hr = p.st_s5re[(((size_t)l * 8 + b) * 64 + g) * 64 + lane]; hi = p.st_s5im[(((size_t)l * 8 + b) * 64 + g) * 64 + lane]; }
  const f32x4 d4 = *(const f32x4*)(p.d_s5 + l * 1024 + g * 16 + fq * 4);
  const bf16_t* ubase = p.proj + C_U + g * 16;
  bf16x8 a_next = *(const bf16x8*)(ubase + (size_t)(tok0 + (lane & 31)) * LDP + 8 * (lane >> 5));
  for (int blk = 0; blk < nblk; ++blk) {
    const bf16x8 a = a_next;
    if (blk + 1 < nblk) a_next = *(const bf16x8*)(ubase + (size_t)(tok0 + (blk + 1) * 32 + (lane & 31)) * LDP + 8 * (lane >> 5));
    u32x2 u4v[2];
#pragma unroll
    for (int mt = 0; mt < 2; ++mt) u4v[mt] = *(const u32x2*)(ubase + (size_t)(tok0 + blk * 32 + mt * 16 + fr) * LDP + fq * 4);
    float bre[32], bim[32];
    {
      f32x16 d[4];
#pragma unroll
      for (int nt = 0; nt < 4; ++nt) {
        f32x16 z = {0.f, 0.f, 0.f, 0.f, 0.f, 0.f, 0.f, 0.f, 0.f, 0.f, 0.f, 0.f, 0.f, 0.f, 0.f, 0.f};
        d[nt] = __builtin_amdgcn_mfma_f32_32x32x16_bf16(a, Bfrag[nt], z, 0, 0, 0);
      }
#pragma unroll
      for (int r = 0; r < 16; ++r) {
        const int tA = (r & 3) + 8 * (r >> 2);
        const auto sr = __builtin_amdgcn_permlane32_swap(__float_as_uint(d[0][r]), __float_as_uint(d[1][r]), false, false);
        bre[tA] = __uint_as_float(sr[0]); bre[tA + 4] = __uint_as_float(sr[1]);
        const auto si = __builtin_amdgcn_permlane32_swap(__float_as_uint(d[2][r]), __float_as_uint(d[3][r]), false, false);
        bim[tA] = __uint_as_float(si[0]); bim[tA + 4] = __uint_as_float(si[1]);
      }
    }
#pragma unroll
    for (int t = 0; t < 32; ++t) {
      float nr = fma_asm(lr, hr, bre[t]); nr = fma_asm(nli, hi, nr);
      float ni = fma_asm(lr, hi, bim[t]); ni = fma_asm(li, hr, ni);
      hr = nr; hi = ni;
      buf[t * 132 + lane] = hr; buf[t * 132 + 64 + lane] = hi;
    }
    asm volatile("s_waitcnt lgkmcnt(0)" ::: "memory");
#pragma unroll
    for (int mt = 0; mt < 2; ++mt) {
      f32x4 acc = (f32x4){0.f, 0.f, 0.f, 0.f};
#pragma unroll
      for (int ks = 0; ks < 4; ++ks) {
        const LAS float* hp = buf + (mt * 16 + fr) * 132 + ks * 32 + fq * 8;
        const f32x4 h0 = *(const LAS f32x4*)hp, h1 = *(const LAS f32x4*)(hp + 4);
        u32x4 hw = (u32x4){pk2(h0[0], h0[1]), pk2(h0[2], h0[3]), pk2(h1[0], h1[1]), pk2(h1[2], h1[3])};
        bf16x8 hf = __builtin_bit_cast(bf16x8, hw);
        acc = mfma16(Cfrag[ks], hf, acc);
      }
      const size_t trow = (size_t)(tok0 + blk * 32 + mt * 16 + fr);
      const u32x2 u4 = u4v[mt];
      const float y0 = gelu_tanh(acc[0] + d4[0] * lo_f(u4.x));
      const float y1 = gelu_tanh(acc[1] + d4[1] * hi_f(u4.x));
      const float y2 = gelu_tanh(acc[2] + d4[2] * lo_f(u4.y));
      const float y3 = gelu_tanh(acc[3] + d4[3] * hi_f(u4.y));
      *(u32x2*)(p.xb + trow * 1024 + g * 16 + fq * 4) = (u32x2){pk2(y0, y1), pk2(y2, y3)};
    }
    asm volatile("" ::: "memory");
  }
  p.out[(smp ? O_S5RES : O_S5REP) + (((size_t)l * NB + b) * 64 + g) * 64 + lane] = hr;
  p.out[(smp ? O_S5IMS : O_S5IMP) + (((size_t)l * NB + b) * 64 + g) * 64 + lane] = hi;
}

__device__ void phase_mixer(LAS unsigned char* lds, const Params& p, int l) {
  const int wid = otid() >> 6;
  for (int u = blockIdx.x; u < 768; u += gridDim.x) {
    if (u < 256) {
      const int x = u & 7, j = u >> 3, G = x * 8 + (j >> 2);
      ssd_item(lds, p, l, G >> 2, (G & 3) * 4 + (j & 3), false);
    }
    else if (u < 512) { if (wid < 4) { const int seq = (u - 256) * 4 + wid; s5_seq(lds, p, l, seq >> 6, seq & 63, false); } }
    else if (u < 640) {
      const int v = u - 512, x = v & 7, j = v >> 3, G = x * 4 + (j >> 2);
      ssd_item(lds, p, l, G >> 2, (G & 3) * 4 + (j & 3), true);
    }
    else { if (wid < 4) { const int seq = (u - 640) * 4 + wid; s5_seq(lds, p, l, seq >> 6, seq & 63, true); } }
    __syncthreads();
  }
}

__device__ void norm_unit(const Params& p, int nu) {
  const int tid = otid();
  const int tok = nu * 32 + (tid >> 4), hh = tid & 15, gg = hh >> 2;
  const f32x4 s4 = *(const f32x4*)(p.ssqa + (size_t)tok * 16 + gg * 4);
  const float rs = rsqrtf((s4[0] + s4[1] + s4[2] + s4[3]) * (1.f / 256.f) + 1e-6f);
  bf16_t* q = p.proj + (size_t)tok * LDP + C_ZA + hh * 64;
#pragma unroll
  for (int i = 0; i < 8; ++i) {
    u32x4 v = *(u32x4*)(q + i * 8);
#pragma unroll
    for (int k = 0; k < 4; ++k) v[k] = pk2(lo_f(v[k]) * rs, hi_f(v[k]) * rs);
    *(u32x4*)(q + i * 8) = v;
  }
}

__device__ void final_unit(const Params& p, int unit) {
  const int tid_ = otid(); const int wid = tid_ >> 6, lane = tid_ & 63;
  const int row = unit * 8 + wid;
  const f32x4* sp = (const f32x4*)(p.sumsq + ((size_t)4 * T_TOK + row) * 16);
  const f32x4 s0 = sp[0], s1 = sp[1], s2 = sp[2], s3 = sp[3];
  const float ss = ((s0[0] + s0[1]) + (s0[2] + s0[3])) + ((s1[0] + s1[1]) + (s1[2] + s1[3])) +
                   ((s2[0] + s2[1]) + (s2[2] + s2[3])) + ((s3[0] + s3[1]) + (s3[2] + s3[3]));
  const float rs = rsqrtf(ss * (1.f / 1024.f) + 1e-6f);
  float* xr = p.out + (size_t)row * 1024;
#pragma unroll
  for (int i = 0; i < 4; ++i) {
    const int c = i * 256 + lane * 4;
    const f32x4 v = *(const f32x4*)(xr + c);
    const f32x4 gv = *(const f32x4*)(p.final_g + c);
    *(f32x4*)(xr + c) = v * rs * gv;
  }
}

__device__ __forceinline__ void grid_barrier(cg::grid_group& grid, unsigned* ctr, unsigned target) {
  asm volatile("s_waitcnt vmcnt(0) lgkmcnt(0)" ::: "memory");
  __syncthreads();
  if (target == gridDim.x) grid.sync();
  if (threadIdx.x == 0) {
    __builtin_amdgcn_fence(__ATOMIC_RELEASE, "agent");
    asm volatile("s_waitcnt vmcnt(0)" ::: "memory");
    __hip_atomic_fetch_add(ctr, 1u, __ATOMIC_RELAXED, __HIP_MEMORY_SCOPE_AGENT);
    while (__hip_atomic_load(ctr, __ATOMIC_RELAXED, __HIP_MEMORY_SCOPE_AGENT) < target) __builtin_amdgcn_s_sleep(1);
    __builtin_amdgcn_fence(__ATOMIC_ACQUIRE, "agent");
    asm volatile("s_waitcnt vmcnt(0)" ::: "memory");
  }
  __syncthreads();
}

__global__ void __launch_bounds__(NTHREADS) mega(Params p) {
  __shared__ __attribute__((aligned(1024))) unsigned char shm[LDS_BYTES];
  LAS unsigned char* lds = (LAS unsigned char*)shm;
  cg::grid_group grid = cg::this_grid();
  phase_prep(lds, p);
  grid_barrier(grid, p.bar, gridDim.x);
  for (int ph = 1; ph < p.phase_end; ++ph) {
    if (ph == 17) {
      for (int u = blockIdx.x; u < 4160; u += gridDim.x) final_unit(p, u);
    } else {
      const int l = (ph - 1) >> 2, sub = (ph - 1) & 3;
      if (sub == 0) {
        g8::EpiIn8 e{p.proj, p.sumsq + (size_t)l * T_TOK * 16};
        g8::Order S{NMT * 21, 21};
        g8::gemm_phase8(lds, p.xb, 1024, 1 << 30, 0, p.WinT + (size_t)l * 5376 * 1024, 1024, S, e);
      } else if (sub == 1) {
        phase_mixer(lds, p, l);
      } else if (sub == 2) {
        g8::EpiGlu8 e{p.proj, p.b_glu + l * 1024, p.xb};
        g8::Order S{NMT * 4, 4};
        g8::gemm_phase8(lds, p.xb, 1024, 1 << 30, 0, p.WgluT + (size_t)l * 1024 * 1024, 1024, S, e);
        for (int u = gridDim.x - 1 - blockIdx.x; u < 1040; u += gridDim.x) norm_unit(p, u);
      } else {
        g8::EpiOut8 e{l == 0 ? p.x_prompt : p.out, l == 0 ? p.x_sample : (p.out + (size_t)TP * 1024), p.out,
                      l == 3 ? (bf16_t*)nullptr : p.xb, p.sumsq + (size_t)(l + 1) * T_TOK * 16};
        g8::Order S{NMT * 4, 4};
        g8::gemm_phase8(lds, p.proj, LDP, 16, 3072, p.WoutT + (size_t)l * 1024 * 2048, 2048, S, e);
      }
    }
    if (ph + 1 < p.phase_end) grid_barrier(grid, p.bar, (unsigned)(ph - p.phase_begin + 1) * gridDim.x);
  }
}

extern "C" void kernel_launch(void* const* d_in, const int* in_sizes, int n_in, void* d_out, int out_size, void* d_ws, size_t ws_size,
                              hipStream_t stream) {
  static int grid_blocks = 0;
  if (!grid_blocks) {
    int dev = 0, cus = 0, per_cu = 0;
    hipGetDevice(&dev);
    hipDeviceGetAttribute(&cus, hipDeviceAttributeMultiprocessorCount, dev);
    hipOccupancyMaxActiveBlocksPerMultiprocessor(&per_cu, mega, NTHREADS, 0);
    if (per_cu < 1) per_cu = 1;
    if (per_cu > 1) per_cu = 1;
    grid_blocks = cus * per_cu;
  }
  Params p{};
  const float* const* in = (const float* const*)d_in;
  p.x_prompt = in[0]; p.x_sample = in[1]; p.st_conv = in[2]; p.st_ssd = in[3]; p.st_s5re = in[4]; p.st_s5im = in[5];
  p.norm_g = in[6]; p.w_in = in[7]; p.conv_w = in[8]; p.conv_b = in[9]; p.dt_bias = in[10]; p.a_log = in[11]; p.d_ssd = in[12];
  p.ssd_norm_g = in[13]; p.lam_re = in[14]; p.lam_im = in[15]; p.log_dt = in[16]; p.b_re = in[17]; p.b_im = in[18];
  p.c_re = in[19]; p.c_im = in[20]; p.d_s5 = in[21]; p.w_glu = in[22]; p.b_glu = in[23]; p.w_out = in[24]; p.final_g = in[25];
  p.out = (float*)d_out;
  unsigned char* ws = (unsigned char*)d_ws;
  size_t off = 0;
  auto take = [&](size_t bytes) { unsigned char* r = ws + off; off += (bytes + 1023) & ~(size_t)1023; return r; };
  p.xb = (bf16_t*)take((size_t)T_TOK * 1024 * 2);
  p.proj = (bf16_t*)take((size_t)T_TOK * LDP * 2);
  p.WinT = (bf16_t*)take((size_t)4 * 5376 * 1024 * 2);
  p.WgluT = (bf16_t*)take((size_t)4 * 1024 * 1024 * 2);
  p.WoutT = (bf16_t*)take((size_t)4 * 1024 * 2048 * 2);
  p.BbT = (bf16_t*)take((size_t)256 * 2048 * 2);
  p.CmT = (bf16_t*)take((size_t)256 * 2048 * 2);
  p.sumsq = (float*)take((size_t)5 * T_TOK * 16 * 4);
  p.ssqa = (float*)take((size_t)T_TOK * 16 * 4);
  p.lamb = (float*)take((size_t)256 * 64 * 2 * 4);
  p.bar = (unsigned*)take(1024);
  hipMemsetAsync(p.bar, 0, 1024, stream);
  if (off > ws_size) { fprintf(stderr, "workspace too small: need %zu have %zu\n", off, ws_size); return; }
  p.phase_begin = 0; p.phase_end = 18;
  void* args[] = {&p};
  hipError_t e = hipLaunchCooperativeKernel((void*)mega, dim3(grid_blocks), dim3(NTHREADS), args, 0, stream);
  if (e != hipSuccess) fprintf(stderr, "cooperative launch failed: %s (grid %d)\n", hipGetErrorString(e), grid_blocks);
}
```

```cpp
#include <hip/hip_runtime.h>
#include <hip/hip_cooperative_groups.h>
#include <cstdio>
namespace cg = cooperative_groups;

#define LAS __attribute__((address_space(3)))
typedef unsigned short bf16_t;
typedef short bf16x8 __attribute__((ext_vector_type(8)));
typedef float f32x4 __attribute__((ext_vector_type(4)));
typedef float f32x16 __attribute__((ext_vector_type(16)));
typedef unsigned u32x4 __attribute__((ext_vector_type(4)));
typedef unsigned u32x2 __attribute__((ext_vector_type(2)));

constexpr int T_TOK = 33280, TP = 32768, NMT = 130;
constexpr int LDP = 5376;
constexpr int C_ZA = 0, C_XBC = 1024, C_U = 3072, C_ZB = 4096, C_DT = 5120;
constexpr int NTHREADS = 512;
constexpr int LDS_BYTES = 139264;

constexpr size_t O_Y = 0, O_CONVP = 34078720, O_SSDP = 34471936, O_S5REP = 42860544, O_S5IMP = 43122688,
                 O_CONVS = 43384832, O_SSDS = 43581440, O_S5RES = 47775744, O_S5IMS = 47906816;

struct Params {
  const float *x_prompt, *x_sample, *st_conv, *st_ssd, *st_s5re, *st_s5im;
  const float *norm_g, *w_in, *conv_w, *conv_b, *dt_bias, *a_log, *d_ssd, *ssd_norm_g;
  const float *lam_re, *lam_im, *log_dt, *b_re, *b_im, *c_re, *c_im, *d_s5, *w_glu, *b_glu, *w_out, *final_g;
  float* out;
  bf16_t *xb, *proj, *WinT, *WgluT, *WoutT, *BbT, *CmT;
  float *sumsq, *ssqa, *lamb;
  unsigned* bar;
  int phase_begin, phase_end;
};

__device__ __forceinline__ float bf2f(unsigned short v) { return __uint_as_float(((unsigned)v) << 16); }
__device__ __forceinline__ float lo_f(unsigned w) { return __uint_as_float(w << 16); }
__device__ __forceinline__ float hi_f(unsigned w) { return __uint_as_float(w & 0xffff0000u); }
__device__ __forceinline__ unsigned pk2(float lo, float hi) { unsigned r; asm("v_cvt_pk_bf16_f32 %0, %1, %2" : "=v"(r) : "v"(lo), "v"(hi)); return r; }
__device__ __forceinline__ float sigm(float x) { return __builtin_amdgcn_rcpf(1.f + __expf(-x)); }
__device__ __forceinline__ float siluf(float x) { return x * sigm(x); }
__device__ __forceinline__ float gelu_tanh(float x) { const float z = 0.7978845608028654f * (x + 0.044715f * x * x * x); return x * sigm(2.f * z); }
__device__ __forceinline__ f32x4 mfma16(bf16x8 a, bf16x8 b, f32x4 c) { return __builtin_amdgcn_mfma_f32_16x16x32_bf16(a, b, c, 0, 0, 0); }
#define WAIT_V0() asm volatile("s_waitcnt vmcnt(0)" ::: "memory")
#define LDS_BARRIER() asm volatile("s_waitcnt lgkmcnt(0)\n\ts_barrier" ::: "memory")
__device__ __forceinline__ int otid() { int t = threadIdx.x; asm volatile("" : "+v"(t)); return t; }

__device__ __forceinline__ void stage_rc(int b, int& R, int& C) {
  const int st = b >> 10, sb = b & 1023, swz = sb ^ (((sb >> 9) & 1) << 5);
  R = (st >> 1) * 16 + swz / 64;
  C = (st & 1) * 32 + (swz % 64) / 2;
}

__device__ __forceinline__ int xcd_remap(int u) {
  const int G = gridDim.x, i = u / G, blk = u % G, per = G >> 3;
  if (G & 7) return u;
  return (i * 8 + (blk & 7)) * per + (blk >> 3);
}
__device__ __forceinline__ void tile_map(int u, int nN, int& pm, int& pn) {
  const int nig = 8 * nN, gid = u / nig, fm = gid * 8, rem = u % nig;
  const int gsz = (NMT - fm) < 8 ? (NMT - fm) : 8;
  pm = fm + rem % gsz; pn = rem / gsz;
}

namespace g8 {
constexpr int HTB = 128 * 64 * 2;
__device__ __forceinline__ int lds_byte(int r, int c) { const int st = (r >> 4) * 2 + (c >> 5), rr = r & 15, cc = c & 31, ob = rr * 64 + cc * 2; return st * 1024 + (ob ^ (((ob >> 9) & 1) << 5)); }
struct Unit { int pm, pn; };
struct Order {
  int ntiles, nN;
  __device__ __forceinline__ bool next(int i, Unit& u) const {
    const int w = xcd_remap((int)blockIdx.x + i * (int)gridDim.x);
    if (w >= ntiles) return false;
    tile_map(w, nN, u.pm, u.pn); return true;
  }
};
__device__ __forceinline__ int perm32(int rho) { const int n = rho >> 4, i = rho & 15; return 8 * (i >> 2) + 4 * n + (i & 3); }
struct EpiIn8 {
  static constexpr bool PERM = true;
  bf16_t* proj; const float* sumsq;
  __device__ __forceinline__ void operator()(const f32x4 (&acc)[2][2][4][2], const Unit& u, int wr, int wc, int fr, int fq) const {
    const int row0 = u.pm * 256 + wr * 64 + fr, col0 = u.pn * 256 + wc * 32 + fq * 8;
#pragma unroll
    for (int ai = 0; ai < 2; ++ai)
#pragma unroll
      for (int m = 0; m < 4; ++m) {
        asm volatile("" ::: "memory");
        const int row = row0 + ai * 128 + m * 16;
        const f32x4* sp = (const f32x4*)(sumsq + (size_t)row * 16);
        const f32x4 s0 = sp[0], s1 = sp[1], s2 = sp[2], s3 = sp[3];
        const float ss = ((s0[0] + s0[1]) + (s0[2] + s0[3])) + ((s1[0] + s1[1]) + (s1[2] + s1[3])) +
                         ((s2[0] + s2[1]) + (s2[2] + s2[3])) + ((s3[0] + s3[1]) + (s3[2] + s3[3]));
        const float rs = rsqrtf(ss * (1.f / 1024.f) + 1e-6f);
        bf16_t* rp = proj + (size_t)row * LDP + col0;
#pragma unroll
        for (int bj = 0; bj < 2; ++bj) {
          const f32x4 v0 = acc[ai][bj][m][0] * rs, v1 = acc[ai][bj][m][1] * rs;
          *(u32x4*)(rp + bj * 128) = (u32x4){pk2(v0[0], v0[1]), pk2(v0[2], v0[3]), pk2(v1[0], v1[1]), pk2(v1[2], v1[3])};
        }
      }
  }
};
struct EpiGlu8 {
  static constexpr bool PERM = true;
  bf16_t* proj; const float* bglu; const bf16_t* ys;
  __device__ __forceinline__ void operator()(const f32x4 (&acc)[2][2][4][2], const Unit& u, int wr, int wc, int fr, int fq) const {
    const int row0 = u.pm * 256 + wr * 64 + fr, col0 = u.pn * 256 + wc * 32 + fq * 8;
#pragma unroll
    for (int ai = 0; ai < 2; ++ai)
#pragma unroll
      for (int m = 0; m < 4; ++m) {
        asm volatile("" ::: "memory");
        const int row = row0 + ai * 128 + m * 16;
        bf16_t* base = proj + (size_t)row * LDP;
#pragma unroll
        for (int bj = 0; bj < 2; ++bj) {
          const int col = col0 + bj * 128;
          const f32x4 g0 = acc[ai][bj][m][0] + *(const f32x4*)(bglu + col), g1 = acc[ai][bj][m][1] + *(const f32x4*)(bglu + col + 4);
          const u32x4 a = *(const u32x4*)(ys + (size_t)row * 1024 + col);
          const u32x4 z = *(const u32x4*)(base + C_ZB + col);
          u32x4 o;
          o[0] = pk2(lo_f(a[0]) * sigm(g0[0]) * siluf(lo_f(z[0])), hi_f(a[0]) * sigm(g0[1]) * siluf(hi_f(z[0])));
          o[1] = pk2(lo_f(a[1]) * sigm(g0[2]) * siluf(lo_f(z[1])), hi_f(a[1]) * sigm(g0[3]) * siluf(hi_f(z[1])));
          o[2] = pk2(lo_f(a[2]) * sigm(g1[0]) * siluf(lo_f(z[2])), hi_f(a[2]) * sigm(g1[1]) * siluf(hi_f(z[2])));
          o[3] = pk2(lo_f(a[3]) * sigm(g1[2]) * siluf(lo_f(z[3])), hi_f(a[3]) * sigm(g1[3]) * siluf(hi_f(z[3])));
          *(u32x4*)(base + C_ZB + col) = o;
        }
      }
  }
};
struct EpiOut8 {
  static constexpr bool PERM = true;
  const float *xin_p, *xin_s; float* xout; bf16_t* xb; float* ssq_next;
  __device__ __forceinline__ void operator()(const f32x4 (&acc)[2][2][4][2], const Unit& u, int wr, int wc, int fr, int fq) const {
    const int row0 = u.pm * 256 + wr * 64 + fr, col0 = u.pn * 256 + wc * 32 + fq * 8;
#pragma unroll
    for (int ai = 0; ai < 2; ++ai)
#pragma unroll
      for (int m = 0; m < 4; ++m) {
        asm volatile("" ::: "memory");
        const int row = row0 + ai * 128 + m * 16;
        const float* xr = (row < TP) ? (xin_p + (size_t)row * 1024) : (xin_s + (size_t)(row - TP) * 1024);
        float s = 0.f;
#pragma unroll
        for (int bj = 0; bj < 2; ++bj) {
          const int col = col0 + bj * 128;
          const f32x4 v0 = acc[ai][bj][m][0] + *(const f32x4*)(xr + col), v1 = acc[ai][bj][m][1] + *(const f32x4*)(xr + col + 4);
          *(f32x4*)(xout + (size_t)row * 1024 + col) = v0;
          *(f32x4*)(xout + (size_t)row * 1024 + col + 4) = v1;
          if (xb) *(u32x4*)(xb + (size_t)row * 1024 + col) = (u32x4){pk2(v0[0], v0[1]), pk2(v0[2], v0[3]), pk2(v1[0], v1[1]), pk2(v1[2], v1[3])};
          s += v0[0] * v0[0] + v0[1] * v0[1] + v0[2] * v0[2] + v0[3] * v0[3] + v1[0] * v1[0] + v1[1] * v1[1] + v1[2] * v1[2] + v1[3] * v1[3];
        }
        s += __shfl_xor(s, 16); s += __shfl_xor(s, 32);
        if (fq == 0) ssq_next[(size_t)row * 16 + u.pn * 4 + wc] = s;
      }
  }
};

template <class Epi>
__device__ __forceinline__ void gemm_phase8(LAS unsigned char* lds, const bf16_t* A, int lda, int segkt, int segoff, const bf16_t* Bt, int K,
                                            const Order& S, const Epi& E) {
  const int tid = otid(), wid = __builtin_amdgcn_readfirstlane(tid >> 6), lane = tid & 63, wr = wid >> 2, wc = wid & 3, fr = lane & 15, fq = lane >> 4;
  const int nt = K / 64;
  unsigned voffA[2], voffB[2];
#pragma unroll
  for (int i = 0; i < 2; ++i) { int R, C; stage_rc(tid * 16 + i * 8192, R, C); const int Rb = Epi::PERM ? ((R & ~31) + perm32(R & 31)) : R;
    voffA[i] = (unsigned)(R * lda + C) * 2u; voffB[i] = (unsigned)(Rb * K + C) * 2u; }
  const size_t kstep = 128;
  const size_t hstepA = (size_t)128 * lda * 2, tstepA = 2 * hstepA;
  const size_t hstepB = (size_t)128 * K * 2, tstepB = 2 * hstepB;
  const size_t segB = (size_t)segoff * 2;
#define G8_AK(kt) ((size_t)(kt) * 128 + (((kt) >= segkt) ? segB : (size_t)0))
  const unsigned ldsw = (unsigned)wid * 1024u;
  const int aoff = lds_byte(wr * 64 + fr, fq * 8), boff = lds_byte(wc * 32 + fr, fq * 8);
#define G8_SA(b, h) (((b) * 2 + (h)) * HTB)
#define G8_SB(b, h) ((4 + (b) * 2 + (h)) * HTB)
#define G8_STAGE(bufoff, gbase, voff) do { _Pragma("unroll") for (int _i = 0; _i < 2; ++_i) \
    __builtin_amdgcn_global_load_lds((const unsigned*)((const char*)(gbase) + (voff)[_i]), (LAS unsigned*)(lds + (bufoff) + ldsw + _i * 8192), 16, 0, 0); } while (0)
#define G8_LDA(dst, b, h) do { _Pragma("unroll") for (int m = 0; m < 4; ++m) _Pragma("unroll") for (int k = 0; k < 2; ++k) dst[m][k] = *(const LAS bf16x8*)(lds + G8_SA(b, h) + aoff + m * 2048 + k * 1024); } while (0)
#define G8_LDB(dst, b, h) do { _Pragma("unroll") for (int n = 0; n < 2; ++n) _Pragma("unroll") for (int k = 0; k < 2; ++k) dst[n][k] = *(const LAS bf16x8*)(lds + G8_SB(b, h) + boff + n * 2048 + k * 1024); } while (0)
#define G8_MMA(ai, bj, At, Bt_) do { __builtin_amdgcn_s_setprio(1); _Pragma("unroll") for (int m = 0; m < 4; ++m) _Pragma("unroll") for (int n = 0; n < 2; ++n) _Pragma("unroll") for (int k = 0; k < 2; ++k) \
    acc[ai][bj][m][n] = __builtin_amdgcn_mfma_f32_16x16x32_bf16(Bt_[n][k], At[m][k], acc[ai][bj][m][n], 0, 0, 0); __builtin_amdgcn_s_setprio(0); } while (0)
#define G8_WAIT_V(n) asm volatile("s_waitcnt vmcnt(" #n ")" ::: "memory")
#define G8_WAIT_L(n) asm volatile("s_waitcnt lgkmcnt(" #n ")" ::: "memory")
#define G8_BAR __builtin_amdgcn_s_barrier()
#define G8_SCHED __builtin_amdgcn_sched_barrier(0)
  Unit cur, nxt; int ui = 0;
  if (!S.next(0, cur)) return;
  f32x4 acc[2][2][4][2];
#pragma unroll
  for (int a = 0; a < 2; ++a)
#pragma unroll
    for (int b = 0; b < 2; ++b)
#pragma unroll
      for (int m = 0; m < 4; ++m)
#pragma unroll
        for (int n = 0; n < 2; ++n) acc[a][b][m][n] = (f32x4){0.f, 0.f, 0.f, 0.f};
  bf16x8 At[4][2], B0[2][2], B1[2][2];
  const char* cA = (const char*)A + (size_t)cur.pm * tstepA; const char* cB = (const char*)Bt + (size_t)cur.pn * tstepB;
  G8_STAGE(G8_SB(0, 0), cB, voffB); G8_STAGE(G8_SA(0, 0), cA, voffA); G8_STAGE(G8_SB(0, 1), cB + hstepB, voffB); G8_STAGE(G8_SA(0, 1), cA + hstepA, voffA);
  if (wr == 1) G8_BAR;
  G8_WAIT_V(4); G8_BAR;
  G8_STAGE(G8_SB(1, 0), cB + kstep, voffB); G8_STAGE(G8_SA(1, 0), cA + G8_AK(1), voffA); G8_STAGE(G8_SB(1, 1), cB + hstepB + kstep, voffB);
  G8_WAIT_V(6); G8_BAR;
  for (;;) {
    const bool has_next = S.next(ui + 1, nxt);
    const char* nA = has_next ? (const char*)A + (size_t)nxt.pm * tstepA : cA; const char* nB = has_next ? (const char*)Bt + (size_t)nxt.pn * tstepB : cB;
    for (int t = 0; t < nt; t += 2) {
      const bool last = (t == nt - 2);
      const char* a1 = cA + G8_AK(t + 1);
      const char* a2 = last ? nA : cA + G8_AK(t + 2); const char* b2 = last ? nB : cB + (size_t)(t + 2) * kstep;
      const char* a3 = last ? nA + G8_AK(1) : cA + G8_AK(t + 3); const char* b3 = b2 + kstep;
      G8_LDB(B0, 0, 0); G8_SCHED; G8_LDA(At, 0, 0); G8_STAGE(G8_SA(1, 1), a1 + hstepA, voffA);
      G8_WAIT_L(8); G8_BAR; G8_WAIT_L(0); G8_MMA(0, 0, At, B0); G8_BAR; G8_SCHED;
      G8_LDB(B1, 0, 1); G8_STAGE(G8_SB(0, 0), b2, voffB);
      G8_BAR; G8_WAIT_L(0); G8_MMA(0, 1, At, B1); G8_BAR;
      G8_LDA(At, 0, 1); G8_STAGE(G8_SA(0, 0), a2, voffA);
      G8_BAR; G8_WAIT_L(0); G8_MMA(1, 0, At, B0); G8_BAR; G8_SCHED;
      G8_STAGE(G8_SB(0, 1), b2 + hstepB, voffB);
      G8_WAIT_V(6); G8_BAR; G8_MMA(1, 1, At, B1); G8_BAR;
      G8_LDB(B0, 1, 0); G8_SCHED; G8_LDA(At, 1, 0); G8_STAGE(G8_SA(0, 1), a2 + hstepA, voffA);
      G8_WAIT_L(8); G8_BAR; G8_WAIT_L(0); G8_MMA(0, 0, At, B0); G8_BAR; G8_SCHED;
      G8_LDB(B1, 1, 1); G8_STAGE(G8_SB(1, 0), b3, voffB);
      G8_BAR; G8_WAIT_L(0); G8_MMA(0, 1, At, B1); G8_BAR;
      G8_LDA(At, 1, 1); G8_STAGE(G8_SA(1, 0), a3, voffA);
      G8_BAR; G8_WAIT_L(0); G8_MMA(1, 0, At, B0); G8_BAR; G8_SCHED;
      G8_STAGE(G8_SB(1, 1), b3 + hstepB, voffB);
      G8_WAIT_V(6); G8_BAR; G8_MMA(1, 1, At, B1); G8_BAR;
    }
    E(acc, cur, wr, wc, fr, fq);
    if (!has_next) break;
#pragma unroll
    for (int a = 0; a < 2; ++a)
#pragma unroll
      for (int b = 0; b < 2; ++b)
#pragma unroll
        for (int m = 0; m < 4; ++m)
#pragma unroll
          for (int n = 0; n < 2; ++n) acc[a][b][m][n] = (f32x4){0.f, 0.f, 0.f, 0.f};
    cur = nxt; cA = nA; cB = nB; ++ui;
  }
  G8_WAIT_V(0);
  if (wr == 0) G8_BAR;
  G8_BAR;
#undef G8_AK
#undef G8_SA
#undef G8_SB
#undef G8_STAGE
#undef G8_LDA
#undef G8_LDB
#undef G8_MMA
#undef G8_WAIT_V
#undef G8_WAIT_L
#undef G8_BAR
#undef G8_SCHED
}
}

__device__ void xrow_unit(const Params& p, int unit) {
  const int tid_ = otid(); const int wid = tid_ >> 6, lane = tid_ & 63;
  f32x4 v[2][4];
#pragma unroll
  for (int r = 0; r < 2; ++r) {
    const int row = unit * 16 + r * 8 + wid;
    const float* src = (row < TP) ? (p.x_prompt + (size_t)row * 1024) : (p.x_sample + (size_t)(row - TP) * 1024);
#pragma unroll
    for (int i = 0; i < 4; ++i) v[r][i] = *(const f32x4*)(src + i * 256 + lane * 4);
  }
#pragma unroll
  for (int r = 0; r < 2; ++r) {
    const int row = unit * 16 + r * 8 + wid;
    float s = 0.f;
#pragma unroll
    for (int i = 0; i < 4; ++i) {
      const f32x4 x = v[r][i];
      s += x[0] * x[0] + x[1] * x[1] + x[2] * x[2] + x[3] * x[3];
      u32x2 o; o.x = pk2(x[0], x[1]); o.y = pk2(x[2], x[3]);
      *(u32x2*)(p.xb + (size_t)row * 1024 + i * 256 + lane * 4) = o;
    }
#pragma unroll
    for (int o = 32; o >= 1; o >>= 1) s += __shfl_xor(s, o);
    if (lane < 16) p.sumsq[(size_t)row * 16 + lane] = (lane == 0) ? s : 0.f;
  }
}

__device__ void transpose_unit(LAS unsigned char* lds, const float* src, int ldsrc, const float* scale, int nscale,
                               bf16_t* dst, int ldd, int kt, int ntile, int mode) {
  LAS float* tl = (LAS float*)lds;
  const int tid = otid();
  const int k0 = kt * 64, n0 = ntile * 64;
  f32x4 v[2];
#pragma unroll
  for (int i = 0; i < 2; ++i) {
    const int idx = tid + i * 512, kk = idx >> 4, n4 = (idx & 15) * 4;
    const int np = n0 + n4;
    int sc = np;
    if (mode == 0) { sc = (np < 3072) ? np : (np < 5120) ? (np + 16) : (np < 5136) ? (np - 5120 + 3072) : -1; }
    f32x4 x = (f32x4){0.f, 0.f, 0.f, 0.f};
    if (sc >= 0) {
      x = *(const f32x4*)(src + (size_t)(k0 + kk) * ldsrc + sc);
      if (scale && (k0 + kk) < nscale) x = x * scale[k0 + kk];
    }
    v[i] = x;
  }
#pragma unroll
  for (int i = 0; i < 2; ++i) {
    const int idx = tid + i * 512, kk = idx >> 4, n4 = (idx & 15) * 4;
#pragma unroll
    for (int j = 0; j < 4; ++j) tl[kk * 65 + n4 + j] = v[i][j];
  }
  __syncthreads();
  {
    const int nn = tid >> 3, kk0 = (tid & 7) * 8;
    float t[8];
#pragma unroll
    for (int j = 0; j < 8; ++j) t[j] = tl[(kk0 + j) * 65 + nn];
    *(u32x4*)(dst + (size_t)(n0 + nn) * ldd + k0 + kk0) = (u32x4){pk2(t[0], t[1]), pk2(t[2], t[3]), pk2(t[4], t[5]), pk2(t[6], t[7])};
  }
  __syncthreads();
}

__device__ __forceinline__ double exp_d(double x) {
  const double k = rint(x * 1.4426950408889634);
  const double r = fma(-k, 0.6931471805599453, x) - k * 2.3190468138462996e-17;
  double s = 1.0 / 6227020800.0;
  s = fma(s, r, 1.0 / 479001600.0); s = fma(s, r, 1.0 / 39916800.0); s = fma(s, r, 1.0 / 3628800.0);
  s = fma(s, r, 1.0 / 362880.0); s = fma(s, r, 1.0 / 40320.0); s = fma(s, r, 1.0 / 5040.0);
  s = fma(s, r, 1.0 / 720.0); s = fma(s, r, 1.0 / 120.0); s = fma(s, r, 1.0 / 24.0);
  s = fma(s, r, 1.0 / 6.0); s = fma(s, r, 0.5); s = fma(s, r, 1.0); s = fma(s, r, 1.0);
  return ldexp(s, (int)k);
}
__device__ __forceinline__ void sincos_d(double x, double& sn, double& cs) {
  const double k = rint(x * 0.6366197723675814);
  double r = fma(-k, 1.5707963267948966, x); r = fma(-k, 6.123233995736766e-17, r);
  const int q = ((int)k) & 3;
  const double r2 = r * r;
  double sp = 1.0 / 1307674368000.0;
  sp = fma(sp, r2, -1.0 / 6227020800.0); sp = fma(sp, r2, 1.0 / 39916800.0); sp = fma(sp, r2, -1.0 / 362880.0);
  sp = fma(sp, r2, 1.0 / 5040.0); sp = fma(sp, r2, -1.0 / 120.0); sp = fma(sp, r2, 1.0 / 6.0);
  sp = r - r * r2 * sp;
  double cp = 1.0 / 20922789888000.0;
  cp = fma(cp, r2, -1.0 / 87178291200.0); cp = fma(cp, r2, 1.0 / 479001600.0); cp = fma(cp, r2, -1.0 / 3628800.0);
  cp = fma(cp, r2, 1.0 / 40320.0); cp = fma(cp, r2, -1.0 / 720.0); cp = fma(cp, r2, 1.0 / 24.0); cp = fma(cp, r2, -0.5);
  cp = fma(cp, r2, 1.0);
  sn = (q == 0) ? sp : (q == 1) ? cp : (q == 2) ? -sp : -cp;
  cs = (q == 0) ? cp : (q == 1) ? -sp : (q == 2) ? -cp : sp;
}

__device__ void s5prep_unit(LAS unsigned char* lds, const Params& p, int l, int g) {
  LAS float* cf = (LAS float*)lds;
  const int tid = otid();
  const int lg = l * 64 + g;
  if (tid < 64) {
    const double dt = exp_d((double)p.log_dt[lg]);
    const double lr = (double)p.lam_re[lg * 64 + tid], li = (double)p.lam_im[lg * 64 + tid];
    const double e = exp_d(lr * dt);
    double sn, cs; sincos_d(li * dt, sn, cs);
    const double lbr = e * cs, lbi = e * sn;
    const double nr = lbr - 1.0, ni = lbi;
    const double den = lr * lr + li * li;
    const double cr = (nr * lr + ni * li) / den, ci = (ni * lr - nr * li) / den;
    p.lamb[(size_t)(lg * 64 + tid) * 2 + 0] = (float)lbr;
    p.lamb[(size_t)(lg * 64 + tid) * 2 + 1] = (float)lbi;
    cf[tid * 2 + 0] = (float)cr; cf[tid * 2 + 1] = (float)ci;
  }
  __syncthreads();
#pragma unroll
  for (int i = 0; i < 4; ++i) {
    const int idx = tid * 4 + i;
    {
      const int pp = idx >> 4, c = idx & 15, st = pp & 63;
      const float br = p.b_re[((size_t)lg * 64 + st) * 16 + c], bi = p.b_im[((size_t)lg * 64 + st) * 16 + c];
      const float cr = cf[st * 2], ci = cf[st * 2 + 1];
      const float v = (pp < 64) ? (cr * br - ci * bi) : (cr * bi + ci * br);
      p.BbT[(size_t)lg * 2048 + idx] = (bf16_t)(pk2(v, v) & 0xffffu);
    }
    {
      const int c = idx >> 7, pp = idx & 127, st = pp & 63;
      const float v = (pp < 64) ? p.c_re[((size_t)lg * 16 + c) * 64 + st] : -p.c_im[((size_t)lg * 16 + c) * 64 + st];
      p.CmT[(size_t)lg * 2048 + idx] = (bf16_t)(pk2(v, v) & 0xffffu);
    }
  }
  __syncthreads();
}

__device__ void phase_prep(LAS unsigned char* lds, const Params& p) {
  constexpr int U_X = 2080, U_WIN = 5376, U_WGLU = 1024, U_WOUT = 2048, U_S5 = 256;
  constexpr int TOTAL = U_X + U_WIN + U_WGLU + U_WOUT + U_S5;
  for (int u = blockIdx.x; u < TOTAL; u += gridDim.x) {
    int idx = u;
    if (idx < U_X) { xrow_unit(p, idx); continue; }
    idx -= U_X;
    if (idx < U_WIN) {
      const int l = idx / 1344, r = idx % 1344, ntile = r / 16, kt = r % 16;
      transpose_unit(lds, p.w_in + (size_t)l * 1024 * 5136, 5136, p.norm_g + l * 1024, 1024,
                     p.WinT + (size_t)l * 5376 * 1024, 1024, kt, ntile, 0);
      continue;
    }
    idx -= U_WIN;
    if (idx < U_WGLU) {
      const int l = idx / 256, r = idx % 256, ntile = r / 16, kt = r % 16;
      transpose_unit(lds, p.w_glu + (size_t)l * 1024 * 1024, 1024, nullptr, 0, p.WgluT + (size_t)l * 1024 * 1024, 1024, kt, ntile, 1);
      continue;
    }
    idx -= U_WGLU;
    if (idx < U_WOUT) {
      const int l = idx / 512, r = idx % 512, ntile = r / 32, kt = r % 32;
      transpose_unit(lds, p.w_out + (size_t)l * 2048 * 1024, 1024, p.ssd_norm_g + l * 1024, 1024,
                     p.WoutT + (size_t)l * 1024 * 2048, 2048, kt, ntile, 2);
      continue;
    }
    idx -= U_WOUT;
    s5prep_unit(lds, p, idx / 64, idx % 64);
  }
}

constexpr int CM_OFF = 0, BM_OFF = 17408, BMT_OFF = 34816, XDT_OFF = 53248, XW_OFF = 62464, MM_OFF = 71680,
              HB_OFF = 80896, XS_OFF = 98304, ACS_OFF = 107520, DTV_OFF = 115712, SSQ_OFF = 123904, CW_OFF = 124416;

__device__ __forceinline__ bf16x8 ldfrag(LAS unsigned char* lds, int off, int row, int stride, int col) {
  return *(const LAS bf16x8*)(lds + off + (row * stride + col) * 2);
}

template <int NCH>
__device__ __forceinline__ void conv_load_rows(unsigned (&rows)[7][NCH / 2], const bf16_t* proj, const float* stc, int tok0, int c, int s0, int ccol) {
#pragma unroll
  for (int i = 0; i < 7; ++i) {
    const int pos = c * 64 + s0 - 3 + i;
    if (pos >= 0) {
      const bf16_t* q = proj + (size_t)(tok0 + pos) * LDP + C_XBC + ccol;
      if (NCH == 8) { const u32x4 v = *(const u32x4*)q; rows[i][0] = v[0]; rows[i][1] = v[1]; rows[i][NCH / 2 - 2] = v[2]; rows[i][NCH / 2 - 1] = v[3]; }
      else rows[i][0] = *(const unsigned*)q;
    } else if (stc) {
      const float* sp = stc + (size_t)(3 + pos) * 2048 + ccol;
#pragma unroll
      for (int k = 0; k < NCH / 2; ++k) rows[i][k] = pk2(sp[2 * k], sp[2 * k + 1]);
    } else {
#pragma unroll
      for (int k = 0; k < NCH / 2; ++k) rows[i][k] = 0u;
    }
  }
}
template <int NCH>
__device__ __forceinline__ void conv_load_rows_fast(unsigned (&rows)[7][NCH / 2], const bf16_t* proj, int tok0, int c, int s0, int ccol) {
  const bf16_t* q0 = proj + (size_t)(tok0 + c * 64 + s0 - 3) * LDP + C_XBC + ccol;
#pragma unroll
  for (int i = 0; i < 7; ++i) {
    const bf16_t* q = q0 + (size_t)i * LDP;
    if (NCH == 8) { const u32x4 v = *(const u32x4*)q; rows[i][0] = v[0]; rows[i][1] = v[1]; rows[i][NCH / 2 - 2] = v[2]; rows[i][NCH / 2 - 1] = v[3]; }
    else rows[i][0] = *(const unsigned*)q;
  }
}
template <int NCH>
__device__ __forceinline__ void conv_store_row(LAS unsigned char* addr, const float* o) {
  if (NCH == 8) *(LAS u32x4*)addr = (u32x4){pk2(o[0], o[1]), pk2(o[2], o[3]), pk2(o[NCH - 4], o[NCH - 3]), pk2(o[NCH - 2], o[NCH - 1])};
  else *(LAS unsigned*)addr = pk2(o[0], o[1]);
}
template <int NCH>
__device__ __forceinline__ void conv_unit(LAS unsigned char* lds, const unsigned (&rows)[7][NCH / 2], const LAS float* wl,
                                          int oct, int chq, int s0, const LAS float* acs, const LAS float* dtv) {
  float o[4][NCH];
  float w[4][NCH], bs[NCH];
#pragma unroll
  for (int e = 0; e < NCH; ++e) { bs[e] = wl[32 + e];
#pragma unroll
    for (int k = 0; k < 4; ++k) w[k][e] = wl[k * 8 + e]; }
#pragma unroll
  for (int e = 0; e < NCH; ++e) {
    float xv[7];
#pragma unroll
    for (int i = 0; i < 7; ++i) xv[i] = (e & 1) ? hi_f(rows[i][e >> 1]) : lo_f(rows[i][e >> 1]);
#pragma unroll
    for (int j = 0; j < 4; ++j) o[j][e] = siluf(bs[e] + w[0][e] * xv[j] + w[1][e] * xv[j + 1] + w[2][e] * xv[j + 2] + w[3][e] * xv[j + 3]);
  }
  if (oct < 8) {
    float dts[4], wsc[4];
    const float aend = acs[63];
#pragma unroll
    for (int j = 0; j < 4; ++j) { dts[j] = dtv[s0 + j]; wsc[j] = dts[j] * __expf(aend - acs[s0 + j]); }
    const int p0 = oct * 8 + chq;
#pragma unroll
    for (int j = 0; j < 4; ++j) conv_store_row<NCH>(lds + XS_OFF + ((s0 + j) * 72 + p0) * 2, o[j]);
#pragma unroll
    for (int e = 0; e < NCH; ++e) {
      *(LAS u32x2*)(lds + XDT_OFF + ((p0 + e) * 72 + s0) * 2) = (u32x2){pk2(o[0][e] * dts[0], o[1][e] * dts[1]), pk2(o[2][e] * dts[2], o[3][e] * dts[3])};
      *(LAS u32x2*)(lds + XW_OFF + ((p0 + e) * 72 + s0) * 2) = (u32x2){pk2(o[0][e] * wsc[0], o[1][e] * wsc[1]), pk2(o[2][e] * wsc[2], o[3][e] * wsc[3])};
    }
  } else if (oct < 24) {
    const int n0 = (oct - 8) * 8 + chq;
#pragma unroll
    for (int j = 0; j < 4; ++j) conv_store_row<NCH>(lds + BM_OFF + ((s0 + j) * 136 + n0) * 2, o[j]);
#pragma unroll
    for (int e = 0; e < NCH; ++e) *(LAS u32x2*)(lds + BMT_OFF + ((n0 + e) * 72 + s0) * 2) = (u32x2){pk2(o[0][e], o[1][e]), pk2(o[2][e], o[3][e])};
  } else {
    const int n0 = (oct - 24) * 8 + chq;
#pragma unroll
    for (int j = 0; j < 4; ++j) conv_store_row<NCH>(lds + CM_OFF + ((s0 + j) * 136 + n0) * 2, o[j]);
  }
}

__device__ void ssd_item(LAS unsigned char* lds, const Params& p, int l, int b, int h, bool smp) {
  const int tid = otid(), wid = tid >> 6, lane = tid & 63, fr = lane & 15, fq = lane >> 4;
  const int g = h >> 2;
  const int tok0 = smp ? (TP + b * 64) : (b * 2048);
  const int nchunk = smp ? 1 : 32;
  const int NB = smp ? 8 : 16;
  bf16_t* proj = p.proj;
  LAS float* acs_all = (LAS float*)(lds + ACS_OFF);
  LAS float* dtv_all = (LAS float*)(lds + DTV_OFF);
  LAS float* ssq = (LAS float*)(lds + SSQ_OFF);
  const float dtb = p.dt_bias[l * 16 + h];
  const float Aneg = -__expf(p.a_log[l * 16 + h]);
  const float Dh = p.d_ssd[l * 16 + h];

  f32x4 hacc[4];
#pragma unroll
  for (int pt = 0; pt < 4; ++pt) {
    if (smp) hacc[pt] = *(const f32x4*)(p.st_ssd + ((((size_t)l * 8 + b) * 16 + h) * 64 + pt * 16 + fr) * 128 + wid * 16 + fq * 4);
    else hacc[pt] = (f32x4){0.f, 0.f, 0.f, 0.f};
  }

  const float* stc = smp ? (p.st_conv + ((size_t)l * 8 + b) * 3 * 2048) : nullptr;
  int octA, s0A;
  if (tid < 128) { octA = tid & 7; s0A = (tid >> 3) * 4; }
  else if (tid < 384) { const int i = tid - 128; octA = 8 + (i & 15); s0A = (i >> 4) * 4; }
  else { const int i = tid - 384; octA = 24 + (i & 15); s0A = (i >> 4) * 4; }
  const int jB = tid >> 2, octB = 24 + (jB & 15), s0B = (8 + (jB >> 4)) * 4, chqB = (tid & 3) * 2;
  const int cchA = (octA < 8) ? (h * 64 + octA * 8) : (octA < 24) ? (1024 + g * 128 + (octA - 8) * 8) : (1536 + g * 128 + (octA - 24) * 8);
  const int cchB = ((octB < 8) ? (h * 64 + octB * 8) : (octB < 24) ? (1024 + g * 128 + (octB - 8) * 8) : (1536 + g * 128 + (octB - 24) * 8)) + chqB;
  LAS float* cwl = (LAS float*)(lds + CW_OFF);
  {
    const float* cw = p.conv_w + (size_t)l * 4 * 2048;
    const float* cb = p.conv_b + (size_t)l * 2048;
    for (int idx = tid; idx < 1600; idx += 512) {
      const int oc = idx / 40, r = idx % 40, k = r >> 3, e = r & 7;
      const int cc = ((oc < 8) ? (h * 64 + oc * 8) : (oc < 24) ? (1024 + g * 128 + (oc - 8) * 8) : (1536 + g * 128 + (oc - 24) * 8)) + e;
      cwl[idx] = (k < 4) ? cw[k * 2048 + cc] : cb[cc];
    }
  }
  unsigned rowsA[7][4], rowsB[7][1];
  conv_load_rows<8>(rowsA, proj, stc, tok0, 0, s0A, cchA);
  conv_load_rows<2>(rowsB, proj, stc, tok0, 0, s0B, cchB);
  for (int c = wid; c < nchunk; c += 8) {
    const float dtr = bf2f(proj[(size_t)(tok0 + c * 64 + lane) * LDP + C_DT + h]);
    const float xx = dtr + dtb;
    const float dt = xx > 20.f ? xx : log1pf(__expf(xx));
    float cs = dt * Aneg;
#pragma unroll
    for (int o = 1; o < 64; o <<= 1) { const float v = __shfl_up(cs, o); if (lane >= o) cs += v; }
    acs_all[c * 64 + lane] = cs; dtv_all[c * 64 + lane] = dt;
  }
  LDS_BARRIER();
  for (int c = 0; c < nchunk; ++c) {
    const int ctok = tok0 + c * 64;
    const LAS float* acs = acs_all + c * 64;
    const LAS float* dtv = dtv_all + c * 64;
    u32x2 z4v[2];
    {
      const int lt_ = wid >> 1, ptb_ = (wid & 1) * 2;
#pragma unroll
      for (int q = 0; q < 2; ++q) z4v[q] = *(const u32x2*)(proj + (size_t)(ctok + lt_ * 16 + fr) * LDP + C_ZA + h * 64 + (ptb_ + q) * 16 + fq * 4);
    }
    conv_unit<8>(lds, rowsA, cwl + octA * 40, octA, 0, s0A, acs, dtv);
    conv_unit<2>(lds, rowsB, cwl + octB * 40 + chqB, octB, chqB, s0B, acs, dtv);
    if (c + 1 < nchunk) {
      conv_load_rows_fast<8>(rowsA, proj, tok0, c + 1, s0A, cchA);
      conv_load_rows_fast<2>(rowsB, proj, tok0, c + 1, s0B, cchB);
    }
#pragma unroll
    for (int pt = 0; pt < 4; ++pt)
      *(LAS u32x2*)(lds + HB_OFF + ((pt * 16 + fr) * 136 + wid * 16 + fq * 4) * 2) =
          (u32x2){pk2(hacc[pt][0], hacc[pt][1]), pk2(hacc[pt][2], hacc[pt][3])};
    LDS_BARRIER();
    const int lt = wid >> 1, ptb = (wid & 1) * 2;
    {
      const int st = wid >> 1, ltb = (wid & 1) * 2;
      bf16x8 bfr[4];
#pragma unroll
      for (int ks = 0; ks < 4; ++ks) bfr[ks] = ldfrag(lds, BM_OFF, st * 16 + fr, 136, ks * 32 + fq * 8);
#pragma unroll
      for (int q = 0; q < 2; ++q) {
        const int ltq = ltb + q;
        f32x4 a = (f32x4){0.f, 0.f, 0.f, 0.f};
#pragma unroll
        for (int ks = 0; ks < 4; ++ks) a = mfma16(bfr[ks], ldfrag(lds, CM_OFF, ltq * 16 + fr, 136, ks * 32 + fq * 8), a);
        const int l_ = ltq * 16 + fr;
        const float al = acs[l_];
        float mv[4];
#pragma unroll
        for (int r = 0; r < 4; ++r) { const int s_ = st * 16 + fq * 4 + r; const float ex = __expf(al - acs[s_]); mv[r] = (s_ <= l_) ? a[r] * ex : 0.f; }
        *(LAS u32x2*)(lds + MM_OFF + (l_ * 72 + st * 16 + fq * 4) * 2) = (u32x2){pk2(mv[0], mv[1]), pk2(mv[2], mv[3])};
      }
    }
    f32x4 accI[2];
    accI[0] = (f32x4){0.f, 0.f, 0.f, 0.f}; accI[1] = accI[0];
#pragma unroll
    for (int ks = 0; ks < 4; ++ks) {
      const bf16x8 cfr = ldfrag(lds, CM_OFF, lt * 16 + fr, 136, ks * 32 + fq * 8);
#pragma unroll
      for (int q = 0; q < 2; ++q) accI[q] = mfma16(ldfrag(lds, HB_OFF, (ptb + q) * 16 + fr, 136, ks * 32 + fq * 8), cfr, accI[q]);
    }
    {
      const float dec = __expf(acs[63]);
      bf16x8 bt[2];
#pragma unroll
      for (int ks = 0; ks < 2; ++ks) bt[ks] = ldfrag(lds, BMT_OFF, wid * 16 + fr, 72, ks * 32 + fq * 8);
#pragma unroll
      for (int pt = 0; pt < 4; ++pt) {
        hacc[pt] = hacc[pt] * dec;
#pragma unroll
        for (int ks = 0; ks < 2; ++ks) hacc[pt] = mfma16(bt[ks], ldfrag(lds, XW_OFF, pt * 16 + fr, 72, ks * 32 + fq * 8), hacc[pt]);
      }
    }
    LDS_BARRIER();
    {
      f32x4 accY[2];
      accY[0] = (f32x4){0.f, 0.f, 0.f, 0.f}; accY[1] = accY[0];
#pragma unroll
      for (int ks = 0; ks < 2; ++ks) {
        const bf16x8 mf = ldfrag(lds, MM_OFF, lt * 16 + fr, 72, ks * 32 + fq * 8);
#pragma unroll
        for (int q = 0; q < 2; ++q) accY[q] = mfma16(ldfrag(lds, XDT_OFF, (ptb + q) * 16 + fr, 72, ks * 32 + fq * 8), mf, accY[q]);
      }
      const int l_ = lt * 16 + fr;
      const float el = __expf(acs[l_]);
      float sq = 0.f;
#pragma unroll
      for (int q = 0; q < 2; ++q) {
        const int p0 = (ptb + q) * 16 + fq * 4;
        const u32x2 xs4 = *(const LAS u32x2*)(lds + XS_OFF + (l_ * 72 + p0) * 2);
        bf16_t* zp = proj + (size_t)(ctok + l_) * LDP + C_ZA + h * 64 + p0;
        const u32x2 z4 = z4v[q];
        const float y0 = (accY[q][0] + el * accI[q][0] + Dh * lo_f(xs4.x)) * siluf(lo_f(z4.x));
        const float y1 = (accY[q][1] + el * accI[q][1] + Dh * hi_f(xs4.x)) * siluf(hi_f(z4.x));
        const float y2 = (accY[q][2] + el * accI[q][2] + Dh * lo_f(xs4.y)) * siluf(lo_f(z4.y));
        const float y3 = (accY[q][3] + el * accI[q][3] + Dh * hi_f(xs4.y)) * siluf(hi_f(z4.y));
        sq += y0 * y0 + y1 * y1 + y2 * y2 + y3 * y3;
        *(u32x2*)zp = (u32x2){pk2(y0, y1), pk2(y2, y3)};
      }
      sq += __shfl_xor(sq, 16); sq += __shfl_xor(sq, 32);
      if (fq == 0) ssq[(wid & 1) * 64 + l_] = sq;
    }
    LDS_BARRIER();
    if (tid < 64) p.ssqa[(size_t)(ctok + tid) * 16 + h] = ssq[tid] + ssq[64 + tid];
  }
  {
    float* so = p.out + (smp ? O_SSDS : O_SSDP);
#pragma unroll
    for (int pt = 0; pt < 4; ++pt)
      *(f32x4*)(so + ((((size_t)l * NB + b) * 16 + h) * 64 + pt * 16 + fr) * 128 + wid * 16 + fq * 4) = hacc[pt];
    float* co = p.out + (smp ? O_CONVS : O_CONVP);
    const int L = smp ? 64 : 2048;
    for (int i = tid; i < 3 * 320; i += 512) {
      const int r = i / 320, cc = i % 320;
      if (cc >= 64 && (h & 3)) continue;
      const int ch = (cc < 64) ? (h * 64 + cc) : (cc < 192) ? (1024 + g * 128 + (cc - 64)) : (1536 + g * 128 + (cc - 192));
      co[(((size_t)l * NB + b) * 3 + r) * 2048 + ch] = bf2f(proj[(size_t)(tok0 + L - 3 + r) * LDP + C_XBC + ch]);
    }
  }
  __syncthreads();
}

__device__ __forceinline__ float fma_asm(float a, float b, float c) { float d; asm volatile("v_fma_f32 %0, %1, %2, %3" : "=v"(d) : "v"(a), "v"(b), "v"(c)); return d; }
__device__ void s5_seq(LAS unsigned char* lds, const Params& p, int l, int b, int g, bool smp) {
  const int tid_ = otid(); const int wid = tid_ >> 6, lane = tid_ & 63, fr = lane & 15, fq = lane >> 4;
  LAS float* buf = (LAS float*)(lds + wid * 16896);
  const int tok0 = smp ? (TP + b * 64) : (b * 2048);
  const int nblk = smp ? 2 : 64;
  const int NB = smp ? 8 : 16;
  const int lg = l * 64 + g;
  bf16x8 Bfrag[4], Cfrag[4];
#pragma unroll
  for (int nt = 0; nt < 4; ++nt) Bfrag[nt] = *(const bf16x8*)(p.BbT + ((size_t)lg * 128 + nt * 32 + (lane & 31)) * 16 + 8 * (lane >> 5));
#pragma unroll
  for (int ks = 0; ks < 4; ++ks) Cfrag[ks] = *(const bf16x8*)(p.CmT + ((size_t)lg * 16 + fr) * 128 + ks * 32 + fq * 8);
  const float lr = p.lamb[(size_t)(lg * 64 + lane) * 2], li = p.lamb[(size_t)(lg * 64 + lane) * 2 + 1];
  const float nli = -li;
  float hr = 0.f, hi = 0.f;
  if (smp) { hr = p.st_s5re[(((size_t)l * 8 + b) * 64 + g) * 64 + lane]; hi = p.st_s5im[(((size_t)l * 8 + b) * 64 + g) * 64 + lane]; }
  const f32x4 d4 = *(const f32x4*)(p.d_s5 + l * 1024 + g * 16 + fq * 4);
  const bf16_t* ubase = p.proj + C_U + g * 16;
  bf16x8 a_next = *(const bf16x8*)(ubase + (size_t)(tok0 + (lane & 31)) * LDP + 8 * (lane >> 5));
  for (int blk = 0; blk < nblk; ++blk) {
    const bf16x8 a = a_next;
    if (blk + 1 < nblk) a_next = *(const bf16x8*)(ubase + (size_t)(tok0 + (blk + 1) * 32 + (lane & 31)) * LDP + 8 * (lane >> 5));
    u32x2 u4v[2];
#pragma unroll
    for (int mt = 0; mt < 2; ++mt) u4v[mt] = *(const u32x2*)(ubase + (size_t)(tok0 + blk * 32 + mt * 16 + fr) * LDP + fq * 4);
    float bre[32], bim[32];
    {
      f32x16 d[4];
#pragma unroll
      for (int nt = 0; nt < 4; ++nt) {
        f32x16 z = {0.f, 0.f, 0.f, 0.f, 0.f, 0.f, 0.f, 0.f, 0.f, 0.f, 0.f, 0.f, 0.f, 0.f, 0.f, 0.f};
        d[nt] = __builtin_amdgcn_mfma_f32_32x32x16_bf16(a, Bfrag[nt], z, 0, 0, 0);
      }
#pragma unroll
      for (int r = 0; r < 16; ++r) {
        const int tA = (r & 3) + 8 * (r >> 2);
        const auto sr = __builtin_amdgcn_permlane32_swap(__float_as_uint(d[0][r]), __float_as_uint(d[1][r]), false, false);
        bre[tA] = __uint_as_float(sr[0]); bre[tA + 4] = __uint_as_float(sr[1]);
        const auto si = __builtin_amdgcn_permlane32_swap(__float_as_uint(d[2][r]), __float_as_uint(d[3][r]), false, false);
        bim[tA] = __uint_as_float(si[0]); bim[tA + 4] = __uint_as_float(si[1]);
      }
    }
#pragma unroll
    for (int t = 0; t < 32; ++t) {
      float nr = fma_asm(lr, hr, bre[t]); nr = fma_asm(nli, hi, nr);
      float ni = fma_asm(lr, hi, bim[t]); ni = fma_asm(li, hr, ni);
      hr = nr; hi = ni;
      buf[t * 132 + lane] = hr; buf[t * 132 + 64 + lane] = hi;
    }
    asm volatile("s_waitcnt lgkmcnt(0)" ::: "memory");
#pragma unroll
    for (int mt = 0; mt < 2; ++mt) {
      f32x4 acc = (f32x4){0.f, 0.f, 0.f, 0.f};
#pragma unroll
      for (int ks = 0; ks < 4; ++ks) {
        const LAS float* hp = buf + (mt * 16 + fr) * 132 + ks * 32 + fq * 8;
        const f32x4 h0 = *(const LAS f32x4*)hp, h1 = *(const LAS f32x4*)(hp + 4);
        u32x4 hw = (u32x4){pk2(h0[0], h0[1]), pk2(h0[2], h0[3]), pk2(h1[0], h1[1]), pk2(h1[2], h1[3])};
        bf16x8 hf = __builtin_bit_cast(bf16x8, hw);
        acc = mfma16(Cfrag[ks], hf, acc);
      }
      const size_t trow = (size_t)(tok0 + blk * 32 + mt * 16 + fr);
      const u32x2 u4 = u4v[mt];
      const float y0 = gelu_tanh(acc[0] + d4[0] * lo_f(u4.x));
      const float y1 = gelu_tanh(acc[1] + d4[1] * hi_f(u4.x));
      const float y2 = gelu_tanh(acc[2] + d4[2] * lo_f(u4.y));
      const float y3 = gelu_tanh(acc[3] + d4[3] * hi_f(u4.y));
      *(u32x2*)(p.xb + trow * 1024 + g * 16 + fq * 4) = (u32x2){pk2(y0, y1), pk2(y2, y3)};
    }
    asm volatile("" ::: "memory");
  }
  p.out[(smp ? O_S5RES : O_S5REP) + (((size_t)l * NB + b) * 64 + g) * 64 + lane] = hr;
  p.out[(smp ? O_S5IMS : O_S5IMP) + (((size_t)l * NB + b) * 64 + g) * 64 + lane] = hi;
}

__device__ void phase_mixer(LAS unsigned char* lds, const Params& p, int l) {
  const int wid = otid() >> 6;
  for (int u = blockIdx.x; u < 768; u += gridDim.x) {
    if (u < 256) {
      const int x = u & 7, j = u >> 3, G = x * 8 + (j >> 2);
      ssd_item(lds, p, l, G >> 2, (G & 3) * 4 + (j & 3), false);
    }
    else if (u < 512) { if (wid < 4) { const int seq = (u - 256) * 4 + wid; s5_seq(lds, p, l, seq >> 6, seq & 63, false); } }
    else if (u < 640) {
      const int v = u - 512, x = v & 7, j = v >> 3, G = x * 4 + (j >> 2);
      ssd_item(lds, p, l, G >> 2, (G & 3) * 4 + (j & 3), true);
    }
    else { if (wid < 4) { const int seq = (u - 640) * 4 + wid; s5_seq(lds, p, l, seq >> 6, seq & 63, true); } }
    __syncthreads();
  }
}

__device__ void norm_unit(const Params& p, int nu) {
  const int tid = otid();
  const int tok = nu * 32 + (tid >> 4), hh = tid & 15, gg = hh >> 2;
  const f32x4 s4 = *(const f32x4*)(p.ssqa + (size_t)tok * 16 + gg * 4);
  const float rs = rsqrtf((s4[0] + s4[1] + s4[2] + s4[3]) * (1.f / 256.f) + 1e-6f);
  bf16_t* q = p.proj + (size_t)tok * LDP + C_ZA + hh * 64;
#pragma unroll
  for (int i = 0; i < 8; ++i) {
    u32x4 v = *(u32x4*)(q + i * 8);
#pragma unroll
    for (int k = 0; k < 4; ++k) v[k] = pk2(lo_f(v[k]) * rs, hi_f(v[k]) * rs);
    *(u32x4*)(q + i * 8) = v;
  }
}

__device__ void final_unit(const Params& p, int unit) {
  const int tid_ = otid(); const int wid = tid_ >> 6, lane = tid_ & 63;
  const int row = unit * 8 + wid;
  const f32x4* sp = (const f32x4*)(p.sumsq + ((size_t)4 * T_TOK + row) * 16);
  const f32x4 s0 = sp[0], s1 = sp[1], s2 = sp[2], s3 = sp[3];
  const float ss = ((s0[0] + s0[1]) + (s0[2] + s0[3])) + ((s1[0] + s1[1]) + (s1[2] + s1[3])) +
                   ((s2[0] + s2[1]) + (s2[2] + s2[3])) + ((s3[0] + s3[1]) + (s3[2] + s3[3]));
  const float rs = rsqrtf(ss * (1.f / 1024.f) + 1e-6f);
  float* xr = p.out + (size_t)row * 1024;
#pragma unroll
  for (int i = 0; i < 4; ++i) {
    const int c = i * 256 + lane * 4;
    const f32x4 v = *(const f32x4*)(xr + c);
    const f32x4 gv = *(const f32x4*)(p.final_g + c);
    *(f32x4*)(xr + c) = v * rs * gv;
  }
}

__device__ __forceinline__ void grid_barrier(cg::grid_group& grid, unsigned* ctr, unsigned target) {
  asm volatile("s_waitcnt vmcnt(0) lgkmcnt(0)" ::: "memory");
  __syncthreads();
  if (target == gridDim.x) grid.sync();
  if (threadIdx.x == 0) {
    __builtin_amdgcn_fence(__ATOMIC_RELEASE, "agent");
    asm volatile("s_waitcnt vmcnt(0)" ::: "memory");
    __hip_atomic_fetch_add(ctr, 1u, __ATOMIC_RELAXED, __HIP_MEMORY_SCOPE_AGENT);
    while (__hip_atomic_load(ctr, __ATOMIC_RELAXED, __HIP_MEMORY_SCOPE_AGENT) < target) __builtin_amdgcn_s_sleep(1);
    __builtin_amdgcn_fence(__ATOMIC_ACQUIRE, "agent");
    asm volatile("s_waitcnt vmcnt(0)" ::: "memory");
  }
  __syncthreads();
}

__global__ void __launch_bounds__(NTHREADS) mega(Params p) {
  __shared__ __attribute__((aligned(1024))) unsigned char shm[LDS_BYTES];
  LAS unsigned char* lds = (LAS unsigned char*)shm;
  cg::grid_group grid = cg::this_grid();
  phase_prep(lds, p);
  grid_barrier(grid, p.bar, gridDim.x);
  for (int ph = 1; ph < p.phase_end; ++ph) {
    if (ph == 17) {
      for (int u = blockIdx.x; u < 4160; u += gridDim.x) final_unit(p, u);
    } else {
      const int l = (ph - 1) >> 2, sub = (ph - 1) & 3;
      if (sub == 0) {
        g8::EpiIn8 e{p.proj, p.sumsq + (size_t)l * T_TOK * 16};
        g8::Order S{NMT * 21, 21};
        g8::gemm_phase8(lds, p.xb, 1024, 1 << 30, 0, p.WinT + (size_t)l * 5376 * 1024, 1024, S, e);
      } else if (sub == 1) {
        phase_mixer(lds, p, l);
      } else if (sub == 2) {
        g8::EpiGlu8 e{p.proj, p.b_glu + l * 1024, p.xb};
        g8::Order S{NMT * 4, 4};
        g8::gemm_phase8(lds, p.xb, 1024, 1 << 30, 0, p.WgluT + (size_t)l * 1024 * 1024, 1024, S, e);
        for (int u = gridDim.x - 1 - blockIdx.x; u < 1040; u += gridDim.x) norm_unit(p, u);
      } else {
        g8::EpiOut8 e{l == 0 ? p.x_prompt : p.out, l == 0 ? p.x_sample : (p.out + (size_t)TP * 1024), p.out,
                      l == 3 ? (bf16_t*)nullptr : p.xb, p.sumsq + (size_t)(l + 1) * T_TOK * 16};
        g8::Order S{NMT * 4, 4};
        g8::gemm_phase8(lds, p.proj, LDP, 16, 3072, p.WoutT + (size_t)l * 1024 * 2048, 2048, S, e);
      }
    }
    if (ph + 1 < p.phase_end) grid_barrier(grid, p.bar, (unsigned)(ph - p.phase_begin + 1) * gridDim.x);
  }
}

extern "C" void kernel_launch(void* const* d_in, const int* in_sizes, int n_in, void* d_out, int out_size, void* d_ws, size_t ws_size,
                              hipStream_t stream) {
  static int grid_blocks = 0;
  if (!grid_blocks) {
    int dev = 0, cus = 0, per_cu = 0;
    hipGetDevice(&dev);
    hipDeviceGetAttribute(&cus, hipDeviceAttributeMultiprocessorCount, dev);
    hipOccupancyMaxActiveBlocksPerMultiprocessor(&per_cu, mega, NTHREADS, 0);
    if (per_cu < 1) per_cu = 1;
    if (per_cu > 1) per_cu = 1;
    grid_blocks = cus * per_cu;
  }
  Params p{};
  const float* const* in = (const float* const*)d_in;
  p.x_prompt = in[0]; p.x_sample = in[1]; p.st_conv = in[2]; p.st_ssd = in[3]; p.st_s5re = in[4]; p.st_s5im = in[5];
  p.norm_g = in[6]; p.w_in = in[7]; p.conv_w = in[8]; p.conv_b = in[9]; p.dt_bias = in[10]; p.a_log = in[11]; p.d_ssd = in[12];
  p.ssd_norm_g = in[13]; p.lam_re = in[14]; p.lam_im = in[15]; p.log_dt = in[16]; p.b_re = in[17]; p.b_im = in[18];
  p.c_re = in[19]; p.c_im = in[20]; p.d_s5 = in[21]; p.w_glu = in[22]; p.b_glu = in[23]; p.w_out = in[24]; p.final_g = in[25];
  p.out = (float*)d_out;
  unsigned char* ws = (unsigned char*)d_ws;
  size_t off = 0;
  auto take = [&](size_t bytes) { unsigned char* r = ws + off; off += (bytes + 1023) & ~(size_t)1023; return r; };
  p.xb = (bf16_t*)take((size_t)T_TOK * 1024 * 2);
  p.proj = (bf16_t*)take((size_t)T_TOK * LDP * 2);
  p.WinT = (bf16_t*)take((size_t)4 * 5376 * 1024 * 2);
  p.WgluT = (bf16_t*)take((size_t)4 * 1024 * 1024 * 2);
  p.WoutT = (bf16_t*)take((size_t)4 * 1024 * 2048 * 2);
  p.BbT = (bf16_t*)take((size_t)256 * 2048 * 2);
  p.CmT = (bf16_t*)take((size_t)256 * 2048 * 2);
  p.sumsq = (float*)take((size_t)5 * T_TOK * 16 * 4);
  p.ssqa = (float*)take((size_t)T_TOK * 16 * 4);
  p.lamb = (float*)take((size_t)256 * 64 * 2 * 4);
  p.bar = (unsigned*)take(1024);
  hipMemsetAsync(p.bar, 0, 1024, stream);
  if (off > ws_size) { fprintf(stderr, "workspace too small: need %zu have %zu\n", off, ws_size); return; }
  p.phase_begin = 0; p.phase_end = 18;
  void* args[] = {&p};
  hipError_t e = hipLaunchCooperativeKernel((void*)mega, dim3(grid_blocks), dim3(NTHREADS), args, 0, stream);
  if (e != hipSuccess) fprintf(stderr, "cooperative launch failed: %s (grid %d)\n", hipGetErrorString(e), grid_blocks);
}
```

```cpp
#include <hip/hip_runtime.h>
#include <hip/hip_cooperative_groups.h>
#include <cstdio>
namespace cg = cooperative_groups;

#define LAS __attribute__((address_space(3)))
typedef unsigned short bf16_t;
typedef short bf16x8 __attribute__((ext_vector_type(8)));
typedef float f32x4 __attribute__((ext_vector_type(4)));
typedef float f32x16 __attribute__((ext_vector_type(16)));
typedef unsigned u32x4 __attribute__((ext_vector_type(4)));
typedef unsigned u32x2 __attribute__((ext_vector_type(2)));

constexpr int T_TOK = 33280, TP = 32768, NMT = 130;
constexpr int LDP = 5376;
constexpr int C_ZA = 0, C_XBC = 1024, C_U = 3072, C_ZB = 4096, C_DT = 5120;
constexpr int NTHREADS = 512;
constexpr int LDS_BYTES = 139264;

constexpr size_t O_Y = 0, O_CONVP = 34078720, O_SSDP = 34471936, O_S5REP = 42860544, O_S5IMP = 43122688,
                 O_CONVS = 43384832, O_SSDS = 43581440, O_S5RES = 47775744, O_S5IMS = 47906816;

struct Params {
  const float *x_prompt, *x_sample, *st_conv, *st_ssd, *st_s5re, *st_s5im;
  const float *norm_g, *w_in, *conv_w, *conv_b, *dt_bias, *a_log, *d_ssd, *ssd_norm_g;
  const float *lam_re, *lam_im, *log_dt, *b_re, *b_im, *c_re, *c_im, *d_s5, *w_glu, *b_glu, *w_out, *final_g;
  float* out;
  bf16_t *xb, *proj, *WinT, *WgluT, *WoutT, *BbT, *CmT;
  float *sumsq, *ssqa, *lamb, *part;
  unsigned* bar;
  int phase_begin, phase_end;
};

__device__ __forceinline__ float bf2f(unsigned short v) { return __uint_as_float(((unsigned)v) << 16); }
__device__ __forceinline__ float lo_f(unsigned w) { return __uint_as_float(w << 16); }
__device__ __forceinline__ float hi_f(unsigned w) { return __uint_as_float(w & 0xffff0000u); }
__device__ __forceinline__ unsigned pk2(float lo, float hi) { unsigned r; asm("v_cvt_pk_bf16_f32 %0, %1, %2" : "=v"(r) : "v"(lo), "v"(hi)); return r; }
__device__ __forceinline__ float sigm(float x) { return __builtin_amdgcn_rcpf(1.f + __expf(-x)); }
__device__ __forceinline__ float siluf(float x) { return x * sigm(x); }
__device__ __forceinline__ float gelu_tanh(float x) { const float z = 0.7978845608028654f * (x + 0.044715f * x * x * x); return x * sigm(2.f * z); }
__device__ __forceinline__ f32x4 mfma16(bf16x8 a, bf16x8 b, f32x4 c) { return __builtin_amdgcn_mfma_f32_16x16x32_bf16(a, b, c, 0, 0, 0); }
#define WAIT_V0() asm volatile("s_waitcnt vmcnt(0)" ::: "memory")
#define LDS_BARRIER() asm volatile("s_waitcnt lgkmcnt(0)\n\ts_barrier" ::: "memory")
__device__ __forceinline__ int otid() { int t = threadIdx.x; asm volatile("" : "+v"(t)); return t; }

__device__ __forceinline__ void stage_rc(int b, int& R, int& C) {
  const int st = b >> 10, sb = b & 1023, swz = sb ^ (((sb >> 9) & 1) << 5);
  R = (st >> 1) * 16 + swz / 64;
  C = (st & 1) * 32 + (swz % 64) / 2;
}

__device__ __forceinline__ int xcd_remap(int u) {
  const int G = gridDim.x, i = u / G, blk = u % G, per = G >> 3;
  if (G & 7) return u;
  return (i * 8 + (blk & 7)) * per + (blk >> 3);
}
__device__ __forceinline__ void tile_map(int u, int nN, int& pm, int& pn) {
  const int nig = 8 * nN, gid = u / nig, fm = gid * 8, rem = u % nig;
  const int gsz = (NMT - fm) < 8 ? (NMT - fm) : 8;
  pm = fm + rem % gsz; pn = rem / gsz;
}

namespace g8 {
constexpr int HTB = 128 * 64 * 2;
__device__ __forceinline__ int lds_byte(int r, int c) { const int st = (r >> 4) * 2 + (c >> 5), rr = r & 15, cc = c & 31, ob = rr * 64 + cc * 2; return st * 1024 + (ob ^ (((ob >> 9) & 1) << 5)); }
struct Unit { int pm, pn; };
struct Order {
  int ntiles, nN, mode, q;
  __device__ __forceinline__ bool next(int i, Unit& u) const {
    if (mode == 1) {
      if (i != 0 || (int)blockIdx.x >= 32 || ((int)blockIdx.x >> 3) != q) return false;
      tile_map(512 + ((int)blockIdx.x & 7), 4, u.pm, u.pn); return true;
    }
    const int w = xcd_remap((int)blockIdx.x + i * (int)gridDim.x);
    if (w >= ntiles) return false;
    tile_map(w, nN, u.pm, u.pn); return true;
  }
};
__device__ __forceinline__ int perm32(int rho) { const int n = rho >> 4, i = rho & 15; return 8 * (i >> 2) + 4 * n + (i & 3); }
struct EpiIn8 {
  static constexpr bool PERM = true;
  bf16_t* proj; const float* sumsq;
  __device__ __forceinline__ void operator()(const f32x4 (&acc)[2][2][4][2], const Unit& u, int wr, int wc, int fr, int fq) const {
    const int row0 = u.pm * 256 + wr * 64 + fr, col0 = u.pn * 256 + wc * 32 + fq * 8;
#pragma unroll
    for (int ai = 0; ai < 2; ++ai)
#pragma unroll
      for (int m = 0; m < 4; ++m) {
        asm volatile("" ::: "memory");
        const int row = row0 + ai * 128 + m * 16;
        const f32x4* sp = (const f32x4*)(sumsq + (size_t)row * 16);
        const f32x4 s0 = sp[0], s1 = sp[1], s2 = sp[2], s3 = sp[3];
        const float ss = ((s0[0] + s0[1]) + (s0[2] + s0[3])) + ((s1[0] + s1[1]) + (s1[2] + s1[3])) +
                         ((s2[0] + s2[1]) + (s2[2] + s2[3])) + ((s3[0] + s3[1]) + (s3[2] + s3[3]));
        const float rs = rsqrtf(ss * (1.f / 1024.f) + 1e-6f);
        bf16_t* rp = proj + (size_t)row * LDP + col0;
#pragma unroll
        for (int bj = 0; bj < 2; ++bj) {
          const f32x4 v0 = acc[ai][bj][m][0] * rs, v1 = acc[ai][bj][m][1] * rs;
          *(u32x4*)(rp + bj * 128) = (u32x4){pk2(v0[0], v0[1]), pk2(v0[2], v0[3]), pk2(v1[0], v1[1]), pk2(v1[2], v1[3])};
        }
      }
  }
};
struct EpiGlu8 {
  static constexpr bool PERM = true;
  bf16_t* proj; const float* bglu; const bf16_t* ys;
  __device__ __forceinline__ void operator()(const f32x4 (&acc)[2][2][4][2], const Unit& u, int wr, int wc, int fr, int fq) const {
    const int row0 = u.pm * 256 + wr * 64 + fr, col0 = u.pn * 256 + wc * 32 + fq * 8;
#pragma unroll
    for (int ai = 0; ai < 2; ++ai)
#pragma unroll
      for (int m = 0; m < 4; ++m) {
        asm volatile("" ::: "memory");
        const int row = row0 + ai * 128 + m * 16;
        bf16_t* base = proj + (size_t)row * LDP;
#pragma unroll
        for (int bj = 0; bj < 2; ++bj) {
          const int col = col0 + bj * 128;
          const f32x4 g0 = acc[ai][bj][m][0] + *(const f32x4*)(bglu + col), g1 = acc[ai][bj][m][1] + *(const f32x4*)(bglu + col + 4);
          const u32x4 a = *(const u32x4*)(ys + (size_t)row * 1024 + col);
          const u32x4 z = *(const u32x4*)(base + C_ZB + col);
          u32x4 o;
          o[0] = pk2(lo_f(a[0]) * sigm(g0[0]) * siluf(lo_f(z[0])), hi_f(a[0]) * sigm(g0[1]) * siluf(hi_f(z[0])));
          o[1] = pk2(lo_f(a[1]) * sigm(g0[2]) * siluf(lo_f(z[1])), hi_f(a[1]) * sigm(g0[3]) * siluf(hi_f(z[1])));
          o[2] = pk2(lo_f(a[2]) * sigm(g1[0]) * siluf(lo_f(z[2])), hi_f(a[2]) * sigm(g1[1]) * siluf(hi_f(z[2])));
          o[3] = pk2(lo_f(a[3]) * sigm(g1[2]) * siluf(lo_f(z[3])), hi_f(a[3]) * sigm(g1[3]) * siluf(hi_f(z[3])));
          *(u32x4*)(base + C_ZB + col) = o;
        }
      }
  }
};
struct EpiOut8 {
  static constexpr bool PERM = true;
  const float *xin_p, *xin_s; float* xout; bf16_t* xb; float* ssq_next;
  __device__ __forceinline__ void operator()(const f32x4 (&acc)[2][2][4][2], const Unit& u, int wr, int wc, int fr, int fq) const {
    const int row0 = u.pm * 256 + wr * 64 + fr, col0 = u.pn * 256 + wc * 32 + fq * 8;
#pragma unroll
    for (int ai = 0; ai < 2; ++ai)
#pragma unroll
      for (int m = 0; m < 4; ++m) {
        asm volatile("" ::: "memory");
        const int row = row0 + ai * 128 + m * 16;
        const float* xr = (row < TP) ? (xin_p + (size_t)row * 1024) : (xin_s + (size_t)(row - TP) * 1024);
        float s = 0.f;
#pragma unroll
        for (int bj = 0; bj < 2; ++bj) {
          const int col = col0 + bj * 128;
          const f32x4 v0 = acc[ai][bj][m][0] + *(const f32x4*)(xr + col), v1 = acc[ai][bj][m][1] + *(const f32x4*)(xr + col + 4);
          *(f32x4*)(xout + (size_t)row * 1024 + col) = v0;
          *(f32x4*)(xout + (size_t)row * 1024 + col + 4) = v1;
          if (xb) *(u32x4*)(xb + (size_t)row * 1024 + col) = (u32x4){pk2(v0[0], v0[1]), pk2(v0[2], v0[3]), pk2(v1[0], v1[1]), pk2(v1[2], v1[3])};
          s += v0[0] * v0[0] + v0[1] * v0[1] + v0[2] * v0[2] + v0[3] * v0[3] + v1[0] * v1[0] + v1[1] * v1[1] + v1[2] * v1[2] + v1[3] * v1[3];
        }
        s += __shfl_xor(s, 16); s += __shfl_xor(s, 32);
        if (fq == 0) ssq_next[(size_t)row * 16 + u.pn * 4 + wc] = s;
      }
  }
};

struct EpiPart8 {
  static constexpr bool PERM = true;
  float* part;
  __device__ __forceinline__ void operator()(const f32x4 (&acc)[2][2][4][2], const Unit& u, int wr, int wc, int fr, int fq) const {
    const int row0 = u.pm * 256 + wr * 64 + fr - TP, col0 = u.pn * 256 + wc * 32 + fq * 8;
#pragma unroll
    for (int ai = 0; ai < 2; ++ai)
#pragma unroll
      for (int m = 0; m < 4; ++m)
#pragma unroll
        for (int bj = 0; bj < 2; ++bj) {
          float* q0 = part + (size_t)(row0 + ai * 128 + m * 16) * 1024 + col0 + bj * 128;
          *(f32x4*)q0 = acc[ai][bj][m][0]; *(f32x4*)(q0 + 4) = acc[ai][bj][m][1];
        }
  }
};

template <class Epi>
__device__ __forceinline__ void gemm_phase8(LAS unsigned char* lds, const bf16_t* A, int lda, int segkt, int segoff, const bf16_t* Bt, int ldb, int K,
                                            const Order& S, const Epi& E) {
  const int tid = otid(), wid = __builtin_amdgcn_readfirstlane(tid >> 6), lane = tid & 63, wr = wid >> 2, wc = wid & 3, fr = lane & 15, fq = lane >> 4;
  const int nt = K / 64;
  unsigned voffA[2], voffB[2];
#pragma unroll
  for (int i = 0; i < 2; ++i) { int R, C; stage_rc(tid * 16 + i * 8192, R, C); const int Rb = Epi::PERM ? ((R & ~31) + perm32(R & 31)) : R;
    voffA[i] = (unsigned)(R * lda + C) * 2u; voffB[i] = (unsigned)(Rb * ldb + C) * 2u; }
  const size_t kstep = 128;
  const size_t hstepA = (size_t)128 * lda * 2, tstepA = 2 * hstepA;
  const size_t hstepB = (size_t)128 * ldb * 2, tstepB = 2 * hstepB;
  const size_t segB = (size_t)segoff * 2;
#define G8_AK(kt) ((size_t)(kt) * 128 + (((kt) >= segkt) ? segB : (size_t)0))
  const unsigned ldsw = (unsigned)wid * 1024u;
  const int aoff = lds_byte(wr * 64 + fr, fq * 8), boff = lds_byte(wc * 32 + fr, fq * 8);
#define G8_SA(b, h) (((b) * 2 + (h)) * HTB)
#define G8_SB(b, h) ((4 + (b) * 2 + (h)) * HTB)
#define G8_STAGE(bufoff, gbase, voff) do { _Pragma("unroll") for (int _i = 0; _i < 2; ++_i) \
    __builtin_amdgcn_global_load_lds((const unsigned*)((const char*)(gbase) + (voff)[_i]), (LAS unsigned*)(lds + (bufoff) + ldsw + _i * 8192), 16, 0, 0); } while (0)
#define G8_LDA(dst, b, h) do { _Pragma("unroll") for (int m = 0; m < 4; ++m) _Pragma("unroll") for (int k = 0; k < 2; ++k) dst[m][k] = *(const LAS bf16x8*)(lds + G8_SA(b, h) + aoff + m * 2048 + k * 1024); } while (0)
#define G8_LDB(dst, b, h) do { _Pragma("unroll") for (int n = 0; n < 2; ++n) _Pragma("unroll") for (int k = 0; k < 2; ++k) dst[n][k] = *(const LAS bf16x8*)(lds + G8_SB(b, h) + boff + n * 2048 + k * 1024); } while (0)
#define G8_MMA(ai, bj, At, Bt_) do { __builtin_amdgcn_s_setprio(1); _Pragma("unroll") for (int m = 0; m < 4; ++m) _Pragma("unroll") for (int n = 0; n < 2; ++n) _Pragma("unroll") for (int k = 0; k < 2; ++k) \
    acc[ai][bj][m][n] = __builtin_amdgcn_mfma_f32_16x16x32_bf16(Bt_[n][k], At[m][k], acc[ai][bj][m][n], 0, 0, 0); __builtin_amdgcn_s_setprio(0); } while (0)
#define G8_WAIT_V(n) asm volatile("s_waitcnt vmcnt(" #n ")" ::: "memory")
#define G8_WAIT_L(n) asm volatile("s_waitcnt lgkmcnt(" #n ")" ::: "memory")
#define G8_BAR __builtin_amdgcn_s_barrier()
#define G8_SCHED __builtin_amdgcn_sched_barrier(0)
  Unit cur, nxt; int ui = 0;
  if (!S.next(0, cur)) return;
  f32x4 acc[2][2][4][2];
#pragma unroll
  for (int a = 0; a < 2; ++a)
#pragma unroll
    for (int b = 0; b < 2; ++b)
#pragma unroll
      for (int m = 0; m < 4; ++m)
#pragma unroll
        for (int n = 0; n < 2; ++n) acc[a][b][m][n] = (f32x4){0.f, 0.f, 0.f, 0.f};
  bf16x8 At[4][2], B0[2][2], B1[2][2];
  const char* cA = (const char*)A + (size_t)cur.pm * tstepA; const char* cB = (const char*)Bt + (size_t)cur.pn * tstepB;
  G8_STAGE(G8_SB(0, 0), cB, voffB); G8_STAGE(G8_SA(0, 0), cA, voffA); G8_STAGE(G8_SB(0, 1), cB + hstepB, voffB); G8_STAGE(G8_SA(0, 1), cA + hstepA, voffA);
  if (wr == 1) G8_BAR;
  G8_WAIT_V(4); G8_BAR;
  G8_STAGE(G8_SB(1, 0), cB + kstep, voffB); G8_STAGE(G8_SA(1, 0), cA + G8_AK(1), voffA); G8_STAGE(G8_SB(1, 1), cB + hstepB + kstep, voffB);
  G8_WAIT_V(6); G8_BAR;
  for (;;) {
    const bool has_next = S.next(ui + 1, nxt);
    const char* nA = has_next ? (const char*)A + (size_t)nxt.pm * tstepA : cA; const char* nB = has_next ? (const char*)Bt + (size_t)nxt.pn * tstepB : cB;
    for (int t = 0; t < nt; t += 2) {
      const bool last = (t == nt - 2);
      const char* a1 = cA + G8_AK(t + 1);
      const char* a2 = last ? nA : cA + G8_AK(t + 2); const char* b2 = last ? nB : cB + (size_t)(t + 2) * kstep;
      const char* a3 = last ? nA + G8_AK(1) : cA + G8_AK(t + 3); const char* b3 = b2 + kstep;
      G8_LDB(B0, 0, 0); G8_SCHED; G8_LDA(At, 0, 0); G8_STAGE(G8_SA(1, 1), a1 + hstepA, voffA);
      G8_WAIT_L(8); G8_BAR; G8_WAIT_L(0); G8_MMA(0, 0, At, B0); G8_BAR; G8_SCHED;
      G8_LDB(B1, 0, 1); G8_STAGE(G8_SB(0, 0), b2, voffB);
      G8_BAR; G8_WAIT_L(0); G8_MMA(0, 1, At, B1); G8_BAR;
      G8_LDA(At, 0, 1); G8_STAGE(G8_SA(0, 0), a2, voffA);
      G8_BAR; G8_WAIT_L(0); G8_MMA(1, 0, At, B0); G8_BAR; G8_SCHED;
      G8_STAGE(G8_SB(0, 1), b2 + hstepB, voffB);
      G8_WAIT_V(6); G8_BAR; G8_MMA(1, 1, At, B1); G8_BAR;
      G8_LDB(B0, 1, 0); G8_SCHED; G8_LDA(At, 1, 0); G8_STAGE(G8_SA(0, 1), a2 + hstepA, voffA);
      G8_WAIT_L(8); G8_BAR; G8_WAIT_L(0); G8_MMA(0, 0, At, B0); G8_BAR; G8_SCHED;
      G8_LDB(B1, 1, 1); G8_STAGE(G8_SB(1, 0), b3, voffB);
      G8_BAR; G8_WAIT_L(0); G8_MMA(0, 1, At, B1); G8_BAR;
      G8_LDA(At, 1, 1); G8_STAGE(G8_SA(1, 0), a3, voffA);
      G8_BAR; G8_WAIT_L(0); G8_MMA(1, 0, At, B0); G8_BAR; G8_SCHED;
      G8_STAGE(G8_SB(1, 1), b3 + hstepB, voffB);
      G8_WAIT_V(6); G8_BAR; G8_MMA(1, 1, At, B1); G8_BAR;
    }
    E(acc, cur, wr, wc, fr, fq);
    if (!has_next) break;
#pragma unroll
    for (int a = 0; a < 2; ++a)
#pragma unroll
      for (int b = 0; b < 2; ++b)
#pragma unroll
        for (int m = 0; m < 4; ++m)
#pragma unroll
          for (int n = 0; n < 2; ++n) acc[a][b][m][n] = (f32x4){0.f, 0.f, 0.f, 0.f};
    cur = nxt; cA = nA; cB = nB; ++ui;
  }
  G8_WAIT_V(0);
  if (wr == 0) G8_BAR;
  G8_BAR;
#undef G8_AK
#undef G8_SA
#undef G8_SB
#undef G8_STAGE
#undef G8_LDA
#undef G8_LDB
#undef G8_MMA
#undef G8_WAIT_V
#undef G8_WAIT_L
#undef G8_BAR
#undef G8_SCHED
}
}

__device__ void xrow_unit(const Params& p, int unit) {
  const int tid_ = otid(); const int wid = tid_ >> 6, lane = tid_ & 63;
  f32x4 v[2][4];
#pragma unroll
  for (int r = 0; r < 2; ++r) {
    const int row = unit * 16 + r * 8 + wid;
    const float* src = (row < TP) ? (p.x_prompt + (size_t)row * 1024) : (p.x_sample + (size_t)(row - TP) * 1024);
#pragma unroll
    for (int i = 0; i < 4; ++i) v[r][i] = *(const f32x4*)(src + i * 256 + lane * 4);
  }
#pragma unroll
  for (int r = 0; r < 2; ++r) {
    const int row = unit * 16 + r * 8 + wid;
    float s = 0.f;
#pragma unroll
    for (int i = 0; i < 4; ++i) {
      const f32x4 x = v[r][i];
      s += x[0] * x[0] + x[1] * x[1] + x[2] * x[2] + x[3] * x[3];
      u32x2 o; o.x = pk2(x[0], x[1]); o.y = pk2(x[2], x[3]);
      *(u32x2*)(p.xb + (size_t)row * 1024 + i * 256 + lane * 4) = o;
    }
#pragma unroll
    for (int o = 32; o >= 1; o >>= 1) s += __shfl_xor(s, o);
    if (lane < 16) p.sumsq[(size_t)row * 16 + lane] = (lane == 0) ? s : 0.f;
  }
}

__device__ void transpose_unit(LAS unsigned char* lds, const float* src, int ldsrc, const float* scale, int nscale,
                               bf16_t* dst, int ldd, int kt, int ntile, int mode) {
  LAS float* tl = (LAS float*)lds;
  const int tid = otid();
  const int k0 = kt * 64, n0 = ntile * 64;
  f32x4 v[2];
#pragma unroll
  for (int i = 0; i < 2; ++i) {
    const int idx = tid + i * 512, kk = idx >> 4, n4 = (idx & 15) * 4;
    const int np = n0 + n4;
    int sc = np;
    if (mode == 0) { sc = (np < 3072) ? np : (np < 5120) ? (np + 16) : (np < 5136) ? (np - 5120 + 3072) : -1; }
    f32x4 x = (f32x4){0.f, 0.f, 0.f, 0.f};
    if (sc >= 0) {
      x = *(const f32x4*)(src + (size_t)(k0 + kk) * ldsrc + sc);
      if (scale && (k0 + kk) < nscale) x = x * scale[k0 + kk];
    }
    v[i] = x;
  }
#pragma unroll
  for (int i = 0; i < 2; ++i) {
    const int idx = tid + i * 512, kk = idx >> 4, n4 = (idx & 15) * 4;
#pragma unroll
    for (int j = 0; j < 4; ++j) tl[kk * 65 + n4 + j] = v[i][j];
  }
  __syncthreads();
  {
    const int nn = tid >> 3, kk0 = (tid & 7) * 8;
    float t[8];
#pragma unroll
    for (int j = 0; j < 8; ++j) t[j] = tl[(kk0 + j) * 65 + nn];
    *(u32x4*)(dst + (size_t)(n0 + nn) * ldd + k0 + kk0) = (u32x4){pk2(t[0], t[1]), pk2(t[2], t[3]), pk2(t[4], t[5]), pk2(t[6], t[7])};
  }
  __syncthreads();
}

__device__ __forceinline__ double exp_d(double x) {
  const double k = rint(x * 1.4426950408889634);
  const double r = fma(-k, 0.6931471805599453, x) - k * 2.3190468138462996e-17;
  double s = 1.0 / 6227020800.0;
  s = fma(s, r, 1.0 / 479001600.0); s = fma(s, r, 1.0 / 39916800.0); s = fma(s, r, 1.0 / 3628800.0);
  s = fma(s, r, 1.0 / 362880.0); s = fma(s, r, 1.0 / 40320.0); s = fma(s, r, 1.0 / 5040.0);
  s = fma(s, r, 1.0 / 720.0); s = fma(s, r, 1.0 / 120.0); s = fma(s, r, 1.0 / 24.0);
  s = fma(s, r, 1.0 / 6.0); s = fma(s, r, 0.5); s = fma(s, r, 1.0); s = fma(s, r, 1.0);
  return ldexp(s, (int)k);
}
__device__ __forceinline__ void sincos_d(double x, double& sn, double& cs) {
  const double k = rint(x * 0.6366197723675814);
  double r = fma(-k, 1.5707963267948966, x); r = fma(-k, 6.123233995736766e-17, r);
  const int q = ((int)k) & 3;
  const double r2 = r * r;
  double sp = 1.0 / 1307674368000.0;
  sp = fma(sp, r2, -1.0 / 6227020800.0); sp = fma(sp, r2, 1.0 / 39916800.0); sp = fma(sp, r2, -1.0 / 362880.0);
  sp = fma(sp, r2, 1.0 / 5040.0); sp = fma(sp, r2, -1.0 / 120.0); sp = fma(sp, r2, 1.0 / 6.0);
  sp = r - r * r2 * sp;
  double cp = 1.0 / 20922789888000.0;
  cp = fma(cp, r2, -1.0 / 87178291200.0); cp = fma(cp, r2, 1.0 / 479001600.0); cp = fma(cp, r2, -1.0 / 3628800.0);
  cp = fma(cp, r2, 1.0 / 40320.0); cp = fma(cp, r2, -1.0 / 720.0); cp = fma(cp, r2, 1.0 / 24.0); cp = fma(cp, r2, -0.5);
  cp = fma(cp, r2, 1.0);
  sn = (q == 0) ? sp : (q == 1) ? cp : (q == 2) ? -sp : -cp;
  cs = (q == 0) ? cp : (q == 1) ? -sp : (q == 2) ? -cp : sp;
}

__device__ void s5prep_unit(LAS unsigned char* lds, const Params& p, int l, int g) {
  LAS float* cf = (LAS float*)lds;
  const int tid = otid();
  const int lg = l * 64 + g;
  if (tid < 64) {
    const double dt = exp_d((double)p.log_dt[lg]);
    const double lr = (double)p.lam_re[lg * 64 + tid], li = (double)p.lam_im[lg * 64 + tid];
    const double e = exp_d(lr * dt);
    double sn, cs; sincos_d(li * dt, sn, cs);
    const double lbr = e * cs, lbi = e * sn;
    const double nr = lbr - 1.0, ni = lbi;
    const double den = lr * lr + li * li;
    const double cr = (nr * lr + ni * li) / den, ci = (ni * lr - nr * li) / den;
    p.lamb[(size_t)(lg * 64 + tid) * 2 + 0] = (float)lbr;
    p.lamb[(size_t)(lg * 64 + tid) * 2 + 1] = (float)lbi;
    cf[tid * 2 + 0] = (float)cr; cf[tid * 2 + 1] = (float)ci;
  }
  __syncthreads();
#pragma unroll
  for (int i = 0; i < 4; ++i) {
    const int idx = tid * 4 + i;
    {
      const int pp = idx >> 4, c = idx & 15, st = pp & 63;
      const float br = p.b_re[((size_t)lg * 64 + st) * 16 + c], bi = p.b_im[((size_t)lg * 64 + st) * 16 + c];
      const float cr = cf[st * 2], ci = cf[st * 2 + 1];
      const float v = (pp < 64) ? (cr * br - ci * bi) : (cr * bi + ci * br);
      p.BbT[(size_t)lg * 2048 + idx] = (bf16_t)(pk2(v, v) & 0xffffu);
    }
    {
      const int c = idx >> 7, pp = idx & 127, st = pp & 63;
      const float v = (pp < 64) ? p.c_re[((size_t)lg * 16 + c) * 64 + st] : -p.c_im[((size_t)lg * 16 + c) * 64 + st];
      p.CmT[(size_t)lg * 2048 + idx] = (bf16_t)(pk2(v, v) & 0xffffu);
    }
  }
  __syncthreads();
}

__device__ void phase_prep(LAS unsigned char* lds, const Params& p) {
  constexpr int U_X = 2080, U_WIN = 5376, U_WGLU = 1024, U_WOUT = 2048, U_S5 = 256;
  constexpr int TOTAL = U_X + U_WIN + U_WGLU + U_WOUT + U_S5;
  for (int u = blockIdx.x; u < TOTAL; u += gridDim.x) {
    int idx = u;
    if (idx < U_X) { xrow_unit(p, idx); continue; }
    idx -= U_X;
    if (idx < U_WIN) {
      const int l = idx / 1344, r = idx % 1344, ntile = r / 16, kt = r % 16;
      transpose_unit(lds, p.w_in + (size_t)l * 1024 * 5136, 5136, p.norm_g + l * 1024, 1024,
                     p.WinT + (size_t)l * 5376 * 1024, 1024, kt, ntile, 0);
      continue;
    }
    idx -= U_WIN;
    if (idx < U_WGLU) {
      const int l = idx / 256, r = idx % 256, ntile = r / 16, kt = r % 16;
      transpose_unit(lds, p.w_glu + (size_t)l * 1024 * 1024, 1024, nullptr, 0, p.WgluT + (size_t)l * 1024 * 1024, 1024, kt, ntile, 1);
      continue;
    }
    idx -= U_WGLU;
    if (idx < U_WOUT) {
      const int l = idx / 512, r = idx % 512, ntile = r / 32, kt = r % 32;
      transpose_unit(lds, p.w_out + (size_t)l * 2048 * 1024, 1024, p.ssd_norm_g + l * 1024, 1024,
                     p.WoutT + (size_t)l * 1024 * 2048, 2048, kt, ntile, 2);
      continue;
    }
    idx -= U_WOUT;
    s5prep_unit(lds, p, idx / 64, idx % 64);
  }
}

constexpr int CM_OFF = 0, BM_OFF = 17408, BMT_OFF = 34816, XDT_OFF = 53248, XW_OFF = 62464, MM_OFF = 71680,
              HB_OFF = 80896, XS_OFF = 98304, ACS_OFF = 107520, DTV_OFF = 115712, SSQ_OFF = 123904, CW_OFF = 124416;

__device__ __forceinline__ bf16x8 ldfrag(LAS unsigned char* lds, int off, int row, int stride, int col) {
  return *(const LAS bf16x8*)(lds + off + (row * stride + col) * 2);
}

template <int NCH>
__device__ __forceinline__ void conv_load_rows(unsigned (&rows)[7][NCH / 2], const bf16_t* proj, const float* stc, int tok0, int c, int s0, int ccol) {
#pragma unroll
  for (int i = 0; i < 7; ++i) {
    const int pos = c * 64 + s0 - 3 + i;
    if (pos >= 0) {
      const bf16_t* q = proj + (size_t)(tok0 + pos) * LDP + C_XBC + ccol;
      if (NCH == 8) { const u32x4 v = *(const u32x4*)q; rows[i][0] = v[0]; rows[i][1] = v[1]; rows[i][NCH / 2 - 2] = v[2]; rows[i][NCH / 2 - 1] = v[3]; }
      else rows[i][0] = *(const unsigned*)q;
    } else if (stc) {
      const float* sp = stc + (size_t)(3 + pos) * 2048 + ccol;
#pragma unroll
      for (int k = 0; k < NCH / 2; ++k) rows[i][k] = pk2(sp[2 * k], sp[2 * k + 1]);
    } else {
#pragma unroll
      for (int k = 0; k < NCH / 2; ++k) rows[i][k] = 0u;
    }
  }
}
template <int NCH>
__device__ __forceinline__ void conv_load_rows_fast(unsigned (&rows)[7][NCH / 2], const bf16_t* proj, int tok0, int c, int s0, int ccol) {
  const bf16_t* q0 = proj + (size_t)(tok0 + c * 64 + s0 - 3) * LDP + C_XBC + ccol;
#pragma unroll
  for (int i = 0; i < 7; ++i) {
    const bf16_t* q = q0 + (size_t)i * LDP;
    if (NCH == 8) { const u32x4 v = *(const u32x4*)q; rows[i][0] = v[0]; rows[i][1] = v[1]; rows[i][NCH / 2 - 2] = v[2]; rows[i][NCH / 2 - 1] = v[3]; }
    else rows[i][0] = *(const unsigned*)q;
  }
}
template <int NCH>
__device__ __forceinline__ void conv_store_row(LAS unsigned char* addr, const float* o) {
  if (NCH == 8) *(LAS u32x4*)addr = (u32x4){pk2(o[0], o[1]), pk2(o[2], o[3]), pk2(o[NCH - 4], o[NCH - 3]), pk2(o[NCH - 2], o[NCH - 1])};
  else *(LAS unsigned*)addr = pk2(o[0], o[1]);
}
template <int NCH>
__device__ __forceinline__ void conv_unit(LAS unsigned char* lds, const unsigned (&rows)[7][NCH / 2], const LAS float* wl,
                                          int oct, int chq, int s0, const LAS float* acs, const LAS float* dtv) {
  float o[4][NCH];
  float w[4][NCH], bs[NCH];
#pragma unroll
  for (int e = 0; e < NCH; ++e) { bs[e] = wl[32 + e];
#pragma unroll
    for (int k = 0; k < 4; ++k) w[k][e] = wl[k * 8 + e]; }
#pragma unroll
  for (int e = 0; e < NCH; ++e) {
    float xv[7];
#pragma unroll
    for (int i = 0; i < 7; ++i) xv[i] = (e & 1) ? hi_f(rows[i][e >> 1]) : lo_f(rows[i][e >> 1]);
#pragma unroll
    for (int j = 0; j < 4; ++j) o[j][e] = siluf(bs[e] + w[0][e] * xv[j] + w[1][e] * xv[j + 1] + w[2][e] * xv[j + 2] + w[3][e] * xv[j + 3]);
  }
  if (oct < 8) {
    float dts[4], wsc[4];
    const float aend = acs[63];
#pragma unroll
    for (int j = 0; j < 4; ++j) { dts[j] = dtv[s0 + j]; wsc[j] = dts[j] * __expf(aend - acs[s0 + j]); }
    const int p0 = oct * 8 + chq;
#pragma unroll
    for (int j = 0; j < 4; ++j) conv_store_row<NCH>(lds + XS_OFF + ((s0 + j) * 72 + p0) * 2, o[j]);
#pragma unroll
    for (int e = 0; e < NCH; ++e) {
      *(LAS u32x2*)(lds + XDT_OFF + ((p0 + e) * 72 + s0) * 2) = (u32x2){pk2(o[0][e] * dts[0], o[1][e] * dts[1]), pk2(o[2][e] * dts[2], o[3][e] * dts[3])};
      *(LAS u32x2*)(lds + XW_OFF + ((p0 + e) * 72 + s0) * 2) = (u32x2){pk2(o[0][e] * wsc[0], o[1][e] * wsc[1]), pk2(o[2][e] * wsc[2], o[3][e] * wsc[3])};
    }
  } else if (oct < 24) {
    const int n0 = (oct - 8) * 8 + chq;
#pragma unroll
    for (int j = 0; j < 4; ++j) conv_store_row<NCH>(lds + BM_OFF + ((s0 + j) * 136 + n0) * 2, o[j]);
#pragma unroll
    for (int e = 0; e < NCH; ++e) *(LAS u32x2*)(lds + BMT_OFF + ((n0 + e) * 72 + s0) * 2) = (u32x2){pk2(o[0][e], o[1][e]), pk2(o[2][e], o[3][e])};
  } else {
    const int n0 = (oct - 24) * 8 + chq;
#pragma unroll
    for (int j = 0; j < 4; ++j) conv_store_row<NCH>(lds + CM_OFF + ((s0 + j) * 136 + n0) * 2, o[j]);
  }
}

__device__ void ssd_item(LAS unsigned char* lds, const Params& p, int l, int b, int h, bool smp) {
  const int tid = otid(), wid = tid >> 6, lane = tid & 63, fr = lane & 15, fq = lane >> 4;
  const int g = h >> 2;
  const int tok0 = smp ? (TP + b * 64) : (b * 2048);
  const int nchunk = smp ? 1 : 32;
  const int NB = smp ? 8 : 16;
  bf16_t* proj = p.proj;
  LAS float* acs_all = (LAS float*)(lds + ACS_OFF);
  LAS float* dtv_all = (LAS float*)(lds + DTV_OFF);
  LAS float* ssq = (LAS float*)(lds + SSQ_OFF);
  const float dtb = p.dt_bias[l * 16 + h];
  const float Aneg = -__expf(p.a_log[l * 16 + h]);
  const float Dh = p.d_ssd[l * 16 + h];

  f32x4 hacc[4];
#pragma unroll
  for (int pt = 0; pt < 4; ++pt) {
    if (smp) hacc[pt] = *(const f32x4*)(p.st_ssd + ((((size_t)l * 8 + b) * 16 + h) * 64 + pt * 16 + fr) * 128 + wid * 16 + fq * 4);
    else hacc[pt] = (f32x4){0.f, 0.f, 0.f, 0.f};
  }

  const float* stc = smp ? (p.st_conv + ((size_t)l * 8 + b) * 3 * 2048) : nullptr;
  int octA, s0A;
  if (tid < 128) { octA = tid & 7; s0A = (tid >> 3) * 4; }
  else if (tid < 384) { const int i = tid - 128; octA = 8 + (i & 15); s0A = (i >> 4) * 4; }
  else { const int i = tid - 384; octA = 24 + (i & 15); s0A = (i >> 4) * 4; }
  const int jB = tid >> 2, octB = 24 + (jB & 15), s0B = (8 + (jB >> 4)) * 4, chqB = (tid & 3) * 2;
  const int cchA = (octA < 8) ? (h * 64 + octA * 8) : (octA < 24) ? (1024 + g * 128 + (octA - 8) * 8) : (1536 + g * 128 + (octA - 24) * 8);
  const int cchB = ((octB < 8) ? (h * 64 + octB * 8) : (octB < 24) ? (1024 + g * 128 + (octB - 8) * 8) : (1536 + g * 128 + (octB - 24) * 8)) + chqB;
  LAS float* cwl = (LAS float*)(lds + CW_OFF);
  {
    const float* cw = p.conv_w + (size_t)l * 4 * 2048;
    const float* cb = p.conv_b + (size_t)l * 2048;
    for (int idx = tid; idx < 1600; idx += 512) {
      const int oc = idx / 40, r = idx % 40, k = r >> 3, e = r & 7;
      const int cc = ((oc < 8) ? (h * 64 + oc * 8) : (oc < 24) ? (1024 + g * 128 + (oc - 8) * 8) : (1536 + g * 128 + (oc - 24) * 8)) + e;
      cwl[idx] = (k < 4) ? cw[k * 2048 + cc] : cb[cc];
    }
  }
  unsigned rowsA[7][4], rowsB[7][1];
  conv_load_rows<8>(rowsA, proj, stc, tok0, 0, s0A, cchA);
  conv_load_rows<2>(rowsB, proj, stc, tok0, 0, s0B, cchB);
  for (int c = wid; c < nchunk; c += 8) {
    const float dtr = bf2f(proj[(size_t)(tok0 + c * 64 + lane) * LDP + C_DT + h]);
    const float xx = dtr + dtb;
    const float dt = xx > 20.f ? xx : log1pf(__expf(xx));
    float cs = dt * Aneg;
#pragma unroll
    for (int o = 1; o < 64; o <<= 1) { const float v = __shfl_up(cs, o); if (lane >= o) cs += v; }
    acs_all[c * 64 + lane] = cs; dtv_all[c * 64 + lane] = dt;
  }
  LDS_BARRIER();
  for (int c = 0; c < nchunk; ++c) {
    const int ctok = tok0 + c * 64;
    const LAS float* acs = acs_all + c * 64;
    const LAS float* dtv = dtv_all + c * 64;
    u32x2 z4v[2];
    {
      const int lt_ = wid >> 1, ptb_ = (wid & 1) * 2;
#pragma unroll
      for (int q = 0; q < 2; ++q) z4v[q] = *(const u32x2*)(proj + (size_t)(ctok + lt_ * 16 + fr) * LDP + C_ZA + h * 64 + (ptb_ + q) * 16 + fq * 4);
    }
    conv_unit<8>(lds, rowsA, cwl + octA * 40, octA, 0, s0A, acs, dtv);
    conv_unit<2>(lds, rowsB, cwl + octB * 40 + chqB, octB, chqB, s0B, acs, dtv);
    if (c + 1 < nchunk) {
      conv_load_rows_fast<8>(rowsA, proj, tok0, c + 1, s0A, cchA);
      conv_load_rows_fast<2>(rowsB, proj, tok0, c + 1, s0B, cchB);
    }
#pragma unroll
    for (int pt = 0; pt < 4; ++pt)
      *(LAS u32x2*)(lds + HB_OFF + ((pt * 16 + fr) * 136 + wid * 16 + fq * 4) * 2) =
          (u32x2){pk2(hacc[pt][0], hacc[pt][1]), pk2(hacc[pt][2], hacc[pt][3])};
    LDS_BARRIER();
    const int lt = wid >> 1, ptb = (wid & 1) * 2;
    {
      const int st = wid >> 1, ltb = (wid & 1) * 2;
      bf16x8 bfr[4];
#pragma unroll
      for (int ks = 0; ks < 4; ++ks) bfr[ks] = ldfrag(lds, BM_OFF, st * 16 + fr, 136, ks * 32 + fq * 8);
#pragma unroll
      for (int q = 0; q < 2; ++q) {
        const int ltq = ltb + q;
        f32x4 a = (f32x4){0.f, 0.f, 0.f, 0.f};
#pragma unroll
        for (int ks = 0; ks < 4; ++ks) a = mfma16(bfr[ks], ldfrag(lds, CM_OFF, ltq * 16 + fr, 136, ks * 32 + fq * 8), a);
        const int l_ = ltq * 16 + fr;
        const float al = acs[l_];
        float mv[4];
#pragma unroll
        for (int r = 0; r < 4; ++r) { const int s_ = st * 16 + fq * 4 + r; const float ex = __expf(al - acs[s_]); mv[r] = (s_ <= l_) ? a[r] * ex : 0.f; }
        *(LAS u32x2*)(lds + MM_OFF + (l_ * 72 + st * 16 + fq * 4) * 2) = (u32x2){pk2(mv[0], mv[1]), pk2(mv[2], mv[3])};
      }
    }
    f32x4 accI[2];
    accI[0] = (f32x4){0.f, 0.f, 0.f, 0.f}; accI[1] = accI[0];
#pragma unroll
    for (int ks = 0; ks < 4; ++ks) {
      const bf16x8 cfr = ldfrag(lds, CM_OFF, lt * 16 + fr, 136, ks * 32 + fq * 8);
#pragma unroll
      for (int q = 0; q < 2; ++q) accI[q] = mfma16(ldfrag(lds, HB_OFF, (ptb + q) * 16 + fr, 136, ks * 32 + fq * 8), cfr, accI[q]);
    }
    {
      const float dec = __expf(acs[63]);
      bf16x8 bt[2];
#pragma unroll
      for (int ks = 0; ks < 2; ++ks) bt[ks] = ldfrag(lds, BMT_OFF, wid * 16 + fr, 72, ks * 32 + fq * 8);
#pragma unroll
      for (int pt = 0; pt < 4; ++pt) {
        hacc[pt] = hacc[pt] * dec;
#pragma unroll
        for (int ks = 0; ks < 2; ++ks) hacc[pt] = mfma16(bt[ks], ldfrag(lds, XW_OFF, pt * 16 + fr, 72, ks * 32 + fq * 8), hacc[pt]);
      }
    }
    LDS_BARRIER();
    {
      f32x4 accY[2];
      accY[0] = (f32x4){0.f, 0.f, 0.f, 0.f}; accY[1] = accY[0];
#pragma unroll
      for (int ks = 0; ks < 2; ++ks) {
        const bf16x8 mf = ldfrag(lds, MM_OFF, lt * 16 + fr, 72, ks * 32 + fq * 8);
#pragma unroll
        for (int q = 0; q < 2; ++q) accY[q] = mfma16(ldfrag(lds, XDT_OFF, (ptb + q) * 16 + fr, 72, ks * 32 + fq * 8), mf, accY[q]);
      }
      const int l_ = lt * 16 + fr;
      const float el = __expf(acs[l_]);
      float sq = 0.f;
#pragma unroll
      for (int q = 0; q < 2; ++q) {
        const int p0 = (ptb + q) * 16 + fq * 4;
        const u32x2 xs4 = *(const LAS u32x2*)(lds + XS_OFF + (l_ * 72 + p0) * 2);
        bf16_t* zp = proj + (size_t)(ctok + l_) * LDP + C_ZA + h * 64 + p0;
        const u32x2 z4 = z4v[q];
        const float y0 = (accY[q][0] + el * accI[q][0] + Dh * lo_f(xs4.x)) * siluf(lo_f(z4.x));
        const float y1 = (accY[q][1] + el * accI[q][1] + Dh * hi_f(xs4.x)) * siluf(hi_f(z4.x));
        const float y2 = (accY[q][2] + el * accI[q][2] + Dh * lo_f(xs4.y)) * siluf(lo_f(z4.y));
        const float y3 = (accY[q][3] + el * accI[q][3] + Dh * hi_f(xs4.y)) * siluf(hi_f(z4.y));
        sq += y0 * y0 + y1 * y1 + y2 * y2 + y3 * y3;
        *(u32x2*)zp = (u32x2){pk2(y0, y1), pk2(y2, y3)};
      }
      sq += __shfl_xor(sq, 16); sq += __shfl_xor(sq, 32);
      if (fq == 0) ssq[(wid & 1) * 64 + l_] = sq;
    }
    LDS_BARRIER();
    if (tid < 64) p.ssqa[(size_t)(ctok + tid) * 16 + h] = ssq[tid] + ssq[64 + tid];
  }
  {
    float* so = p.out + (smp ? O_SSDS : O_SSDP);
#pragma unroll
    for (int pt = 0; pt < 4; ++pt)
      *(f32x4*)(so + ((((size_t)l * NB + b) * 16 + h) * 64 + pt * 16 + fr) * 128 + wid * 16 + fq * 4) = hacc[pt];
    float* co = p.out + (smp ? O_CONVS : O_CONVP);
    const int L = smp ? 64 : 2048;
    for (int i = tid; i < 3 * 320; i += 512) {
      const int r = i / 320, cc = i % 320;
      if (cc >= 64 && (h & 3)) continue;
      const int ch = (cc < 64) ? (h * 64 + cc) : (cc < 192) ? (1024 + g * 128 + (cc - 64)) : (1536 + g * 128 + (cc - 192));
      co[(((size_t)l * NB + b) * 3 + r) * 2048 + ch] = bf2f(proj[(size_t)(tok0 + L - 3 + r) * LDP + C_XBC + ch]);
    }
  }
  __syncthreads();
}

__device__ __forceinline__ float fma_asm(float a, float b, float c) { float d; asm volatile("v_fma_f32 %0, %1, %2, %3" : "=v"(d) : "v"(a), "v"(b), "v"(c)); return d; }
__device__ void s5_seq(LAS unsigned char* lds, const Params& p, int l, int b, int g, bool smp) {
  const int tid_ = otid(); const int wid = tid_ >> 6, lane = tid_ & 63, fr = lane & 15, fq = lane >> 4;
  LAS float* buf = (LAS float*)(lds + wid * 16896);
  const int tok0 = smp ? (TP + b * 64) : (b * 2048);
  const int nblk = smp ? 2 : 64;
  const int NB = smp ? 8 : 16;
  const int lg = l * 64 + g;
  bf16x8 Bfrag[4], Cfrag[4];
#pragma unroll
  for (int nt = 0; nt < 4; ++nt) Bfrag[nt] = *(const bf16x8*)(p.BbT + ((size_t)lg * 128 + nt * 32 + (lane & 31)) * 16 + 8 * (lane >> 5));
#pragma unroll
  for (int ks = 0; ks < 4; ++ks) Cfrag[ks] = *(const bf16x8*)(p.CmT + ((size_t)lg * 16 + fr) * 128 + ks * 32 + fq * 8);
  const float lr = p.lamb[(size_t)(lg * 64 + lane) * 2], li = p.lamb[(size_t)(lg * 64 + lane) * 2 + 1];
  const float nli = -li;
  float hr = 0.f, hi = 0.f;
  if (smp) { hr = p.st_s5re[(((size_t)l * 8 + b) * 64 + g) * 64 + lane]; hi = p.st_s5im[(((size_t)l * 8 + b) * 64 + g) * 64 + lane]; }
  const f32x4 d4 = *(const f32x4*)(p.d_s5 + l * 1024 + g * 16 + fq * 4);
  const bf16_t* ubase = p.proj + C_U + g * 16;
  bf16x8 a_next = *(const bf16x8*)(ubase + (size_t)(tok0 + (lane & 31)) * LDP + 8 * (lane >> 5));
  for (int blk = 0; blk < nblk; ++blk) {
    const bf16x8 a = a_next;
    if (blk + 1 < nblk) a_next = *(const bf16x8*)(ubase + (size_t)(tok0 + (blk + 1) * 32 + (lane & 31)) * LDP + 8 * (lane >> 5));
    u32x2 u4v[2];
#pragma unroll
    for (int mt = 0; mt < 2; ++mt) u4v[mt] = *(const u32x2*)(ubase + (size_t)(tok0 + blk * 32 + mt * 16 + fr) * LDP + fq * 4);
    float bre[32], bim[32];
    {
      f32x16 d[4];
#pragma unroll
      for (int nt = 0; nt < 4; ++nt) {
        f32x16 z = {0.f, 0.f, 0.f, 0.f, 0.f, 0.f, 0.f, 0.f, 0.f, 0.f, 0.f, 0.f, 0.f, 0.f, 0.f, 0.f};
        d[nt] = __builtin_amdgcn_mfma_f32_32x32x16_bf16(a, Bfrag[nt], z, 0, 0, 0);
      }
#pragma unroll
      for (int r = 0; r < 16; ++r) {
        const int tA = (r & 3) + 8 * (r >> 2);
        const auto sr = __builtin_amdgcn_permlane32_swap(__float_as_uint(d[0][r]), __float_as_uint(d[1][r]), false, false);
        bre[tA] = __uint_as_float(sr[0]); bre[tA + 4] = __uint_as_float(sr[1]);
        const auto si = __builtin_amdgcn_permlane32_swap(__float_as_uint(d[2][r]), __float_as_uint(d[3][r]), false, false);
        bim[tA] = __uint_as_float(si[0]); bim[tA + 4] = __uint_as_float(si[1]);
      }
    }
#pragma unroll
    for (int t = 0; t < 32; ++t) {
      float nr = fma_asm(lr, hr, bre[t]); nr = fma_asm(nli, hi, nr);
      float ni = fma_asm(lr, hi, bim[t]); ni = fma_asm(li, hr, ni);
      hr = nr; hi = ni;
      buf[t * 132 + lane] = hr; buf[t * 132 + 64 + lane] = hi;
    }
    asm volatile("s_waitcnt lgkmcnt(0)" ::: "memory");
#pragma unroll
    for (int mt = 0; mt < 2; ++mt) {
      f32x4 acc = (f32x4){0.f, 0.f, 0.f, 0.f};
#pragma unroll
      for (int ks = 0; ks < 4; ++ks) {
        const LAS float* hp = buf + (mt * 16 + fr) * 132 + ks * 32 + fq * 8;
        const f32x4 h0 = *(const LAS f32x4*)hp, h1 = *(const LAS f32x4*)(hp + 4);
        u32x4 hw = (u32x4){pk2(h0[0], h0[1]), pk2(h0[2], h0[3]), pk2(h1[0], h1[1]), pk2(h1[2], h1[3])};
        bf16x8 hf = __builtin_bit_cast(bf16x8, hw);
        acc = mfma16(Cfrag[ks], hf, acc);
      }
      const size_t trow = (size_t)(tok0 + blk * 32 + mt * 16 + fr);
      const u32x2 u4 = u4v[mt];
      const float y0 = gelu_tanh(acc[0] + d4[0] * lo_f(u4.x));
      const float y1 = gelu_tanh(acc[1] + d4[1] * hi_f(u4.x));
      const float y2 = gelu_tanh(acc[2] + d4[2] * lo_f(u4.y));
      const float y3 = gelu_tanh(acc[3] + d4[3] * hi_f(u4.y));
      *(u32x2*)(p.xb + trow * 1024 + g * 16 + fq * 4) = (u32x2){pk2(y0, y1), pk2(y2, y3)};
    }
    asm volatile("" ::: "memory");
  }
  p.out[(smp ? O_S5RES : O_S5REP) + (((size_t)l * NB + b) * 64 + g) * 64 + lane] = hr;
  p.out[(smp ? O_S5IMS : O_S5IMP) + (((size_t)l * NB + b) * 64 + g) * 64 + lane] = hi;
}

__device__ void phase_mixer(LAS unsigned char* lds, const Params& p, int l) {
  const int wid = otid() >> 6;
  for (int u = blockIdx.x; u < 768; u += gridDim.x) {
    if (u < 256) {
      const int x = u & 7, j = u >> 3, G = x * 8 + (j >> 2);
      ssd_item(lds, p, l, G >> 2, (G & 3) * 4 + (j & 3), false);
    }
    else if (u < 512) { if (wid < 4) { const int seq = (u - 256) * 4 + wid; s5_seq(lds, p, l, seq >> 6, seq & 63, false); } }
    else if (u < 640) {
      const int v = u - 512, x = v & 7, j = v >> 3, G = x * 4 + (j >> 2);
      ssd_item(lds, p, l, G >> 2, (G & 3) * 4 + (j & 3), true);
    }
    else { if (wid < 4) { const int seq = (u - 640) * 4 + wid; s5_seq(lds, p, l, seq >> 6, seq & 63, true); } }
    __syncthreads();
  }
}

__device__ void norm_unit(const Params& p, int nu) {
  const int tid = otid();
  const int tok = nu * 32 + (tid >> 4), hh = tid & 15, gg = hh >> 2;
  const f32x4 s4 = *(const f32x4*)(p.ssqa + (size_t)tok * 16 + gg * 4);
  const float rs = rsqrtf((s4[0] + s4[1] + s4[2] + s4[3]) * (1.f / 256.f) + 1e-6f);
  bf16_t* q = p.proj + (size_t)tok * LDP + C_ZA + hh * 64;
#pragma unroll
  for (int i = 0; i < 8; ++i) {
    u32x4 v = *(u32x4*)(q + i * 8);
#pragma unroll
    for (int k = 0; k < 4; ++k) v[k] = pk2(lo_f(v[k]) * rs, hi_f(v[k]) * rs);
    *(u32x4*)(q + i * 8) = v;
  }
}

__device__ void final_unit(const Params& p, int unit) {
  const int tid_ = otid(); const int wid = tid_ >> 6, lane = tid_ & 63;
  const int row = unit * 8 + wid;
  const f32x4* sp = (const f32x4*)(p.sumsq + ((size_t)4 * T_TOK + row) * 16);
  const f32x4 s0 = sp[0], s1 = sp[1], s2 = sp[2], s3 = sp[3];
  const float ss = ((s0[0] + s0[1]) + (s0[2] + s0[3])) + ((s1[0] + s1[1]) + (s1[2] + s1[3])) +
                   ((s2[0] + s2[1]) + (s2[2] + s2[3])) + ((s3[0] + s3[1]) + (s3[2] + s3[3]));
  const float rs = rsqrtf(ss * (1.f / 1024.f) + 1e-6f);
  float* xr = p.out + (size_t)row * 1024;
#pragma unroll
  for (int i = 0; i < 4; ++i) {
    const int c = i * 256 + lane * 4;
    const f32x4 v = *(const f32x4*)(xr + c);
    const f32x4 gv = *(const f32x4*)(p.final_g + c);
    *(f32x4*)(xr + c) = v * rs * gv;
  }
}

__device__ __forceinline__ void grid_barrier(cg::grid_group& grid, unsigned* ctr, unsigned target) {
  asm volatile("s_waitcnt vmcnt(0) lgkmcnt(0)" ::: "memory");
  __syncthreads();
  if (target == gridDim.x) grid.sync();
  if (threadIdx.x == 0) {
    __builtin_amdgcn_fence(__ATOMIC_RELEASE, "agent");
    asm volatile("s_waitcnt vmcnt(0)" ::: "memory");
    __hip_atomic_fetch_add(ctr, 1u, __ATOMIC_RELAXED, __HIP_MEMORY_SCOPE_AGENT);
    while (__hip_atomic_load(ctr, __ATOMIC_RELAXED, __HIP_MEMORY_SCOPE_AGENT) < target) __builtin_amdgcn_s_sleep(1);
    __builtin_amdgcn_fence(__ATOMIC_ACQUIRE, "agent");
    asm volatile("s_waitcnt vmcnt(0)" ::: "memory");
  }
  __syncthreads();
}

__global__ void __launch_bounds__(NTHREADS) mega(Params p) {
  __shared__ __attribute__((aligned(1024))) unsigned char shm[LDS_BYTES];
  LAS unsigned char* lds = (LAS unsigned char*)shm;
  cg::grid_group grid = cg::this_grid();
  unsigned nbar = 0;
  phase_prep(lds, p);
  grid_barrier(grid, p.bar, (++nbar) * gridDim.x);
  for (int ph = 1; ph < p.phase_end; ++ph) {
    if (ph == 17) {
      for (int u = blockIdx.x; u < 4160; u += gridDim.x) final_unit(p, u);
    } else {
      const int l = (ph - 1) >> 2, sub = (ph - 1) & 3;
      if (sub == 0) {
        g8::EpiIn8 e{p.proj, p.sumsq + (size_t)l * T_TOK * 16};
        g8::Order S{NMT * 21, 21, 0, 0};
        g8::gemm_phase8(lds, p.xb, 1024, 1 << 30, 0, p.WinT + (size_t)l * 5376 * 1024, 1024, 1024, S, e);
      } else if (sub == 1) {
        phase_mixer(lds, p, l);
      } else if (sub == 2) {
        g8::EpiGlu8 e{p.proj, p.b_glu + l * 1024, p.xb};
        g8::Order S{NMT * 4, 4, 0, 0};
        g8::gemm_phase8(lds, p.xb, 1024, 1 << 30, 0, p.WgluT + (size_t)l * 1024 * 1024, 1024, 1024, S, e);
        for (int u = gridDim.x - 1 - blockIdx.x; u < 1040; u += gridDim.x) norm_unit(p, u);
      } else {
        g8::EpiOut8 e{l == 0 ? p.x_prompt : p.out, l == 0 ? p.x_sample : (p.out + (size_t)TP * 1024), p.out,
                      l == 3 ? (bf16_t*)nullptr : p.xb, p.sumsq + (size_t)(l + 1) * T_TOK * 16};
        g8::Order S{512, 4, 0, 0};
        g8::gemm_phase8(lds, p.proj, LDP, 16, 3072, p.WoutT + (size_t)l * 1024 * 2048, 2048, 2048, S, e);
#pragma unroll 1
        for (int q = 0; q < 4; ++q) {
          const int kt0 = q * 8;
          g8::Order Sq{0, 4, 1, q};
          g8::EpiPart8 ep{p.part + (size_t)q * 512 * 1024};
          g8::gemm_phase8(lds, p.proj + kt0 * 64 + (kt0 >= 16 ? 3072 : 0), LDP, 1 << 30, 0, p.WoutT + (size_t)l * 1024 * 2048 + kt0 * 64, 2048, 512, Sq, ep);
        }
        grid_barrier(grid, p.bar, (++nbar) * gridDim.x);
        {
          const int tid_ = otid(); const int wid = tid_ >> 6, lane = tid_ & 63;
          for (int r = blockIdx.x * 8 + wid; r < 512; r += gridDim.x * 8) {
            const int row = TP + r;
            const float* xr = (l == 0) ? (p.x_sample + (size_t)r * 1024) : (p.out + (size_t)row * 1024);
            float ssum = 0.f;
#pragma unroll
            for (int i = 0; i < 4; ++i) {
              const int c = i * 256 + lane * 4;
              f32x4 v = *(const f32x4*)(xr + c);
#pragma unroll
              for (int q = 0; q < 4; ++q) v += *(const f32x4*)(p.part + ((size_t)q * 512 + r) * 1024 + c);
              *(f32x4*)(p.out + (size_t)row * 1024 + c) = v;
              if (l < 3) { u32x2 o; o.x = pk2(v[0], v[1]); o.y = pk2(v[2], v[3]); *(u32x2*)(p.xb + (size_t)row * 1024 + c) = o; }
              ssum += v[0] * v[0] + v[1] * v[1] + v[2] * v[2] + v[3] * v[3];
            }
#pragma unroll
            for (int o = 32; o >= 1; o >>= 1) ssum += __shfl_xor(ssum, o);
            if (lane < 16) p.sumsq[((size_t)(l + 1) * T_TOK + row) * 16 + lane] = (lane == 0) ? ssum : 0.f;
          }
        }
      }
    }
    if (ph + 1 < p.phase_end) grid_barrier(grid, p.bar, (++nbar) * gridDim.x);
  }
}

extern "C" void kernel_launch(void* const* d_in, const int* in_sizes, int n_in, void* d_out, int out_size, void* d_ws, size_t ws_size,
                              hipStream_t stream) {
  static int grid_blocks = 0;
  if (!grid_blocks) {
    int dev = 0, cus = 0, per_cu = 0;
    hipGetDevice(&dev);
    hipDeviceGetAttribute(&cus, hipDeviceAttributeMultiprocessorCount, dev);
    hipOccupancyMaxActiveBlocksPerMultiprocessor(&per_cu, mega, NTHREADS, 0);
    if (per_cu < 1) per_cu = 1;
    if (per_cu > 1) per_cu = 1;
    grid_blocks = cus * per_cu;
  }
  Params p{};
  const float* const* in = (const float* const*)d_in;
  p.x_prompt = in[0]; p.x_sample = in[1]; p.st_conv = in[2]; p.st_ssd = in[3]; p.st_s5re = in[4]; p.st_s5im = in[5];
  p.norm_g = in[6]; p.w_in = in[7]; p.conv_w = in[8]; p.conv_b = in[9]; p.dt_bias = in[10]; p.a_log = in[11]; p.d_ssd = in[12];
  p.ssd_norm_g = in[13]; p.lam_re = in[14]; p.lam_im = in[15]; p.log_dt = in[16]; p.b_re = in[17]; p.b_im = in[18];
  p.c_re = in[19]; p.c_im = in[20]; p.d_s5 = in[21]; p.w_glu = in[22]; p.b_glu = in[23]; p.w_out = in[24]; p.final_g = in[25];
  p.out = (float*)d_out;
  unsigned char* ws = (unsigned char*)d_ws;
  size_t off = 0;
  auto take = [&](size_t bytes) { unsigned char* r = ws + off; off += (bytes + 1023) & ~(size_t)1023; return r; };
  p.xb = (bf16_t*)take((size_t)T_TOK * 1024 * 2);
  p.proj = (bf16_t*)take((size_t)T_TOK * LDP * 2);
  p.WinT = (bf16_t*)take((size_t)4 * 5376 * 1024 * 2);
  p.WgluT = (bf16_t*)take((size_t)4 * 1024 * 1024 * 2);
  p.WoutT = (bf16_t*)take((size_t)4 * 1024 * 2048 * 2);
  p.BbT = (bf16_t*)take((size_t)256 * 2048 * 2);
  p.CmT = (bf16_t*)take((size_t)256 * 2048 * 2);
  p.sumsq = (float*)take((size_t)5 * T_TOK * 16 * 4);
  p.ssqa = (float*)take((size_t)T_TOK * 16 * 4);
  p.lamb = (float*)take((size_t)256 * 64 * 2 * 4);
  p.part = (float*)take((size_t)4 * 512 * 1024 * 4);
  p.bar = (unsigned*)take(1024);
  hipMemsetAsync(p.bar, 0, 1024, stream);
  if (off > ws_size) { fprintf(stderr, "workspace too small: need %zu have %zu\n", off, ws_size); return; }
  p.phase_begin = 0; p.phase_end = 18;
  void* args[] = {&p};
  hipError_t e = hipLaunchCooperativeKernel((void*)mega, dim3(grid_blocks), dim3(NTHREADS), args, 0, stream);
  if (e != hipSuccess) fprintf(stderr, "cooperative launch failed: %s (grid %d)\n", hipGetErrorString(e), grid_blocks);
}
```

```cpp
#include <hip/hip_runtime.h>
#include <hip/hip_cooperative_groups.h>
#include <cstdio>
namespace cg = cooperative_groups;

#define LAS __attribute__((address_space(3)))
typedef unsigned short bf16_t;
typedef short bf16x8 __attribute__((ext_vector_type(8)));
typedef float f32x4 __attribute__((ext_vector_type(4)));
typedef float f32x16 __attribute__((ext_vector_type(16)));
typedef unsigned u32x4 __attribute__((ext_vector_type(4)));
typedef unsigned u32x2 __attribute__((ext_vector_type(2)));

constexpr int T_TOK = 33280, TP = 32768, NMT = 130;
constexpr int LDP = 5376;
constexpr int C_ZA = 0, C_XBC = 1024, C_U = 3072, C_ZB = 4096, C_DT = 5120;
constexpr int NTHREADS = 512;
constexpr int LDS_BYTES = 139264;

constexpr size_t O_Y = 0, O_CONVP = 34078720, O_SSDP = 34471936, O_S5REP = 42860544, O_S5IMP = 43122688,
                 O_CONVS = 43384832, O_SSDS = 43581440, O_S5RES = 47775744, O_S5IMS = 47906816;

struct Params {
  const float *x_prompt, *x_sample, *st_conv, *st_ssd, *st_s5re, *st_s5im;
  const float *norm_g, *w_in, *conv_w, *conv_b, *dt_bias, *a_log, *d_ssd, *ssd_norm_g;
  const float *lam_re, *lam_im, *log_dt, *b_re, *b_im, *c_re, *c_im, *d_s5, *w_glu, *b_glu, *w_out, *final_g;
  float* out;
  bf16_t *xb, *proj, *WinT, *WgluT, *WoutT, *BbT, *CmT;
  float *sumsq, *ssqa, *lamb, *part;
  unsigned* bar;
  int phase_begin, phase_end;
};

__device__ __forceinline__ float bf2f(unsigned short v) { return __uint_as_float(((unsigned)v) << 16); }
__device__ __forceinline__ float lo_f(unsigned w) { return __uint_as_float(w << 16); }
__device__ __forceinline__ float hi_f(unsigned w) { return __uint_as_float(w & 0xffff0000u); }
__device__ __forceinline__ unsigned pk2(float lo, float hi) { unsigned r; asm("v_cvt_pk_bf16_f32 %0, %1, %2" : "=v"(r) : "v"(lo), "v"(hi)); return r; }
__device__ __forceinline__ float sigm(float x) { return __builtin_amdgcn_rcpf(1.f + __expf(-x)); }
__device__ __forceinline__ float siluf(float x) { return x * sigm(x); }
__device__ __forceinline__ float gelu_tanh(float x) { const float z = 0.7978845608028654f * (x + 0.044715f * x * x * x); return x * sigm(2.f * z); }
__device__ __forceinline__ f32x4 mfma16(bf16x8 a, bf16x8 b, f32x4 c) { return __builtin_amdgcn_mfma_f32_16x16x32_bf16(a, b, c, 0, 0, 0); }
#define WAIT_V0() asm volatile("s_waitcnt vmcnt(0)" ::: "memory")
#define LDS_BARRIER() asm volatile("s_waitcnt lgkmcnt(0)\n\ts_barrier" ::: "memory")
__device__ __forceinline__ int otid() { int t = threadIdx.x; asm volatile("" : "+v"(t)); return t; }

__device__ __forceinline__ void stage_rc(int b, int& R, int& C) {
  const int st = b >> 10, sb = b & 1023, swz = sb ^ (((sb >> 9) & 1) << 5);
  R = (st >> 1) * 16 + swz / 64;
  C = (st & 1) * 32 + (swz % 64) / 2;
}

__device__ __forceinline__ int xcd_remap(int u) {
  const int G = gridDim.x, i = u / G, blk = u % G, per = G >> 3;
  if (G & 7) return u;
  return (i * 8 + (blk & 7)) * per + (blk >> 3);
}
__device__ __forceinline__ void tile_map(int u, int nN, int& pm, int& pn) {
  const int nig = 8 * nN, gid = u / nig, fm = gid * 8, rem = u % nig;
  const int gsz = (NMT - fm) < 8 ? (NMT - fm) : 8;
  pm = fm + rem % gsz; pn = rem / gsz;
}

namespace g8 {
constexpr int HTB = 128 * 64 * 2;
__device__ __forceinline__ int lds_byte(int r, int c) { const int st = (r >> 4) * 2 + (c >> 5), rr = r & 15, cc = c & 31, ob = rr * 64 + cc * 2; return st * 1024 + (ob ^ (((ob >> 9) & 1) << 5)); }
struct Unit { int pm, pn; };
struct Order {
  int ntiles, nN, mode, q;
  __device__ __forceinline__ bool next(int i, Unit& u) const {
    if (mode == 1) {
      if (i != 0 || (int)blockIdx.x >= 32 || ((int)blockIdx.x >> 3) != q) return false;
      tile_map(512 + ((int)blockIdx.x & 7), 4, u.pm, u.pn); return true;
    }
    const int w = xcd_remap((int)blockIdx.x + i * (int)gridDim.x);
    if (w >= ntiles) return false;
    tile_map(w, nN, u.pm, u.pn); return true;
  }
};
__device__ __forceinline__ int perm32(int rho) { const int n = rho >> 4, i = rho & 15; return 8 * (i >> 2) + 4 * n + (i & 3); }
struct EpiIn8 {
  static constexpr bool PERM = true;
  bf16_t* proj; const float* sumsq;
  __device__ __forceinline__ void operator()(const f32x4 (&acc)[2][2][4][2], const Unit& u, int wr, int wc, int fr, int fq) const {
    const int row0 = u.pm * 256 + wr * 64 + fr, col0 = u.pn * 256 + wc * 32 + fq * 8;
#pragma unroll
    for (int ai = 0; ai < 2; ++ai)
#pragma unroll
      for (int m = 0; m < 4; ++m) {
        asm volatile("" ::: "memory");
        const int row = row0 + ai * 128 + m * 16;
        const f32x4* sp = (const f32x4*)(sumsq + (size_t)row * 16);
        const f32x4 s0 = sp[0], s1 = sp[1], s2 = sp[2], s3 = sp[3];
        const float ss = ((s0[0] + s0[1]) + (s0[2] + s0[3])) + ((s1[0] + s1[1]) + (s1[2] + s1[3])) +
                         ((s2[0] + s2[1]) + (s2[2] + s2[3])) + ((s3[0] + s3[1]) + (s3[2] + s3[3]));
        const float rs = rsqrtf(ss * (1.f / 1024.f) + 1e-6f);
        bf16_t* rp = proj + (size_t)row * LDP + col0;
#pragma unroll
        for (int bj = 0; bj < 2; ++bj) {
          const f32x4 v0 = acc[ai][bj][m][0] * rs, v1 = acc[ai][bj][m][1] * rs;
          *(u32x4*)(rp + bj * 128) = (u32x4){pk2(v0[0], v0[1]), pk2(v0[2], v0[3]), pk2(v1[0], v1[1]), pk2(v1[2], v1[3])};
        }
      }
  }
};
struct EpiGlu8 {
  static constexpr bool PERM = true;
  bf16_t* proj; const float* bglu; const bf16_t* ys;
  __device__ __forceinline__ void operator()(const f32x4 (&acc)[2][2][4][2], const Unit& u, int wr, int wc, int fr, int fq) const {
    const int row0 = u.pm * 256 + wr * 64 + fr, col0 = u.pn * 256 + wc * 32 + fq * 8;
#pragma unroll
    for (int ai = 0; ai < 2; ++ai)
#pragma unroll
      for (int m = 0; m < 4; ++m) {
        asm volatile("" ::: "memory");
        const int row = row0 + ai * 128 + m * 16;
        bf16_t* base = proj + (size_t)row * LDP;
#pragma unroll
        for (int bj = 0; bj < 2; ++bj) {
          const int col = col0 + bj * 128;
          const f32x4 g0 = acc[ai][bj][m][0] + *(const f32x4*)(bglu + col), g1 = acc[ai][bj][m][1] + *(const f32x4*)(bglu + col + 4);
          const u32x4 a = *(const u32x4*)(ys + (size_t)row * 1024 + col);
          const u32x4 z = *(const u32x4*)(base + C_ZB + col);
          u32x4 o;
          o[0] = pk2(lo_f(a[0]) * sigm(g0[0]) * siluf(lo_f(z[0])), hi_f(a[0]) * sigm(g0[1]) * siluf(hi_f(z[0])));
          o[1] = pk2(lo_f(a[1]) * sigm(g0[2]) * siluf(lo_f(z[1])), hi_f(a[1]) * sigm(g0[3]) * siluf(hi_f(z[1])));
          o[2] = pk2(lo_f(a[2]) * sigm(g1[0]) * siluf(lo_f(z[2])), hi_f(a[2]) * sigm(g1[1]) * siluf(hi_f(z[2])));
          o[3] = pk2(lo_f(a[3]) * sigm(g1[2]) * siluf(lo_f(z[3])), hi_f(a[3]) * sigm(g1[3]) * siluf(hi_f(z[3])));
          *(u32x4*)(base + C_ZB + col) = o;
        }
      }
  }
};
struct EpiOut8 {
  static constexpr bool PERM = true;
  const float *xin_p, *xin_s; float* xout; bf16_t* xb; float* ssq_next;
  __device__ __forceinline__ void operator()(const f32x4 (&acc)[2][2][4][2], const Unit& u, int wr, int wc, int fr, int fq) const {
    const int row0 = u.pm * 256 + wr * 64 + fr, col0 = u.pn * 256 + wc * 32 + fq * 8;
#pragma unroll
    for (int ai = 0; ai < 2; ++ai)
#pragma unroll
      for (int m = 0; m < 4; ++m) {
        asm volatile("" ::: "memory");
        const int row = row0 + ai * 128 + m * 16;
        const float* xr = (row < TP) ? (xin_p + (size_t)row * 1024) : (xin_s + (size_t)(row - TP) * 1024);
        float s = 0.f;
#pragma unroll
        for (int bj = 0; bj < 2; ++bj) {
          const int col = col0 + bj * 128;
          const f32x4 v0 = acc[ai][bj][m][0] + *(const f32x4*)(xr + col), v1 = acc[ai][bj][m][1] + *(const f32x4*)(xr + col + 4);
          *(f32x4*)(xout + (size_t)row * 1024 + col) = v0;
          *(f32x4*)(xout + (size_t)row * 1024 + col + 4) = v1;
          if (xb) *(u32x4*)(xb + (size_t)row * 1024 + col) = (u32x4){pk2(v0[0], v0[1]), pk2(v0[2], v0[3]), pk2(v1[0], v1[1]), pk2(v1[2], v1[3])};
          s += v0[0] * v0[0] + v0[1] * v0[1] + v0[2] * v0[2] + v0[3] * v0[3] + v1[0] * v1[0] + v1[1] * v1[1] + v1[2] * v1[2] + v1[3] * v1[3];
        }
        s += __shfl_xor(s, 16); s += __shfl_xor(s, 32);
        if (fq == 0) ssq_next[(size_t)row * 16 + u.pn * 4 + wc] = s;
      }
  }
};

struct EpiPart8 {
  static constexpr bool PERM = true;
  float* part;
  __device__ __forceinline__ void operator()(const f32x4 (&acc)[2][2][4][2], const Unit& u, int wr, int wc, int fr, int fq) const {
    const int row0 = u.pm * 256 + wr * 64 + fr - TP, col0 = u.pn * 256 + wc * 32 + fq * 8;
#pragma unroll
    for (int ai = 0; ai < 2; ++ai)
#pragma unroll
      for (int m = 0; m < 4; ++m)
#pragma unroll
        for (int bj = 0; bj < 2; ++bj) {
          float* q0 = part + (size_t)(row0 + ai * 128 + m * 16) * 1024 + col0 + bj * 128;
          *(f32x4*)q0 = acc[ai][bj][m][0]; *(f32x4*)(q0 + 4) = acc[ai][bj][m][1];
        }
  }
};

template <class Epi>
__device__ __forceinline__ void gemm_phase8(LAS unsigned char* lds, const bf16_t* A, int lda, int segkt, int segoff, const bf16_t* Bt, int ldb, int K,
                                            const Order& S, const Epi& E) {
  const int tid = otid(), wid = __builtin_amdgcn_readfirstlane(tid >> 6), lane = tid & 63, wr = wid >> 2, wc = wid & 3, fr = lane & 15, fq = lane >> 4;
  const int nt = K / 64;
  unsigned voffA[2], voffB[2];
#pragma unroll
  for (int i = 0; i < 2; ++i) { int R, C; stage_rc(tid * 16 + i * 8192, R, C); const int Rb = Epi::PERM ? ((R & ~31) + perm32(R & 31)) : R;
    voffA[i] = (unsigned)(R * lda + C) * 2u; voffB[i] = (unsigned)(Rb * ldb + C) * 2u; }
  const size_t kstep = 128;
  const size_t hstepA = (size_t)128 * lda * 2, tstepA = 2 * hstepA;
  const size_t hstepB = (size_t)128 * ldb * 2, tstepB = 2 * hstepB;
  const size_t segB = (size_t)segoff * 2;
#define G8_AK(kt) ((size_t)(kt) * 128 + (((kt) >= segkt) ? segB : (size_t)0))
  const unsigned ldsw = (unsigned)wid * 1024u;
  const int aoff = lds_byte(wr * 64 + fr, fq * 8), boff = lds_byte(wc * 32 + fr, fq * 8);
#define G8_SA(b, h) (((b) * 2 + (h)) * HTB)
#define G8_SB(b, h) ((4 + (b) * 2 + (h)) * HTB)
#define G8_STAGE(bufoff, gbase, voff) do { _Pragma("unroll") for (int _i = 0; _i < 2; ++_i) \
    __builtin_amdgcn_global_load_lds((const unsigned*)((const char*)(gbase) + (voff)[_i]), (LAS unsigned*)(lds + (bufoff) + ldsw + _i * 8192), 16, 0, 0); } while (0)
#define G8_LDA(dst, b, h) do { _Pragma("unroll") for (int m = 0; m < 4; ++m) _Pragma("unroll") for (int k = 0; k < 2; ++k) dst[m][k] = *(const LAS bf16x8*)(lds + G8_SA(b, h) + aoff + m * 2048 + k * 1024); } while (0)
#define G8_LDB(dst, b, h) do { _Pragma("unroll") for (int n = 0; n < 2; ++n) _Pragma("unroll") for (int k = 0; k < 2; ++k) dst[n][k] = *(const LAS bf16x8*)(lds + G8_SB(b, h) + boff + n * 2048 + k * 1024); } while (0)
#define G8_MMA(ai, bj, At, Bt_) do { __builtin_amdgcn_s_setprio(1); _Pragma("unroll") for (int m = 0; m < 4; ++m) _Pragma("unroll") for (int n = 0; n < 2; ++n) _Pragma("unroll") for (int k = 0; k < 2; ++k) \
    acc[ai][bj][m][n] = __builtin_amdgcn_mfma_f32_16x16x32_bf16(Bt_[n][k], At[m][k], acc[ai][bj][m][n], 0, 0, 0); __builtin_amdgcn_s_setprio(0); } while (0)
#define G8_WAIT_V(n) asm volatile("s_waitcnt vmcnt(" #n ")" ::: "memory")
#define G8_WAIT_L(n) asm volatile("s_waitcnt lgkmcnt(" #n ")" ::: "memory")
#define G8_BAR __builtin_amdgcn_s_barrier()
#define G8_SCHED __builtin_amdgcn_sched_barrier(0)
  Unit cur, nxt; int ui = 0;
  if (!S.next(0, cur)) return;
  f32x4 acc[2][2][4][2];
#pragma unroll
  for (int a = 0; a < 2; ++a)
#pragma unroll
    for (int b = 0; b < 2; ++b)
#pragma unroll
      for (int m = 0; m < 4; ++m)
#pragma unroll
        for (int n = 0; n < 2; ++n) acc[a][b][m][n] = (f32x4){0.f, 0.f, 0.f, 0.f};
  bf16x8 At[4][2], B0[2][2], B1[2][2];
  const char* cA = (const char*)A + (size_t)cur.pm * tstepA; const char* cB = (const char*)Bt + (size_t)cur.pn * tstepB;
  G8_STAGE(G8_SB(0, 0), cB, voffB); G8_STAGE(G8_SA(0, 0), cA, voffA); G8_STAGE(G8_SB(0, 1), cB + hstepB, voffB); G8_STAGE(G8_SA(0, 1), cA + hstepA, voffA);
  if (wr == 1) G8_BAR;
  G8_WAIT_V(4); G8_BAR;
  G8_STAGE(G8_SB(1, 0), cB + kstep, voffB); G8_STAGE(G8_SA(1, 0), cA + G8_AK(1), voffA); G8_STAGE(G8_SB(1, 1), cB + hstepB + kstep, voffB);
  G8_WAIT_V(6); G8_BAR;
  for (;;) {
    const bool has_next = S.next(ui + 1, nxt);
    const char* nA = has_next ? (const char*)A + (size_t)nxt.pm * tstepA : cA; const char* nB = has_next ? (const char*)Bt + (size_t)nxt.pn * tstepB : cB;
    for (int t = 0; t < nt; t += 2) {
      const bool last = (t == nt - 2);
      const char* a1 = cA + G8_AK(t + 1);
      const char* a2 = last ? nA : cA + G8_AK(t + 2); const char* b2 = last ? nB : cB + (size_t)(t + 2) * kstep;
      const char* a3 = last ? nA + G8_AK(1) : cA + G8_AK(t + 3); const char* b3 = b2 + kstep;
      G8_LDB(B0, 0, 0); G8_SCHED; G8_LDA(At, 0, 0); G8_STAGE(G8_SA(1, 1), a1 + hstepA, voffA);
      G8_WAIT_L(8); G8_BAR; G8_WAIT_L(0); G8_MMA(0, 0, At, B0); G8_BAR; G8_SCHED;
      G8_LDB(B1, 0, 1); G8_STAGE(G8_SB(0, 0), b2, voffB);
      G8_BAR; G8_WAIT_L(0); G8_MMA(0, 1, At, B1); G8_BAR;
      G8_LDA(At, 0, 1); G8_STAGE(G8_SA(0, 0), a2, voffA);
      G8_BAR; G8_WAIT_L(0); G8_MMA(1, 0, At, B0); G8_BAR; G8_SCHED;
      G8_STAGE(G8_SB(0, 1), b2 + hstepB, voffB);
      G8_WAIT_V(6); G8_BAR; G8_MMA(1, 1, At, B1); G8_BAR;
      G8_LDB(B0, 1, 0); G8_SCHED; G8_LDA(At, 1, 0); G8_STAGE(G8_SA(0, 1), a2 + hstepA, voffA);
      G8_WAIT_L(8); G8_BAR; G8_WAIT_L(0); G8_MMA(0, 0, At, B0); G8_BAR; G8_SCHED;
      G8_LDB(B1, 1, 1); G8_STAGE(G8_SB(1, 0), b3, voffB);
      G8_BAR; G8_WAIT_L(0); G8_MMA(0, 1, At, B1); G8_BAR;
      G8_LDA(At, 1, 1); G8_STAGE(G8_SA(1, 0), a3, voffA);
      G8_BAR; G8_WAIT_L(0); G8_MMA(1, 0, At, B0); G8_BAR; G8_SCHED;
      G8_STAGE(G8_SB(1, 1), b3 + hstepB, voffB);
      G8_WAIT_V(6); G8_BAR; G8_MMA(1, 1, At, B1); G8_BAR;
    }
    E(acc, cur, wr, wc, fr, fq);
    if (!has_next) break;
#pragma unroll
    for (int a = 0; a < 2; ++a)
#pragma unroll
      for (int b = 0; b < 2; ++b)
#pragma unroll
        for (int m = 0; m < 4; ++m)
#pragma unroll
          for (int n = 0; n < 2; ++n) acc[a][b][m][n] = (f32x4){0.f, 0.f, 0.f, 0.f};
    cur = nxt; cA = nA; cB = nB; ++ui;
  }
  G8_WAIT_V(0);
  if (wr == 0) G8_BAR;
  G8_BAR;
#undef G8_AK
#undef G8_SA
#undef G8_SB
#undef G8_STAGE
#undef G8_LDA
#undef G8_LDB
#undef G8_MMA
#undef G8_WAIT_V
#undef G8_WAIT_L
#undef G8_BAR
#undef G8_SCHED
}
}

__device__ void xrow_unit(const Params& p, int unit) {
  const int tid_ = otid(); const int wid = tid_ >> 6, lane = tid_ & 63;
  f32x4 v[2][4];
#pragma unroll
  for (int r = 0; r < 2; ++r) {
    const int row = unit * 16 + r * 8 + wid;
    const float* src = (row < TP) ? (p.x_prompt + (size_t)row * 1024) : (p.x_sample + (size_t)(row - TP) * 1024);
#pragma unroll
    for (int i = 0; i < 4; ++i) v[r][i] = *(const f32x4*)(src + i * 256 + lane * 4);
  }
#pragma unroll
  for (int r = 0; r < 2; ++r) {
    const int row = unit * 16 + r * 8 + wid;
    float s = 0.f;
#pragma unroll
    for (int i = 0; i < 4; ++i) {
      const f32x4 x = v[r][i];
      s += x[0] * x[0] + x[1] * x[1] + x[2] * x[2] + x[3] * x[3];
      u32x2 o; o.x = pk2(x[0], x[1]); o.y = pk2(x[2], x[3]);
      *(u32x2*)(p.xb + (size_t)row * 1024 + i * 256 + lane * 4) = o;
    }
#pragma unroll
    for (int o = 32; o >= 1; o >>= 1) s += __shfl_xor(s, o);
    if (lane < 16) p.sumsq[(size_t)row * 16 + lane] = (lane == 0) ? s : 0.f;
  }
}

__device__ void transpose_unit(LAS unsigned char* lds, const float* src, int ldsrc, const float* scale, int nscale,
                               bf16_t* dst, int ldd, int kt, int ntile, int mode) {
  LAS float* tl = (LAS float*)lds;
  const int tid = otid();
  const int k0 = kt * 64, n0 = ntile * 64;
  f32x4 v[2];
#pragma unroll
  for (int i = 0; i < 2; ++i) {
    const int idx = tid + i * 512, kk = idx >> 4, n4 = (idx & 15) * 4;
    const int np = n0 + n4;
    int sc = np;
    if (mode == 0) { sc = (np < 3072) ? np : (np < 5120) ? (np + 16) : (np < 5136) ? (np - 5120 + 3072) : -1; }
    f32x4 x = (f32x4){0.f, 0.f, 0.f, 0.f};
    if (sc >= 0) {
      x = *(const f32x4*)(src + (size_t)(k0 + kk) * ldsrc + sc);
      if (scale && (k0 + kk) < nscale) x = x * scale[k0 + kk];
    }
    v[i] = x;
  }
#pragma unroll
  for (int i = 0; i < 2; ++i) {
    const int idx = tid + i * 512, kk = idx >> 4, n4 = (idx & 15) * 4;
#pragma unroll
    for (int j = 0; j < 4; ++j) tl[kk * 65 + n4 + j] = v[i][j];
  }
  __syncthreads();
  {
    const int nn = tid >> 3, kk0 = (tid & 7) * 8;
    float t[8];
#pragma unroll
    for (int j = 0; j < 8; ++j) t[j] = tl[(kk0 + j) * 65 + nn];
    *(u32x4*)(dst + (size_t)(n0 + nn) * ldd + k0 + kk0) = (u32x4){pk2(t[0], t[1]), pk2(t[2], t[3]), pk2(t[4], t[5]), pk2(t[6], t[7])};
  }
  __syncthreads();
}

__device__ __forceinline__ double exp_d(double x) {
  const double k = rint(x * 1.4426950408889634);
  const double r = fma(-k, 0.6931471805599453, x) - k * 2.3190468138462996e-17;
  double s = 1.0 / 6227020800.0;
  s = fma(s, r, 1.0 / 479001600.0); s = fma(s, r, 1.0 / 39916800.0); s = fma(s, r, 1.0 / 3628800.0);
  s = fma(s, r, 1.0 / 362880.0); s = fma(s, r, 1.0 / 40320.0); s = fma(s, r, 1.0 / 5040.0);
  s = fma(s, r, 1.0 / 720.0); s = fma(s, r, 1.0 / 120.0); s = fma(s, r, 1.0 / 24.0);
  s = fma(s, r, 1.0 / 6.0); s = fma(s, r, 0.5); s = fma(s, r, 1.0); s = fma(s, r, 1.0);
  return ldexp(s, (int)k);
}
__device__ __forceinline__ void sincos_d(double x, double& sn, double& cs) {
  const double k = rint(x * 0.6366197723675814);
  double r = fma(-k, 1.5707963267948966, x); r = fma(-k, 6.123233995736766e-17, r);
  const int q = ((int)k) & 3;
  const double r2 = r * r;
  double sp = 1.0 / 1307674368000.0;
  sp = fma(sp, r2, -1.0 / 6227020800.0); sp = fma(sp, r2, 1.0 / 39916800.0); sp = fma(sp, r2, -1.0 / 362880.0);
  sp = fma(sp, r2, 1.0 / 5040.0); sp = fma(sp, r2, -1.0 / 120.0); sp = fma(sp, r2, 1.0 / 6.0);
  sp = r - r * r2 * sp;
  double cp = 1.0 / 20922789888000.0;
  cp = fma(cp, r2, -1.0 / 87178291200.0); cp = fma(cp, r2, 1.0 / 479001600.0); cp = fma(cp, r2, -1.0 / 3628800.0);
  cp = fma(cp, r2, 1.0 / 40320.0); cp = fma(cp, r2, -1.0 / 720.0); cp = fma(cp, r2, 1.0 / 24.0); cp = fma(cp, r2, -0.5);
  cp = fma(cp, r2, 1.0);
  sn = (q == 0) ? sp : (q == 1) ? cp : (q == 2) ? -sp : -cp;
  cs = (q == 0) ? cp : (q == 1) ? -sp : (q == 2) ? -cp : sp;
}

__device__ void s5prep_unit(LAS unsigned char* lds, const Params& p, int l, int g) {
  LAS float* cf = (LAS float*)lds;
  const int tid = otid();
  const int lg = l * 64 + g;
  if (tid < 64) {
    const double dt = exp_d((double)p.log_dt[lg]);
    const double lr = (double)p.lam_re[lg * 64 + tid], li = (double)p.lam_im[lg * 64 + tid];
    const double e = exp_d(lr * dt);
    double sn, cs; sincos_d(li * dt, sn, cs);
    const double lbr = e * cs, lbi = e * sn;
    const double nr = lbr - 1.0, ni = lbi;
    const double den = lr * lr + li * li;
    const double cr = (nr * lr + ni * li) / den, ci = (ni * lr - nr * li) / den;
    p.lamb[(size_t)(lg * 64 + tid) * 2 + 0] = (float)lbr;
    p.lamb[(size_t)(lg * 64 + tid) * 2 + 1] = (float)lbi;
    cf[tid * 2 + 0] = (float)cr; cf[tid * 2 + 1] = (float)ci;
  }
  __syncthreads();
#pragma unroll
  for (int i = 0; i < 4; ++i) {
    const int idx = tid * 4 + i;
    {
      const int pp = idx >> 4, c = idx & 15, st = pp & 63;
      const float br = p.b_re[((size_t)lg * 64 + st) * 16 + c], bi = p.b_im[((size_t)lg * 64 + st) * 16 + c];
      const float cr = cf[st * 2], ci = cf[st * 2 + 1];
      const float v = (pp < 64) ? (cr * br - ci * bi) : (cr * bi + ci * br);
      p.BbT[(size_t)lg * 2048 + idx] = (bf16_t)(pk2(v, v) & 0xffffu);
    }
    {
      const int c = idx >> 7, pp = idx & 127, st = pp & 63;
      const float v = (pp < 64) ? p.c_re[((size_t)lg * 16 + c) * 64 + st] : -p.c_im[((size_t)lg * 16 + c) * 64 + st];
      p.CmT[(size_t)lg * 2048 + idx] = (bf16_t)(pk2(v, v) & 0xffffu);
    }
  }
  __syncthreads();
}

__device__ void phase_prep(LAS unsigned char* lds, const Params& p) {
  constexpr int U_X = 2080, U_WIN = 5376, U_WGLU = 1024, U_WOUT = 2048, U_S5 = 256;
  constexpr int TOTAL = U_X + U_WIN + U_WGLU + U_WOUT + U_S5;
  for (int u = blockIdx.x; u < TOTAL; u += gridDim.x) {
    int idx = u;
    if (idx < U_X) { xrow_unit(p, idx); continue; }
    idx -= U_X;
    if (idx < U_WIN) {
      const int l = idx / 1344, r = idx % 1344, ntile = r / 16, kt = r % 16;
      transpose_unit(lds, p.w_in + (size_t)l * 1024 * 5136, 5136, p.norm_g + l * 1024, 1024,
                     p.WinT + (size_t)l * 5376 * 1024, 1024, kt, ntile, 0);
      continue;
    }
    idx -= U_WIN;
    if (idx < U_WGLU) {
      const int l = idx / 256, r = idx % 256, ntile = r / 16, kt = r % 16;
      transpose_unit(lds, p.w_glu + (size_t)l * 1024 * 1024, 1024, nullptr, 0, p.WgluT + (size_t)l * 1024 * 1024, 1024, kt, ntile, 1);
      continue;
    }
    idx -= U_WGLU;
    if (idx < U_WOUT) {
      const int l = idx / 512, r = idx % 512, ntile = r / 32, kt = r % 32;
      transpose_unit(lds, p.w_out + (size_t)l * 2048 * 1024, 1024, p.ssd_norm_g + l * 1024, 1024,
                     p.WoutT + (size_t)l * 1024 * 2048, 2048, kt, ntile, 2);
      continue;
    }
    idx -= U_WOUT;
    s5prep_unit(lds, p, idx / 64, idx % 64);
  }
}

constexpr int CM_OFF = 0, BM_OFF = 17408, BMT_OFF = 34816, XDT_OFF = 53248, XW_OFF = 62464, MM_OFF = 71680,
              HB_OFF = 80896, XS_OFF = 98304, ACS_OFF = 107520, DTV_OFF = 115712, SSQ_OFF = 123904, CW_OFF = 124416;

__device__ __forceinline__ bf16x8 ldfrag(LAS unsigned char* lds, int off, int row, int stride, int col) {
  return *(const LAS bf16x8*)(lds + off + (row * stride + col) * 2);
}

template <int NCH>
__device__ __forceinline__ void conv_load_rows(unsigned (&rows)[7][NCH / 2], const bf16_t* proj, const float* stc, int tok0, int c, int s0, int ccol) {
#pragma unroll
  for (int i = 0; i < 7; ++i) {
    const int pos = c * 64 + s0 - 3 + i;
    if (pos >= 0) {
      const bf16_t* q = proj + (size_t)(tok0 + pos) * LDP + C_XBC + ccol;
      if (NCH == 8) { const u32x4 v = *(const u32x4*)q; rows[i][0] = v[0]; rows[i][1] = v[1]; rows[i][NCH / 2 - 2] = v[2]; rows[i][NCH / 2 - 1] = v[3]; }
      else rows[i][0] = *(const unsigned*)q;
    } else if (stc) {
      const float* sp = stc + (size_t)(3 + pos) * 2048 + ccol;
#pragma unroll
      for (int k = 0; k < NCH / 2; ++k) rows[i][k] = pk2(sp[2 * k], sp[2 * k + 1]);
    } else {
#pragma unroll
      for (int k = 0; k < NCH / 2; ++k) rows[i][k] = 0u;
    }
  }
}
template <int NCH>
__device__ __forceinline__ void conv_load_rows_fast(unsigned (&rows)[7][NCH / 2], const bf16_t* proj, int tok0, int c, int s0, int ccol) {
  const bf16_t* q0 = proj + (size_t)(tok0 + c * 64 + s0 - 3) * LDP + C_XBC + ccol;
#pragma unroll
  for (int i = 0; i < 7; ++i) {
    const bf16_t* q = q0 + (size_t)i * LDP;
    if (NCH == 8) { const u32x4 v = *(const u32x4*)q; rows[i][0] = v[0]; rows[i][1] = v[1]; rows[i][NCH / 2 - 2] = v[2]; rows[i][NCH / 2 - 1] = v[3]; }
    else rows[i][0] = *(const unsigned*)q;
  }
}
template <int NCH>
__device__ __forceinline__ void conv_store_row(LAS unsigned char* addr, const float* o) {
  if (NCH == 8) *(LAS u32x4*)addr = (u32x4){pk2(o[0], o[1]), pk2(o[2], o[3]), pk2(o[NCH - 4], o[NCH - 3]), pk2(o[NCH - 2], o[NCH - 1])};
  else *(LAS unsigned*)addr = pk2(o[0], o[1]);
}
template <int NCH>
__device__ __forceinline__ void conv_unit(LAS unsigned char* lds, const unsigned (&rows)[7][NCH / 2], const LAS float* wl,
                                          int oct, int chq, int s0, const LAS float* acs, const LAS float* dtv) {
  float o[4][NCH];
  float w[4][NCH], bs[NCH];
#pragma unroll
  for (int e = 0; e < NCH; ++e) { bs[e] = wl[32 + e];
#pragma unroll
    for (int k = 0; k < 4; ++k) w[k][e] = wl[k * 8 + e]; }
#pragma unroll
  for (int e = 0; e < NCH; ++e) {
    float xv[7];
#pragma unroll
    for (int i = 0; i < 7; ++i) xv[i] = (e & 1) ? hi_f(rows[i][e >> 1]) : lo_f(rows[i][e >> 1]);
#pragma unroll
    for (int j = 0; j < 4; ++j) o[j][e] = siluf(bs[e] + w[0][e] * xv[j] + w[1][e] * xv[j + 1] + w[2][e] * xv[j + 2] + w[3][e] * xv[j + 3]);
  }
  if (oct < 8) {
    float dts[4], wsc[4];
    const float aend = acs[63];
#pragma unroll
    for (int j = 0; j < 4; ++j) { dts[j] = dtv[s0 + j]; wsc[j] = dts[j] * __expf(aend - acs[s0 + j]); }
    const int p0 = oct * 8 + chq;
#pragma unroll
    for (int j = 0; j < 4; ++j) conv_store_row<NCH>(lds + XS_OFF + ((s0 + j) * 72 + p0) * 2, o[j]);
#pragma unroll
    for (int e = 0; e < NCH; ++e) {
      *(LAS u32x2*)(lds + XDT_OFF + ((p0 + e) * 72 + s0) * 2) = (u32x2){pk2(o[0][e] * dts[0], o[1][e] * dts[1]), pk2(o[2][e] * dts[2], o[3][e] * dts[3])};
      *(LAS u32x2*)(lds + XW_OFF + ((p0 + e) * 72 + s0) * 2) = (u32x2){pk2(o[0][e] * wsc[0], o[1][e] * wsc[1]), pk2(o[2][e] * wsc[2], o[3][e] * wsc[3])};
    }
  } else if (oct < 24) {
    const int n0 = (oct - 8) * 8 + chq;
#pragma unroll
    for (int j = 0; j < 4; ++j) conv_store_row<NCH>(lds + BM_OFF + ((s0 + j) * 136 + n0) * 2, o[j]);
#pragma unroll
    for (int e = 0; e < NCH; ++e) *(LAS u32x2*)(lds + BMT_OFF + ((n0 + e) * 72 + s0) * 2) = (u32x2){pk2(o[0][e], o[1][e]), pk2(o[2][e], o[3][e])};
  } else {
    const int n0 = (oct - 24) * 8 + chq;
#pragma unroll
    for (int j = 0; j < 4; ++j) conv_store_row<NCH>(lds + CM_OFF + ((s0 + j) * 136 + n0) * 2, o[j]);
  }
}

__device__ void ssd_item(LAS unsigned char* lds, const Params& p, int l, int b, int h, bool smp) {
  const int tid = otid(), wid = tid >> 6, lane = tid & 63, fr = lane & 15, fq = lane >> 4;
  const int g = h >> 2;
  const int tok0 = smp ? (TP + b * 64) : (b * 2048);
  const int nchunk = smp ? 1 : 32;
  const int NB = smp ? 8 : 16;
  bf16_t* proj = p.proj;
  LAS float* acs_all = (LAS float*)(lds + ACS_OFF);
  LAS float* dtv_all = (LAS float*)(lds + DTV_OFF);
  LAS float* ssq = (LAS float*)(lds + SSQ_OFF);
  const float dtb = p.dt_bias[l * 16 + h];
  const float Aneg = -__expf(p.a_log[l * 16 + h]);
  const float Dh = p.d_ssd[l * 16 + h];

  f32x4 hacc[4];
#pragma unroll
  for (int pt = 0; pt < 4; ++pt) {
    if (smp) hacc[pt] = *(const f32x4*)(p.st_ssd + ((((size_t)l * 8 + b) * 16 + h) * 64 + pt * 16 + fr) * 128 + wid * 16 + fq * 4);
    else hacc[pt] = (f32x4){0.f, 0.f, 0.f, 0.f};
  }

  const float* stc = smp ? (p.st_conv + ((size_t)l * 8 + b) * 3 * 2048) : nullptr;
  int octA, s0A;
  if (tid < 128) { octA = tid & 7; s0A = (tid >> 3) * 4; }
  else if (tid < 384) { const int i = tid - 128; octA = 8 + (i & 15); s0A = (i >> 4) * 4; }
  else { const int i = tid - 384; octA = 24 + (i & 15); s0A = (i >> 4) * 4; }
  const int jB = tid >> 2, octB = 24 + (jB & 15), s0B = (8 + (jB >> 4)) * 4, chqB = (tid & 3) * 2;
  const int cchA = (octA < 8) ? (h * 64 + octA * 8) : (octA < 24) ? (1024 + g * 128 + (octA - 8) * 8) : (1536 + g * 128 + (octA - 24) * 8);
  const int cchB = ((octB < 8) ? (h * 64 + octB * 8) : (octB < 24) ? (1024 + g * 128 + (octB - 8) * 8) : (1536 + g * 128 + (octB - 24) * 8)) + chqB;
  LAS float* cwl = (LAS float*)(lds + CW_OFF);
  {
    const float* cw = p.conv_w + (size_t)l * 4 * 2048;
    const float* cb = p.conv_b + (size_t)l * 2048;
    for (int idx = tid; idx < 1600; idx += 512) {
      const int oc = idx / 40, r = idx % 40, k = r >> 3, e = r & 7;
      const int cc = ((oc < 8) ? (h * 64 + oc * 8) : (oc < 24) ? (1024 + g * 128 + (oc - 8) * 8) : (1536 + g * 128 + (oc - 24) * 8)) + e;
      cwl[idx] = (k < 4) ? cw[k * 2048 + cc] : cb[cc];
    }
  }
  unsigned rowsA[7][4], rowsB[7][1];
  conv_load_rows<8>(rowsA, proj, stc, tok0, 0, s0A, cchA);
  conv_load_rows<2>(rowsB, proj, stc, tok0, 0, s0B, cchB);
  for (int c = wid; c < nchunk; c += 8) {
    const float dtr = bf2f(proj[(size_t)(tok0 + c * 64 + lane) * LDP + C_DT + h]);
    const float xx = dtr + dtb;
    const float dt = xx > 20.f ? xx : log1pf(__expf(xx));
    float cs = dt * Aneg;
#pragma unroll
    for (int o = 1; o < 64; o <<= 1) { const float v = __shfl_up(cs, o); if (lane >= o) cs += v; }
    acs_all[c * 64 + lane] = cs; dtv_all[c * 64 + lane] = dt;
  }
  LDS_BARRIER();
  for (int c = 0; c < nchunk; ++c) {
    const int ctok = tok0 + c * 64;
    const LAS float* acs = acs_all + c * 64;
    const LAS float* dtv = dtv_all + c * 64;
    u32x2 z4v[2];
    {
      const int lt_ = wid >> 1, ptb_ = (wid & 1) * 2;
#pragma unroll
      for (int q = 0; q < 2; ++q) z4v[q] = *(const u32x2*)(proj + (size_t)(ctok + lt_ * 16 + fr) * LDP + C_ZA + h * 64 + (ptb_ + q) * 16 + fq * 4);
    }
    conv_unit<8>(lds, rowsA, cwl + octA * 40, octA, 0, s0A, acs, dtv);
    conv_unit<2>(lds, rowsB, cwl + octB * 40 + chqB, octB, chqB, s0B, acs, dtv);
    if (c + 1 < nchunk) {
      conv_load_rows_fast<8>(rowsA, proj, tok0, c + 1, s0A, cchA);
      conv_load_rows_fast<2>(rowsB, proj, tok0, c + 1, s0B, cchB);
    }
#pragma unroll
    for (int pt = 0; pt < 4; ++pt)
      *(LAS u32x2*)(lds + HB_OFF + ((pt * 16 + fr) * 136 + wid * 16 + fq * 4) * 2) =
          (u32x2){pk2(hacc[pt][0], hacc[pt][1]), pk2(hacc[pt][2], hacc[pt][3])};
    LDS_BARRIER();
    const int lt = wid >> 1, ptb = (wid & 1) * 2;
    {
      const int st = wid >> 1, ltb = (wid & 1) * 2;
      bf16x8 bfr[4];
#pragma unroll
      for (int ks = 0; ks < 4; ++ks) bfr[ks] = ldfrag(lds, BM_OFF, st * 16 + fr, 136, ks * 32 + fq * 8);
#pragma unroll
      for (int q = 0; q < 2; ++q) {
        const int ltq = ltb + q;
        f32x4 a = (f32x4){0.f, 0.f, 0.f, 0.f};
#pragma unroll
        for (int ks = 0; ks < 4; ++ks) a = mfma16(bfr[ks], ldfrag(lds, CM_OFF, ltq * 16 + fr, 136, ks * 32 + fq * 8), a);
        const int l_ = ltq * 16 + fr;
        const float al = acs[l_];
        float mv[4];
#pragma unroll
        for (int r = 0; r < 4; ++r) { const int s_ = st * 16 + fq * 4 + r; const float ex = __expf(al - acs[s_]); mv[r] = (s_ <= l_) ? a[r] * ex : 0.f; }
        *(LAS u32x2*)(lds + MM_OFF + (l_ * 72 + st * 16 + fq * 4) * 2) = (u32x2){pk2(mv[0], mv[1]), pk2(mv[2], mv[3])};
      }
    }
    f32x4 accI[2];
    accI[0] = (f32x4){0.f, 0.f, 0.f, 0.f}; accI[1] = accI[0];
#pragma unroll
    for (int ks = 0; ks < 4; ++ks) {
      const bf16x8 cfr = ldfrag(lds, CM_OFF, lt * 16 + fr, 136, ks * 32 + fq * 8);
#pragma unroll
      for (int q = 0; q < 2; ++q) accI[q] = mfma16(ldfrag(lds, HB_OFF, (ptb + q) * 16 + fr, 136, ks * 32 + fq * 8), cfr, accI[q]);
    }
    {
      const float dec = __expf(acs[63]);
      bf16x8 bt[2];
#pragma unroll
      for (int ks = 0; ks < 2; ++ks) bt[ks] = ldfrag(lds, BMT_OFF, wid * 16 + fr, 72, ks * 32 + fq * 8);
#pragma unroll
      for (int pt = 0; pt < 4; ++pt) {
        hacc[pt] = hacc[pt] * dec;
#pragma unroll
        for (int ks = 0; ks < 2; ++ks) hacc[pt] = mfma16(bt[ks], ldfrag(lds, XW_OFF, pt * 16 + fr, 72, ks * 32 + fq * 8), hacc[pt]);
      }
    }
    LDS_BARRIER();
    {
      f32x4 accY[2];
      accY[0] = (f32x4){0.f, 0.f, 0.f, 0.f}; accY[1] = accY[0];
#pragma unroll
      for (int ks = 0; ks < 2; ++ks) {
        const bf16x8 mf = ldfrag(lds, MM_OFF, lt * 16 + fr, 72, ks * 32 + fq * 8);
#pragma unroll
        for (int q = 0; q < 2; ++q) accY[q] = mfma16(ldfrag(lds, XDT_OFF, (ptb + q) * 16 + fr, 72, ks * 32 + fq * 8), mf, accY[q]);
      }
      const int l_ = lt * 16 + fr;
      const float el = __expf(acs[l_]);
      float sq = 0.f;
#pragma unroll
      for (int q = 0; q < 2; ++q) {
        const int p0 = (ptb + q) * 16 + fq * 4;
        const u32x2 xs4 = *(const LAS u32x2*)(lds + XS_OFF + (l_ * 72 + p0) * 2);
        bf16_t* zp = proj + (size_t)(ctok + l_) * LDP + C_ZA + h * 64 + p0;
        const u32x2 z4 = z4v[q];
        const float y0 = (accY[q][0] + el * accI[q][0] + Dh * lo_f(xs4.x)) * siluf(lo_f(z4.x));
        const float y1 = (accY[q][1] + el * accI[q][1] + Dh * hi_f(xs4.x)) * siluf(hi_f(z4.x));
        const float y2 = (accY[q][2] + el * accI[q][2] + Dh * lo_f(xs4.y)) * siluf(lo_f(z4.y));
        const float y3 = (accY[q][3] + el * accI[q][3] + Dh * hi_f(xs4.y)) * siluf(hi_f(z4.y));
        sq += y0 * y0 + y1 * y1 + y2 * y2 + y3 * y3;
        *(u32x2*)zp = (u32x2){pk2(y0, y1), pk2(y2, y3)};
      }
      sq += __shfl_xor(sq, 16); sq += __shfl_xor(sq, 32);
      if (fq == 0) ssq[(wid & 1) * 64 + l_] = sq;
    }
    LDS_BARRIER();
    if (tid < 64) p.ssqa[(size_t)(ctok + tid) * 16 + h] = ssq[tid] + ssq[64 + tid];
  }
  {
    float* so = p.out + (smp ? O_SSDS : O_SSDP);
#pragma unroll
    for (int pt = 0; pt < 4; ++pt)
      *(f32x4*)(so + ((((size_t)l * NB + b) * 16 + h) * 64 + pt * 16 + fr) * 128 + wid * 16 + fq * 4) = hacc[pt];
    float* co = p.out + (smp ? O_CONVS : O_CONVP);
    const int L = smp ? 64 : 2048;
    for (int i = tid; i < 3 * 320; i += 512) {
      const int r = i / 320, cc = i % 320;
      if (cc >= 64 && (h & 3)) continue;
      const int ch = (cc < 64) ? (h * 64 + cc) : (cc < 192) ? (1024 + g * 128 + (cc - 64)) : (1536 + g * 128 + (cc - 192));
      co[(((size_t)l * NB + b) * 3 + r) * 2048 + ch] = bf2f(proj[(size_t)(tok0 + L - 3 + r) * LDP + C_XBC + ch]);
    }
  }
  __syncthreads();
}

__device__ __forceinline__ float fma_asm(float a, float b, float c) { float d; asm volatile("v_fma_f32 %0, %1, %2, %3" : "=v"(d) : "v"(a), "v"(b), "v"(c)); return d; }
__device__ void s5_seq(LAS unsigned char* lds, const Params& p, int l, int b, int g, bool smp) {
  const int tid_ = otid(); const int wid = tid_ >> 6, lane = tid_ & 63, fr = lane & 15, fq = lane >> 4;
  const int pi = wid & 3, role = wid >> 2;
  LAS float* hbuf = (LAS float*)(lds + pi * 33792);
  const int tok0 = smp ? (TP + b * 64) : (b * 2048);
  const int nblk = smp ? 2 : 64;
  const int NB = smp ? 8 : 16;
  const int lg = l * 64 + g;
  const bf16_t* ubase = p.proj + C_U + g * 16;
  if (role == 0) {
    bf16x8 Bfrag[4];
#pragma unroll
    for (int nt = 0; nt < 4; ++nt) Bfrag[nt] = *(const bf16x8*)(p.BbT + ((size_t)lg * 128 + nt * 32 + (lane & 31)) * 16 + 8 * (lane >> 5));
    const float lr = p.lamb[(size_t)(lg * 64 + lane) * 2], li = p.lamb[(size_t)(lg * 64 + lane) * 2 + 1];
    const float nli = -li;
    float hr = 0.f, hi = 0.f;
    if (smp) { hr = p.st_s5re[(((size_t)l * 8 + b) * 64 + g) * 64 + lane]; hi = p.st_s5im[(((size_t)l * 8 + b) * 64 + g) * 64 + lane]; }
    bf16x8 a_next = *(const bf16x8*)(ubase + (size_t)(tok0 + (lane & 31)) * LDP + 8 * (lane >> 5));
    for (int blk = 0; blk <= nblk; ++blk) {
      if (blk < nblk) {
        LAS float* buf = hbuf + (blk & 1) * 4224;
        const bf16x8 a = a_next;
        if (blk + 1 < nblk) a_next = *(const bf16x8*)(ubase + (size_t)(tok0 + (blk + 1) * 32 + (lane & 31)) * LDP + 8 * (lane >> 5));
        float bre[32], bim[32];
        {
          f32x16 d[4];
#pragma unroll
          for (int nt = 0; nt < 4; ++nt) {
            f32x16 z = {0.f, 0.f, 0.f, 0.f, 0.f, 0.f, 0.f, 0.f, 0.f, 0.f, 0.f, 0.f, 0.f, 0.f, 0.f, 0.f};
            d[nt] = __builtin_amdgcn_mfma_f32_32x32x16_bf16(a, Bfrag[nt], z, 0, 0, 0);
          }
#pragma unroll
          for (int r = 0; r < 16; ++r) {
            const int tA = (r & 3) + 8 * (r >> 2);
            const auto sr = __builtin_amdgcn_permlane32_swap(__float_as_uint(d[0][r]), __float_as_uint(d[1][r]), false, false);
            bre[tA] = __uint_as_float(sr[0]); bre[tA + 4] = __uint_as_float(sr[1]);
            const auto si = __builtin_amdgcn_permlane32_swap(__float_as_uint(d[2][r]), __float_as_uint(d[3][r]), false, false);
            bim[tA] = __uint_as_float(si[0]); bim[tA + 4] = __uint_as_float(si[1]);
          }
        }
#pragma unroll
        for (int t = 0; t < 32; ++t) {
          float nr = fma_asm(lr, hr, bre[t]); nr = fma_asm(nli, hi, nr);
          float ni = fma_asm(lr, hi, bim[t]); ni = fma_asm(li, hr, ni);
          hr = nr; hi = ni;
          buf[t * 132 + lane] = hr; buf[t * 132 + 64 + lane] = hi;
        }
      }
      LDS_BARRIER();
    }
    p.out[(smp ? O_S5RES : O_S5REP) + (((size_t)l * NB + b) * 64 + g) * 64 + lane] = hr;
    p.out[(smp ? O_S5IMS : O_S5IMP) + (((size_t)l * NB + b) * 64 + g) * 64 + lane] = hi;
  } else {
    bf16x8 Cfrag[4];
#pragma unroll
    for (int ks = 0; ks < 4; ++ks) Cfrag[ks] = *(const bf16x8*)(p.CmT + ((size_t)lg * 16 + fr) * 128 + ks * 32 + fq * 8);
    const f32x4 d4 = *(const f32x4*)(p.d_s5 + l * 1024 + g * 16 + fq * 4);
    for (int blk = 0; blk <= nblk; ++blk) {
      if (blk >= 1) {
        const int pb = blk - 1;
        const LAS float* buf = hbuf + (pb & 1) * 4224;
        u32x2 u4v[2];
#pragma unroll
        for (int mt = 0; mt < 2; ++mt) u4v[mt] = *(const u32x2*)(ubase + (size_t)(tok0 + pb * 32 + mt * 16 + fr) * LDP + fq * 4);
#pragma unroll
        for (int mt = 0; mt < 2; ++mt) {
          f32x4 acc = (f32x4){0.f, 0.f, 0.f, 0.f};
#pragma unroll
          for (int ks = 0; ks < 4; ++ks) {
            const LAS float* hp = buf + (mt * 16 + fr) * 132 + ks * 32 + fq * 8;
            const f32x4 h0 = *(const LAS f32x4*)hp, h1 = *(const LAS f32x4*)(hp + 4);
            u32x4 hw = (u32x4){pk2(h0[0], h0[1]), pk2(h0[2], h0[3]), pk2(h1[0], h1[1]), pk2(h1[2], h1[3])};
            bf16x8 hf = __builtin_bit_cast(bf16x8, hw);
            acc = mfma16(Cfrag[ks], hf, acc);
          }
          const size_t trow = (size_t)(tok0 + pb * 32 + mt * 16 + fr);
          const u32x2 u4 = u4v[mt];
          const float y0 = gelu_tanh(acc[0] + d4[0] * lo_f(u4.x));
          const float y1 = gelu_tanh(acc[1] + d4[1] * hi_f(u4.x));
          const float y2 = gelu_tanh(acc[2] + d4[2] * lo_f(u4.y));
          const float y3 = gelu_tanh(acc[3] + d4[3] * hi_f(u4.y));
          *(u32x2*)(p.xb + trow * 1024 + g * 16 + fq * 4) = (u32x2){pk2(y0, y1), pk2(y2, y3)};
        }
      }
      LDS_BARRIER();
    }
  }
}

__device__ void phase_mixer(LAS unsigned char* lds, const Params& p, int l) {
  const int wid = otid() >> 6;
  for (int u = blockIdx.x; u < 768; u += gridDim.x) {
    if (u < 256) {
      const int x = u & 7, j = u >> 3, G = x * 8 + (j >> 2);
      ssd_item(lds, p, l, G >> 2, (G & 3) * 4 + (j & 3), false);
    }
    else if (u < 512) { const int seq = (u - 256) * 4 + (wid & 3); s5_seq(lds, p, l, seq >> 6, seq & 63, false); }
    else if (u < 640) {
      const int v = u - 512, x = v & 7, j = v >> 3, G = x * 4 + (j >> 2);
      ssd_item(lds, p, l, G >> 2, (G & 3) * 4 + (j & 3), true);
    }
    else { const int seq = (u - 640) * 4 + (wid & 3); s5_seq(lds, p, l, seq >> 6, seq & 63, true); }
    __syncthreads();
  }
}

__device__ void norm_unit(const Params& p, int nu) {
  const int tid = otid();
  const int tok = nu * 32 + (tid >> 4), hh = tid & 15, gg = hh >> 2;
  const f32x4 s4 = *(const f32x4*)(p.ssqa + (size_t)tok * 16 + gg * 4);
  const float rs = rsqrtf((s4[0] + s4[1] + s4[2] + s4[3]) * (1.f / 256.f) + 1e-6f);
  bf16_t* q = p.proj + (size_t)tok * LDP + C_ZA + hh * 64;
#pragma unroll
  for (int i = 0; i < 8; ++i) {
    u32x4 v = *(u32x4*)(q + i * 8);
#pragma unroll
    for (int k = 0; k < 4; ++k) v[k] = pk2(lo_f(v[k]) * rs, hi_f(v[k]) * rs);
    *(u32x4*)(q + i * 8) = v;
  }
}

__device__ void final_unit(const Params& p, int unit) {
  const int tid_ = otid(); const int wid = tid_ >> 6, lane = tid_ & 63;
  const int row = unit * 8 + wid;
  const f32x4* sp = (const f32x4*)(p.sumsq + ((size_t)4 * T_TOK + row) * 16);
  const f32x4 s0 = sp[0], s1 = sp[1], s2 = sp[2], s3 = sp[3];
  const float ss = ((s0[0] + s0[1]) + (s0[2] + s0[3])) + ((s1[0] + s1[1]) + (s1[2] + s1[3])) +
                   ((s2[0] + s2[1]) + (s2[2] + s2[3])) + ((s3[0] + s3[1]) + (s3[2] + s3[3]));
  const float rs = rsqrtf(ss * (1.f / 1024.f) + 1e-6f);
  float* xr = p.out + (size_t)row * 1024;
#pragma unroll
  for (int i = 0; i < 4; ++i) {
    const int c = i * 256 + lane * 4;
    const f32x4 v = *(const f32x4*)(xr + c);
    const f32x4 gv = *(const f32x4*)(p.final_g + c);
    *(f32x4*)(xr + c) = v * rs * gv;
  }
}

__device__ __forceinline__ void grid_barrier(cg::grid_group& grid, unsigned* ctr, unsigned target) {
  asm volatile("s_waitcnt vmcnt(0) lgkmcnt(0)" ::: "memory");
  __syncthreads();
  if (target == gridDim.x) grid.sync();
  if (threadIdx.x == 0) {
    __builtin_amdgcn_fence(__ATOMIC_RELEASE, "agent");
    asm volatile("s_waitcnt vmcnt(0)" ::: "memory");
    __hip_atomic_fetch_add(ctr, 1u, __ATOMIC_RELAXED, __HIP_MEMORY_SCOPE_AGENT);
    while (__hip_atomic_load(ctr, __ATOMIC_RELAXED, __HIP_MEMORY_SCOPE_AGENT) < target) __builtin_amdgcn_s_sleep(1);
    __builtin_amdgcn_fence(__ATOMIC_ACQUIRE, "agent");
    asm volatile("s_waitcnt vmcnt(0)" ::: "memory");
  }
  __syncthreads();
}

__global__ void __launch_bounds__(NTHREADS) mega(Params p) {
  __shared__ __attribute__((aligned(1024))) unsigned char shm[LDS_BYTES];
  LAS unsigned char* lds = (LAS unsigned char*)shm;
  cg::grid_group grid = cg::this_grid();
  unsigned nbar = 0;
  phase_prep(lds, p);
  grid_barrier(grid, p.bar, (++nbar) * gridDim.x);
  for (int ph = 1; ph < p.phase_end; ++ph) {
    if (ph == 17) {
      for (int u = blockIdx.x; u < 4160; u += gridDim.x) final_unit(p, u);
    } else {
      const int l = (ph - 1) >> 2, sub = (ph - 1) & 3;
      if (sub == 0) {
        g8::EpiIn8 e{p.proj, p.sumsq + (size_t)l * T_TOK * 16};
        g8::Order S{NMT * 21, 21, 0, 0};
        g8::gemm_phase8(lds, p.xb, 1024, 1 << 30, 0, p.WinT + (size_t)l * 5376 * 1024, 1024, 1024, S, e);
      } else if (sub == 1) {
        phase_mixer(lds, p, l);
      } else if (sub == 2) {
        g8::EpiGlu8 e{p.proj, p.b_glu + l * 1024, p.xb};
        g8::Order S{NMT * 4, 4, 0, 0};
        g8::gemm_phase8(lds, p.xb, 1024, 1 << 30, 0, p.WgluT + (size_t)l * 1024 * 1024, 1024, 1024, S, e);
        for (int u = gridDim.x - 1 - blockIdx.x; u < 1040; u += gridDim.x) norm_unit(p, u);
      } else {
        g8::EpiOut8 e{l == 0 ? p.x_prompt : p.out, l == 0 ? p.x_sample : (p.out + (size_t)TP * 1024), p.out,
                      l == 3 ? (bf16_t*)nullptr : p.xb, p.sumsq + (size_t)(l + 1) * T_TOK * 16};
        g8::Order S{512, 4, 0, 0};
        g8::gemm_phase8(lds, p.proj, LDP, 16, 3072, p.WoutT + (size_t)l * 1024 * 2048, 2048, 2048, S, e);
#pragma unroll 1
        for (int q = 0; q < 4; ++q) {
          const int kt0 = q * 8;
          g8::Order Sq{0, 4, 1, q};
          g8::EpiPart8 ep{p.part + (size_t)q * 512 * 1024};
          g8::gemm_phase8(lds, p.proj + kt0 * 64 + (kt0 >= 16 ? 3072 : 0), LDP, 1 << 30, 0, p.WoutT + (size_t)l * 1024 * 2048 + kt0 * 64, 2048, 512, Sq, ep);
        }
        grid_barrier(grid, p.bar, (++nbar) * gridDim.x);
        {
          const int tid_ = otid(); const int wid = tid_ >> 6, lane = tid_ & 63;
          for (int r = blockIdx.x * 8 + wid; r < 512; r += gridDim.x * 8) {
            const int row = TP + r;
            const float* xr = (l == 0) ? (p.x_sample + (size_t)r * 1024) : (p.out + (size_t)row * 1024);
            float ssum = 0.f;
#pragma unroll
            for (int i = 0; i < 4; ++i) {
              const int c = i * 256 + lane * 4;
              f32x4 v = *(const f32x4*)(xr + c);
#pragma unroll
              for (int q = 0; q < 4; ++q) v += *(const f32x4*)(p.part + ((size_t)q * 512 + r) * 1024 + c);
              *(f32x4*)(p.out + (size_t)row * 1024 + c) = v;
              if (l < 3) { u32x2 o; o.x = pk2(v[0], v[1]); o.y = pk2(v[2], v[3]); *(u32x2*)(p.xb + (size_t)row * 1024 + c) = o; }
              ssum += v[0] * v[0] + v[1] * v[1] + v[2] * v[2] + v[3] * v[3];
            }
#pragma unroll
            for (int o = 32; o >= 1; o >>= 1) ssum += __shfl_xor(ssum, o);
            if (lane < 16) p.sumsq[((size_t)(l + 1) * T_TOK + row) * 16 + lane] = (lane == 0) ? ssum : 0.f;
          }
        }
      }
    }
    if (ph + 1 < p.phase_end) grid_barrier(grid, p.bar, (++nbar) * gridDim.x);
  }
}

extern "C" void kernel_launch(void* const* d_in, const int* in_sizes, int n_in, void* d_out, int out_size, void* d_ws, size_t ws_size,
                              hipStream_t stream) {
  static int grid_blocks = 0;
  if (!grid_blocks) {
    int dev = 0, cus = 0, per_cu = 0;
    hipGetDevice(&dev);
    hipDeviceGetAttribute(&cus, hipDeviceAttributeMultiprocessorCount, dev);
    hipOccupancyMaxActiveBlocksPerMultiprocessor(&per_cu, mega, NTHREADS, 0);
    if (per_cu < 1) per_cu = 1;
    if (per_cu > 1) per_cu = 1;
    grid_blocks = cus * per_cu;
  }
  Params p{};
  const float* const* in = (const float* const*)d_in;
  p.x_prompt = in[0]; p.x_sample = in[1]; p.st_conv = in[2]; p.st_ssd = in[3]; p.st_s5re = in[4]; p.st_s5im = in[5];
  p.norm_g = in[6]; p.w_in = in[7]; p.conv_w = in[8]; p.conv_b = in[9]; p.dt_bias = in[10]; p.a_log = in[11]; p.d_ssd = in[12];
  p.ssd_norm_g = in[13]; p.lam_re = in[14]; p.lam_im = in[15]; p.log_dt = in[16]; p.b_re = in[17]; p.b_im = in[18];
  p.c_re = in[19]; p.c_im = in[20]; p.d_s5 = in[21]; p.w_glu = in[22]; p.b_glu = in[23]; p.w_out = in[24]; p.final_g = in[25];
  p.out = (float*)d_out;
  unsigned char* ws = (unsigned char*)d_ws;
  size_t off = 0;
  auto take = [&](size_t bytes) { unsigned char* r = ws + off; off += (bytes + 1023) & ~(size_t)1023; return r; };
  p.xb = (bf16_t*)take((size_t)T_TOK * 1024 * 2);
  p.proj = (bf16_t*)take((size_t)T_TOK * LDP * 2);
  p.WinT = (bf16_t*)take((size_t)4 * 5376 * 1024 * 2);
  p.WgluT = (bf16_t*)take((size_t)4 * 1024 * 1024 * 2);
  p.WoutT = (bf16_t*)take((size_t)4 * 1024 * 2048 * 2);
  p.BbT = (bf16_t*)take((size_t)256 * 2048 * 2);
  p.CmT = (bf16_t*)take((size_t)256 * 2048 * 2);
  p.sumsq = (float*)take((size_t)5 * T_TOK * 16 * 4);
  p.ssqa = (float*)take((size_t)T_TOK * 16 * 4);
  p.lamb = (float*)take((size_t)256 * 64 * 2 * 4);
  p.part = (float*)take((size_t)4 * 512 * 1024 * 4);
  p.bar = (unsigned*)take(1024);
  hipMemsetAsync(p.bar, 0, 1024, stream);
  if (off > ws_size) { fprintf(stderr, "workspace too small: need %zu have %zu\n", off, ws_size); return; }
  p.phase_begin = 0; p.phase_end = 18;
  void* args[] = {&p};
  hipError_t e = hipLaunchCooperativeKernel((void*)mega, dim3(grid_blocks), dim3(NTHREADS), args, 0, stream);
  if (e != hipSuccess) fprintf(stderr, "cooperative launch failed: %s (grid %d)\n", hipGetErrorString(e), grid_blocks);
}
```

```cpp
#include <hip/hip_runtime.h>
#include <hip/hip_cooperative_groups.h>
#include <cstdio>
namespace cg = cooperative_groups;

#define LAS __attribute__((address_space(3)))
typedef unsigned short bf16_t;
typedef short bf16x8 __attribute__((ext_vector_type(8)));
typedef float f32x4 __attribute__((ext_vector_type(4)));
typedef float f32x16 __attribute__((ext_vector_type(16)));
typedef unsigned u32x4 __attribute__((ext_vector_type(4)));
typedef unsigned u32x2 __attribute__((ext_vector_type(2)));

constexpr int T_TOK = 33280, TP = 32768, NMT = 130;
constexpr int LDP = 5376;
constexpr int C_ZA = 0, C_XBC = 1024, C_U = 3072, C_ZB = 4096, C_DT = 5120;
constexpr int NTHREADS = 512;
constexpr int LDS_BYTES = 139264;

constexpr size_t O_Y = 0, O_CONVP = 34078720, O_SSDP = 34471936, O_S5REP = 42860544, O_S5IMP = 43122688,
                 O_CONVS = 43384832, O_SSDS = 43581440, O_S5RES = 47775744, O_S5IMS = 47906816;

struct Params {
  const float *x_prompt, *x_sample, *st_conv, *st_ssd, *st_s5re, *st_s5im;
  const float *norm_g, *w_in, *conv_w, *conv_b, *dt_bias, *a_log, *d_ssd, *ssd_norm_g;
  const float *lam_re, *lam_im, *log_dt, *b_re, *b_im, *c_re, *c_im, *d_s5, *w_glu, *b_glu, *w_out, *final_g;
  float* out;
  bf16_t *xb, *proj, *WinT, *WgluT, *WoutT, *BbT, *CmT;
  float *sumsq, *ssqa, *lamb, *part;
  unsigned* bar;
  int phase_begin, phase_end;
};

__device__ __forceinline__ float bf2f(unsigned short v) { return __uint_as_float(((unsigned)v) << 16); }
__device__ __forceinline__ float lo_f(unsigned w) { return __uint_as_float(w << 16); }
__device__ __forceinline__ float hi_f(unsigned w) { return __uint_as_float(w & 0xffff0000u); }
__device__ __forceinline__ unsigned pk2(float lo, float hi) { unsigned r; asm("v_cvt_pk_bf16_f32 %0, %1, %2" : "=v"(r) : "v"(lo), "v"(hi)); return r; }
__device__ __forceinline__ float sigm(float x) { return __builtin_amdgcn_rcpf(1.f + __expf(-x)); }
__device__ __forceinline__ float siluf(float x) { return x * sigm(x); }
__device__ __forceinline__ float gelu_tanh(float x) { const float z = 0.7978845608028654f * (x + 0.044715f * x * x * x); return x * sigm(2.f * z); }
__device__ __forceinline__ f32x4 mfma16(bf16x8 a, bf16x8 b, f32x4 c) { return __builtin_amdgcn_mfma_f32_16x16x32_bf16(a, b, c, 0, 0, 0); }
#define WAIT_V0() asm volatile("s_waitcnt vmcnt(0)" ::: "memory")
#define LDS_BARRIER() asm volatile("s_waitcnt lgkmcnt(0)\n\ts_barrier" ::: "memory")
__device__ __forceinline__ int otid() { int t = threadIdx.x; asm volatile("" : "+v"(t)); return t; }

__device__ __forceinline__ void stage_rc(int b, int& R, int& C) {
  const int st = b >> 10, sb = b & 1023, swz = sb ^ (((sb >> 9) & 1) << 5);
  R = (st >> 1) * 16 + swz / 64;
  C = (st & 1) * 32 + (swz % 64) / 2;
}

__device__ __forceinline__ int xcd_remap(int u) {
  const int G = gridDim.x, i = u / G, blk = u % G, per = G >> 3;
  if (G & 7) return u;
  return (i * 8 + (blk & 7)) * per + (blk >> 3);
}
__device__ __forceinline__ void tile_map(int u, int nN, int& pm, int& pn) {
  const int nig = 8 * nN, gid = u / nig, fm = gid * 8, rem = u % nig;
  const int gsz = (NMT - fm) < 8 ? (NMT - fm) : 8;
  pm = fm + rem % gsz; pn = rem / gsz;
}

namespace g8 {
constexpr int HTB = 128 * 64 * 2;
__device__ __forceinline__ int lds_byte(int r, int c) { const int st = (r >> 4) * 2 + (c >> 5), rr = r & 15, cc = c & 31, ob = rr * 64 + cc * 2; return st * 1024 + (ob ^ (((ob >> 9) & 1) << 5)); }
struct Unit { int pm, pn; };
struct Order {
  int ntiles, nN, mode, q;
  __device__ __forceinline__ bool next(int i, Unit& u) const {
    if (mode == 1) {
      if (i != 0 || (int)blockIdx.x >= 32 || ((int)blockIdx.x >> 3) != q) return false;
      tile_map(512 + ((int)blockIdx.x & 7), 4, u.pm, u.pn); return true;
    }
    const int w = xcd_remap((int)blockIdx.x + i * (int)gridDim.x);
    if (w >= ntiles) return false;
    tile_map(w, nN, u.pm, u.pn); return true;
  }
};
__device__ __forceinline__ int perm32(int rho) { const int n = rho >> 4, i = rho & 15; return 8 * (i >> 2) + 4 * n + (i & 3); }
struct EpiIn8 {
  static constexpr bool PERM = true;
  bf16_t* proj; const float* sumsq;
  __device__ __forceinline__ void operator()(const f32x4 (&acc)[2][2][4][2], const Unit& u, int wr, int wc, int fr, int fq) const {
    const int row0 = u.pm * 256 + wr * 64 + fr, col0 = u.pn * 256 + wc * 32 + fq * 8;
#pragma unroll
    for (int ai = 0; ai < 2; ++ai)
#pragma unroll
      for (int m = 0; m < 4; ++m) {
        asm volatile("" ::: "memory");
        const int row = row0 + ai * 128 + m * 16;
        const f32x4* sp = (const f32x4*)(sumsq + (size_t)row * 16);
        const f32x4 s0 = sp[0], s1 = sp[1], s2 = sp[2], s3 = sp[3];
        const float ss = ((s0[0] + s0[1]) + (s0[2] + s0[3])) + ((s1[0] + s1[1]) + (s1[2] + s1[3])) +
                         ((s2[0] + s2[1]) + (s2[2] + s2[3])) + ((s3[0] + s3[1]) + (s3[2] + s3[3]));
        const float rs = rsqrtf(ss * (1.f / 1024.f) + 1e-6f);
        bf16_t* rp = proj + (size_t)row * LDP + col0;
#pragma unroll
        for (int bj = 0; bj < 2; ++bj) {
          const f32x4 v0 = acc[ai][bj][m][0] * rs, v1 = acc[ai][bj][m][1] * rs;
          *(u32x4*)(rp + bj * 128) = (u32x4){pk2(v0[0], v0[1]), pk2(v0[2], v0[3]), pk2(v1[0], v1[1]), pk2(v1[2], v1[3])};
        }
      }
  }
};
struct EpiGlu8 {
  static constexpr bool PERM = true;
  bf16_t* proj; const float* bglu; const bf16_t* ys;
  __device__ __forceinline__ void operator()(const f32x4 (&acc)[2][2][4][2], const Unit& u, int wr, int wc, int fr, int fq) const {
    const int row0 = u.pm * 256 + wr * 64 + fr, col0 = u.pn * 256 + wc * 32 + fq * 8;
#pragma unroll
    for (int ai = 0; ai < 2; ++ai)
#pragma unroll
      for (int m = 0; m < 4; ++m) {
        asm volatile("" ::: "memory");
        const int row = row0 + ai * 128 + m * 16;
        bf16_t* base = proj + (size_t)row * LDP;
#pragma unroll
        for (int bj = 0; bj < 2; ++bj) {
          const int col = col0 + bj * 128;
          const f32x4 g0 = acc[ai][bj][m][0] + *(const f32x4*)(bglu + col), g1 = acc[ai][bj][m][1] + *(const f32x4*)(bglu + col + 4);
          const u32x4 a = *(const u32x4*)(ys + (size_t)row * 1024 + col);
          const u32x4 z = *(const u32x4*)(base + C_ZB + col);
          u32x4 o;
          o[0] = pk2(lo_f(a[0]) * sigm(g0[0]) * siluf(lo_f(z[0])), hi_f(a[0]) * sigm(g0[1]) * siluf(hi_f(z[0])));
          o[1] = pk2(lo_f(a[1]) * sigm(g0[2]) * siluf(lo_f(z[1])), hi_f(a[1]) * sigm(g0[3]) * siluf(hi_f(z[1])));
          o[2] = pk2(lo_f(a[2]) * sigm(g1[0]) * siluf(lo_f(z[2])), hi_f(a[2]) * sigm(g1[1]) * siluf(hi_f(z[2])));
          o[3] = pk2(lo_f(a[3]) * sigm(g1[2]) * siluf(lo_f(z[3])), hi_f(a[3]) * sigm(g1[3]) * siluf(hi_f(z[3])));
          *(u32x4*)(base + C_ZB + col) = o;
        }
      }
  }
};
struct EpiOut8 {
  static constexpr bool PERM = true;
  const float *xin_p, *xin_s; float* xout; bf16_t* xb; float* ssq_next;
  __device__ __forceinline__ void operator()(const f32x4 (&acc)[2][2][4][2], const Unit& u, int wr, int wc, int fr, int fq) const {
    const int row0 = u.pm * 256 + wr * 64 + fr, col0 = u.pn * 256 + wc * 32 + fq * 8;
#pragma unroll
    for (int ai = 0; ai < 2; ++ai)
#pragma unroll
      for (int m = 0; m < 4; ++m) {
        asm volatile("" ::: "memory");
        const int row = row0 + ai * 128 + m * 16;
        const float* xr = (row < TP) ? (xin_p + (size_t)row * 1024) : (xin_s + (size_t)(row - TP) * 1024);
        float s = 0.f;
#pragma unroll
        for (int bj = 0; bj < 2; ++bj) {
          const int col = col0 + bj * 128;
          const f32x4 v0 = acc[ai][bj][m][0] + *(const f32x4*)(xr + col), v1 = acc[ai][bj][m][1] + *(const f32x4*)(xr + col + 4);
          *(f32x4*)(xout + (size_t)row * 1024 + col) = v0;
          *(f32x4*)(xout + (size_t)row * 1024 + col + 4) = v1;
          if (xb) *(u32x4*)(xb + (size_t)row * 1024 + col) = (u32x4){pk2(v0[0], v0[1]), pk2(v0[2], v0[3]), pk2(v1[0], v1[1]), pk2(v1[2], v1[3])};
          s += v0[0] * v0[0] + v0[1] * v0[1] + v0[2] * v0[2] + v0[3] * v0[3] + v1[0] * v1[0] + v1[1] * v1[1] + v1[2] * v1[2] + v1[3] * v1[3];
        }
        s += __shfl_xor(s, 16); s += __shfl_xor(s, 32);
        if (fq == 0) ssq_next[(size_t)row * 16 + u.pn * 4 + wc] = s;
      }
  }
};

struct EpiPart8 {
  static constexpr bool PERM = true;
  float* part;
  __device__ __forceinline__ void operator()(const f32x4 (&acc)[2][2][4][2], const Unit& u, int wr, int wc, int fr, int fq) const {
    const int row0 = u.pm * 256 + wr * 64 + fr - TP, col0 = u.pn * 256 + wc * 32 + fq * 8;
#pragma unroll
    for (int ai = 0; ai < 2; ++ai)
#pragma unroll
      for (int m = 0; m < 4; ++m)
#pragma unroll
        for (int bj = 0; bj < 2; ++bj) {
          float* q0 = part + (size_t)(row0 + ai * 128 + m * 16) * 1024 + col0 + bj * 128;
          *(f32x4*)q0 = acc[ai][bj][m][0]; *(f32x4*)(q0 + 4) = acc[ai][bj][m][1];
        }
  }
};

template <class Epi>
__device__ __forceinline__ void gemm_phase8(LAS unsigned char* lds, const bf16_t* A, int lda, int segkt, int segoff, const bf16_t* Bt, int ldb, int K,
                                            const Order& S, const Epi& E) {
  const int tid = otid(), wid = __builtin_amdgcn_readfirstlane(tid >> 6), lane = tid & 63, wr = wid >> 2, wc = wid & 3, fr = lane & 15, fq = lane >> 4;
  const int nt = K / 64;
  unsigned voffA[2], voffB[2];
#pragma unroll
  for (int i = 0; i < 2; ++i) { int R, C; stage_rc(tid * 16 + i * 8192, R, C); const int Rb = Epi::PERM ? ((R & ~31) + perm32(R & 31)) : R;
    voffA[i] = (unsigned)(R * lda + C) * 2u; voffB[i] = (unsigned)(Rb * ldb + C) * 2u; }
  const size_t kstep = 128;
  const size_t hstepA = (size_t)128 * lda * 2, tstepA = 2 * hstepA;
  const size_t hstepB = (size_t)128 * ldb * 2, tstepB = 2 * hstepB;
  const size_t segB = (size_t)segoff * 2;
#define G8_AK(kt) ((size_t)(kt) * 128 + (((kt) >= segkt) ? segB : (size_t)0))
  const unsigned ldsw = (unsigned)wid * 1024u;
  const int aoff = lds_byte(wr * 64 + fr, fq * 8), boff = lds_byte(wc * 32 + fr, fq * 8);
#define G8_SA(b, h) (((b) * 2 + (h)) * HTB)
#define G8_SB(b, h) ((4 + (b) * 2 + (h)) * HTB)
#define G8_STAGE(bufoff, gbase, voff) do { _Pragma("unroll") for (int _i = 0; _i < 2; ++_i) \
    __builtin_amdgcn_global_load_lds((const unsigned*)((const char*)(gbase) + (voff)[_i]), (LAS unsigned*)(lds + (bufoff) + ldsw + _i * 8192), 16, 0, 0); } while (0)
#define G8_LDA(dst, b, h) do { _Pragma("unroll") for (int m = 0; m < 4; ++m) _Pragma("unroll") for (int k = 0; k < 2; ++k) dst[m][k] = *(const LAS bf16x8*)(lds + G8_SA(b, h) + aoff + m * 2048 + k * 1024); } while (0)
#define G8_LDB(dst, b, h) do { _Pragma("unroll") for (int n = 0; n < 2; ++n) _Pragma("unroll") for (int k = 0; k < 2; ++k) dst[n][k] = *(const LAS bf16x8*)(lds + G8_SB(b, h) + boff + n * 2048 + k * 1024); } while (0)
#define G8_MMA(ai, bj, At, Bt_) do { __builtin_amdgcn_s_setprio(1); _Pragma("unroll") for (int m = 0; m < 4; ++m) _Pragma("unroll") for (int n = 0; n < 2; ++n) _Pragma("unroll") for (int k = 0; k < 2; ++k) \
    acc[ai][bj][m][n] = __builtin_amdgcn_mfma_f32_16x16x32_bf16(Bt_[n][k], At[m][k], acc[ai][bj][m][n], 0, 0, 0); __builtin_amdgcn_s_setprio(0); } while (0)
#define G8_WAIT_V(n) asm volatile("s_waitcnt vmcnt(" #n ")" ::: "memory")
#define G8_WAIT_L(n) asm volatile("s_waitcnt lgkmcnt(" #n ")" ::: "memory")
#define G8_BAR __builtin_amdgcn_s_barrier()
#define G8_SCHED __builtin_amdgcn_sched_barrier(0)
  Unit cur, nxt; int ui = 0;
  if (!S.next(0, cur)) return;
  f32x4 acc[2][2][4][2];
#pragma unroll
  for (int a = 0; a < 2; ++a)
#pragma unroll
    for (int b = 0; b < 2; ++b)
#pragma unroll
      for (int m = 0; m < 4; ++m)
#pragma unroll
        for (int n = 0; n < 2; ++n) acc[a][b][m][n] = (f32x4){0.f, 0.f, 0.f, 0.f};
  bf16x8 At[4][2], B0[2][2], B1[2][2];
  const char* cA = (const char*)A + (size_t)cur.pm * tstepA; const char* cB = (const char*)Bt + (size_t)cur.pn * tstepB;
  G8_STAGE(G8_SB(0, 0), cB, voffB); G8_STAGE(G8_SA(0, 0), cA, voffA); G8_STAGE(G8_SB(0, 1), cB + hstepB, voffB); G8_STAGE(G8_SA(0, 1), cA + hstepA, voffA);
  if (wr == 1) G8_BAR;
  G8_WAIT_V(4); G8_BAR;
  G8_STAGE(G8_SB(1, 0), cB + kstep, voffB); G8_STAGE(G8_SA(1, 0), cA + G8_AK(1), voffA); G8_STAGE(G8_SB(1, 1), cB + hstepB + kstep, voffB);
  G8_WAIT_V(6); G8_BAR;
  for (;;) {
    const bool has_next = S.next(ui + 1, nxt);
    const char* nA = has_next ? (const char*)A + (size_t)nxt.pm * tstepA : cA; const char* nB = has_next ? (const char*)Bt + (size_t)nxt.pn * tstepB : cB;
    for (int t = 0; t < nt; t += 2) {
      const bool last = (t == nt - 2);
      const char* a1 = cA + G8_AK(t + 1);
      const char* a2 = last ? nA : cA + G8_AK(t + 2); const char* b2 = last ? nB : cB + (size_t)(t + 2) * kstep;
      const char* a3 = last ? nA + G8_AK(1) : cA + G8_AK(t + 3); const char* b3 = b2 + kstep;
      G8_LDB(B0, 0, 0); G8_SCHED; G8_LDA(At, 0, 0); G8_STAGE(G8_SA(1, 1), a1 + hstepA, voffA);
      G8_WAIT_L(8); G8_BAR; G8_WAIT_L(0); G8_MMA(0, 0, At, B0); G8_BAR; G8_SCHED;
      G8_LDB(B1, 0, 1); G8_STAGE(G8_SB(0, 0), b2, voffB);
      G8_BAR; G8_WAIT_L(0); G8_MMA(0, 1, At, B1); G8_BAR;
      G8_LDA(At, 0, 1); G8_STAGE(G8_SA(0, 0), a2, voffA);
      G8_BAR; G8_WAIT_L(0); G8_MMA(1, 0, At, B0); G8_BAR; G8_SCHED;
      G8_STAGE(G8_SB(0, 1), b2 + hstepB, voffB);
      G8_WAIT_V(6); G8_BAR; G8_MMA(1, 1, At, B1); G8_BAR;
      G8_LDB(B0, 1, 0); G8_SCHED; G8_LDA(At, 1, 0); G8_STAGE(G8_SA(0, 1), a2 + hstepA, voffA);
      G8_WAIT_L(8); G8_BAR; G8_WAIT_L(0); G8_MMA(0, 0, At, B0); G8_BAR; G8_SCHED;
      G8_LDB(B1, 1, 1); G8_STAGE(G8_SB(1, 0), b3, voffB);
      G8_BAR; G8_WAIT_L(0); G8_MMA(0, 1, At, B1); G8_BAR;
      G8_LDA(At, 1, 1); G8_STAGE(G8_SA(1, 0), a3, voffA);
      G8_BAR; G8_WAIT_L(0); G8_MMA(1, 0, At, B0); G8_BAR; G8_SCHED;
      G8_STAGE(G8_SB(1, 1), b3 + hstepB, voffB);
      G8_WAIT_V(6); G8_BAR; G8_MMA(1, 1, At, B1); G8_BAR;
    }
    E(acc, cur, wr, wc, fr, fq);
    if (!has_next) break;
#pragma unroll
    for (int a = 0; a < 2; ++a)
#pragma unroll
      for (int b = 0; b < 2; ++b)
#pragma unroll
        for (int m = 0; m < 4; ++m)
#pragma unroll
          for (int n = 0; n < 2; ++n) acc[a][b][m][n] = (f32x4){0.f, 0.f, 0.f, 0.f};
    cur = nxt; cA = nA; cB = nB; ++ui;
  }
  G8_WAIT_V(0);
  if (wr == 0) G8_BAR;
  G8_BAR;
#undef G8_AK
#undef G8_SA
#undef G8_SB
#undef G8_STAGE
#undef G8_LDA
#undef G8_LDB
#undef G8_MMA
#undef G8_WAIT_V
#undef G8_WAIT_L
#undef G8_BAR
#undef G8_SCHED
}
}

__device__ void xrow_unit(const Params& p, int unit) {
  const int tid_ = otid(); const int wid = tid_ >> 6, lane = tid_ & 63;
  f32x4 v[2][4];
#pragma unroll
  for (int r = 0; r < 2; ++r) {
    const int row = unit * 16 + r * 8 + wid;
    const float* src = (row < TP) ? (p.x_prompt + (size_t)row * 1024) : (p.x_sample + (size_t)(row - TP) * 1024);
#pragma unroll
    for (int i = 0; i < 2; ++i) { v[r][2 * i] = *(const f32x4*)(src + i * 512 + lane * 8); v[r][2 * i + 1] = *(const f32x4*)(src + i * 512 + lane * 8 + 4); }
  }
#pragma unroll
  for (int r = 0; r < 2; ++r) {
    const int row = unit * 16 + r * 8 + wid;
    float s = 0.f;
#pragma unroll
    for (int i = 0; i < 2; ++i) {
      const f32x4 x0 = v[r][2 * i], x1 = v[r][2 * i + 1];
      s += x0[0] * x0[0] + x0[1] * x0[1] + x0[2] * x0[2] + x0[3] * x0[3] + x1[0] * x1[0] + x1[1] * x1[1] + x1[2] * x1[2] + x1[3] * x1[3];
      *(u32x4*)(p.xb + (size_t)row * 1024 + i * 512 + lane * 8) = (u32x4){pk2(x0[0], x0[1]), pk2(x0[2], x0[3]), pk2(x1[0], x1[1]), pk2(x1[2], x1[3])};
    }
#pragma unroll
    for (int o = 32; o >= 1; o >>= 1) s += __shfl_xor(s, o);
    if (lane < 16) p.sumsq[(size_t)row * 16 + lane] = (lane == 0) ? s : 0.f;
  }
}

__device__ void transpose_unit(LAS unsigned char* lds, const float* src, int ldsrc, const float* scale, int nscale,
                               bf16_t* dst, int ldd, int kt, int ntile, int mode) {
  LAS float* tl = (LAS float*)lds;
  const int tid = otid();
  const int k0 = kt * 64, n0 = ntile * 64;
  f32x4 v[2];
#pragma unroll
  for (int i = 0; i < 2; ++i) {
    const int idx = tid + i * 512, kk = idx >> 4, n4 = (idx & 15) * 4;
    const int np = n0 + n4;
    int sc = np;
    if (mode == 0) { sc = (np < 3072) ? np : (np < 5120) ? (np + 16) : (np < 5136) ? (np - 5120 + 3072) : -1; }
    f32x4 x = (f32x4){0.f, 0.f, 0.f, 0.f};
    if (sc >= 0) {
      x = *(const f32x4*)(src + (size_t)(k0 + kk) * ldsrc + sc);
      if (scale && (k0 + kk) < nscale) x = x * scale[k0 + kk];
    }
    v[i] = x;
  }
#pragma unroll
  for (int i = 0; i < 2; ++i) {
    const int idx = tid + i * 512, kk = idx >> 4, n4 = (idx & 15) * 4;
#pragma unroll
    for (int j = 0; j < 4; ++j) tl[kk * 65 + n4 + j] = v[i][j];
  }
  __syncthreads();
  {
    const int nn = tid >> 3, kk0 = (tid & 7) * 8;
    float t[8];
#pragma unroll
    for (int j = 0; j < 8; ++j) t[j] = tl[(kk0 + j) * 65 + nn];
    *(u32x4*)(dst + (size_t)(n0 + nn) * ldd + k0 + kk0) = (u32x4){pk2(t[0], t[1]), pk2(t[2], t[3]), pk2(t[4], t[5]), pk2(t[6], t[7])};
  }
  __syncthreads();
}

__device__ __forceinline__ double exp_d(double x) {
  const double k = rint(x * 1.4426950408889634);
  const double r = fma(-k, 0.6931471805599453, x) - k * 2.3190468138462996e-17;
  double s = 1.0 / 6227020800.0;
  s = fma(s, r, 1.0 / 479001600.0); s = fma(s, r, 1.0 / 39916800.0); s = fma(s, r, 1.0 / 3628800.0);
  s = fma(s, r, 1.0 / 362880.0); s = fma(s, r, 1.0 / 40320.0); s = fma(s, r, 1.0 / 5040.0);
  s = fma(s, r, 1.0 / 720.0); s = fma(s, r, 1.0 / 120.0); s = fma(s, r, 1.0 / 24.0);
  s = fma(s, r, 1.0 / 6.0); s = fma(s, r, 0.5); s = fma(s, r, 1.0); s = fma(s, r, 1.0);
  return ldexp(s, (int)k);
}
__device__ __forceinline__ void sincos_d(double x, double& sn, double& cs) {
  const double k = rint(x * 0.6366197723675814);
  double r = fma(-k, 1.5707963267948966, x); r = fma(-k, 6.123233995736766e-17, r);
  const int q = ((int)k) & 3;
  const double r2 = r * r;
  double sp = 1.0 / 1307674368000.0;
  sp = fma(sp, r2, -1.0 / 6227020800.0); sp = fma(sp, r2, 1.0 / 39916800.0); sp = fma(sp, r2, -1.0 / 362880.0);
  sp = fma(sp, r2, 1.0 / 5040.0); sp = fma(sp, r2, -1.0 / 120.0); sp = fma(sp, r2, 1.0 / 6.0);
  sp = r - r * r2 * sp;
  double cp = 1.0 / 20922789888000.0;
  cp = fma(cp, r2, -1.0 / 87178291200.0); cp = fma(cp, r2, 1.0 / 479001600.0); cp = fma(cp, r2, -1.0 / 3628800.0);
  cp = fma(cp, r2, 1.0 / 40320.0); cp = fma(cp, r2, -1.0 / 720.0); cp = fma(cp, r2, 1.0 / 24.0); cp = fma(cp, r2, -0.5);
  cp = fma(cp, r2, 1.0);
  sn = (q == 0) ? sp : (q == 1) ? cp : (q == 2) ? -sp : -cp;
  cs = (q == 0) ? cp : (q == 1) ? -sp : (q == 2) ? -cp : sp;
}

__device__ void s5prep_unit(LAS unsigned char* lds, const Params& p, int l, int g) {
  LAS float* cf = (LAS float*)lds;
  const int tid = otid();
  const int lg = l * 64 + g;
  if (tid < 64) {
    const double dt = exp_d((double)p.log_dt[lg]);
    const double lr = (double)p.lam_re[lg * 64 + tid], li = (double)p.lam_im[lg * 64 + tid];
    const double e = exp_d(lr * dt);
    double sn, cs; sincos_d(li * dt, sn, cs);
    const double lbr = e * cs, lbi = e * sn;
    const double nr = lbr - 1.0, ni = lbi;
    const double den = lr * lr + li * li;
    const double cr = (nr * lr + ni * li) / den, ci = (ni * lr - nr * li) / den;
    p.lamb[(size_t)(lg * 64 + tid) * 2 + 0] = (float)lbr;
    p.lamb[(size_t)(lg * 64 + tid) * 2 + 1] = (float)lbi;
    cf[tid * 2 + 0] = (float)cr; cf[tid * 2 + 1] = (float)ci;
  }
  __syncthreads();
#pragma unroll
  for (int i = 0; i < 4; ++i) {
    const int idx = tid * 4 + i;
    {
      const int pp = idx >> 4, c = idx & 15, st = pp & 63;
      const float br = p.b_re[((size_t)lg * 64 + st) * 16 + c], bi = p.b_im[((size_t)lg * 64 + st) * 16 + c];
      const float cr = cf[st * 2], ci = cf[st * 2 + 1];
      const float v = (pp < 64) ? (cr * br - ci * bi) : (cr * bi + ci * br);
      p.BbT[(size_t)lg * 2048 + idx] = (bf16_t)(pk2(v, v) & 0xffffu);
    }
    {
      const int c = idx >> 7, pp = idx & 127, st = pp & 63;
      const float v = (pp < 64) ? p.c_re[((size_t)lg * 16 + c) * 64 + st] : -p.c_im[((size_t)lg * 16 + c) * 64 + st];
      p.CmT[(size_t)lg * 2048 + idx] = (bf16_t)(pk2(v, v) & 0xffffu);
    }
  }
  __syncthreads();
}

__device__ void phase_prep(LAS unsigned char* lds, const Params& p) {
  constexpr int U_X = 2080, U_WIN = 5376, U_WGLU = 1024, U_WOUT = 2048, U_S5 = 256;
  constexpr int TOTAL = U_X + U_WIN + U_WGLU + U_WOUT + U_S5;
  for (int u = blockIdx.x; u < TOTAL; u += gridDim.x) {
    int idx = u;
    if (idx < U_X) { xrow_unit(p, idx); continue; }
    idx -= U_X;
    if (idx < U_WIN) {
      const int l = idx / 1344, r = idx % 1344, ntile = r / 16, kt = r % 16;
      transpose_unit(lds, p.w_in + (size_t)l * 1024 * 5136, 5136, p.norm_g + l * 1024, 1024,
                     p.WinT + (size_t)l * 5376 * 1024, 1024, kt, ntile, 0);
      continue;
    }
    idx -= U_WIN;
    if (idx < U_WGLU) {
      const int l = idx / 256, r = idx % 256, ntile = r / 16, kt = r % 16;
      transpose_unit(lds, p.w_glu + (size_t)l * 1024 * 1024, 1024, nullptr, 0, p.WgluT + (size_t)l * 1024 * 1024, 1024, kt, ntile, 1);
      continue;
    }
    idx -= U_WGLU;
    if (idx < U_WOUT) {
      const int l = idx / 512, r = idx % 512, ntile = r / 32, kt = r % 32;
      transpose_unit(lds, p.w_out + (size_t)l * 2048 * 1024, 1024, p.ssd_norm_g + l * 1024, 1024,
                     p.WoutT + (size_t)l * 1024 * 2048, 2048, kt, ntile, 2);
      continue;
    }
    idx -= U_WOUT;
    s5prep_unit(lds, p, idx / 64, idx % 64);
  }
}

constexpr int CM_OFF = 0, BM_OFF = 17408, BMT_OFF = 34816, XDT_OFF = 53248, XW_OFF = 62464, MM_OFF = 71680,
              HB_OFF = 80896, XS_OFF = 98304, ACS_OFF = 107520, DTV_OFF = 115712, SSQ_OFF = 123904, CW_OFF = 124416;

__device__ __forceinline__ bf16x8 ldfrag(LAS unsigned char* lds, int off, int row, int stride, int col) {
  return *(const LAS bf16x8*)(lds + off + (row * stride + col) * 2);
}

template <int NCH>
__device__ __forceinline__ void conv_load_rows(unsigned (&rows)[7][NCH / 2], const bf16_t* proj, const float* stc, int tok0, int c, int s0, int ccol) {
#pragma unroll
  for (int i = 0; i < 7; ++i) {
    const int pos = c * 64 + s0 - 3 + i;
    if (pos >= 0) {
      const bf16_t* q = proj + (size_t)(tok0 + pos) * LDP + C_XBC + ccol;
      if (NCH == 8) { const u32x4 v = *(const u32x4*)q; rows[i][0] = v[0]; rows[i][1] = v[1]; rows[i][NCH / 2 - 2] = v[2]; rows[i][NCH / 2 - 1] = v[3]; }
      else rows[i][0] = *(const unsigned*)q;
    } else if (stc) {
      const float* sp = stc + (size_t)(3 + pos) * 2048 + ccol;
#pragma unroll
      for (int k = 0; k < NCH / 2; ++k) rows[i][k] = pk2(sp[2 * k], sp[2 * k + 1]);
    } else {
#pragma unroll
      for (int k = 0; k < NCH / 2; ++k) rows[i][k] = 0u;
    }
  }
}
template <int NCH>
__device__ __forceinline__ void conv_load_rows_fast(unsigned (&rows)[7][NCH / 2], const bf16_t* proj, int tok0, int c, int s0, int ccol) {
  const bf16_t* q0 = proj + (size_t)(tok0 + c * 64 + s0 - 3) * LDP + C_XBC + ccol;
#pragma unroll
  for (int i = 0; i < 7; ++i) {
    const bf16_t* q = q0 + (size_t)i * LDP;
    if (NCH == 8) { const u32x4 v = *(const u32x4*)q; rows[i][0] = v[0]; rows[i][1] = v[1]; rows[i][NCH / 2 - 2] = v[2]; rows[i][NCH / 2 - 1] = v[3]; }
    else rows[i][0] = *(const unsigned*)q;
  }
}
template <int NCH>
__device__ __forceinline__ void conv_store_row(LAS unsigned char* addr, const float* o) {
  if (NCH == 8) *(LAS u32x4*)addr = (u32x4){pk2(o[0], o[1]), pk2(o[2], o[3]), pk2(o[NCH - 4], o[NCH - 3]), pk2(o[NCH - 2], o[NCH - 1])};
  else *(LAS unsigned*)addr = pk2(o[0], o[1]);
}
template <int NCH>
__device__ __forceinline__ void conv_unit(LAS unsigned char* lds, const unsigned (&rows)[7][NCH / 2], const LAS float* wl,
                                          int oct, int chq, int s0, const LAS float* acs, const LAS float* dtv) {
  float o[4][NCH];
  float w[4][NCH], bs[NCH];
#pragma unroll
  for (int e = 0; e < NCH; ++e) { bs[e] = wl[32 + e];
#pragma unroll
    for (int k = 0; k < 4; ++k) w[k][e] = wl[k * 8 + e]; }
#pragma unroll
  for (int e = 0; e < NCH; ++e) {
    float xv[7];
#pragma unroll
    for (int i = 0; i < 7; ++i) xv[i] = (e & 1) ? hi_f(rows[i][e >> 1]) : lo_f(rows[i][e >> 1]);
#pragma unroll
    for (int j = 0; j < 4; ++j) o[j][e] = siluf(bs[e] + w[0][e] * xv[j] + w[1][e] * xv[j + 1] + w[2][e] * xv[j + 2] + w[3][e] * xv[j + 3]);
  }
  if (oct < 8) {
    float dts[4], wsc[4];
    const float aend = acs[63];
#pragma unroll
    for (int j = 0; j < 4; ++j) { dts[j] = dtv[s0 + j]; wsc[j] = dts[j] * __expf(aend - acs[s0 + j]); }
    const int p0 = oct * 8 + chq;
#pragma unroll
    for (int j = 0; j < 4; ++j) conv_store_row<NCH>(lds + XS_OFF + ((s0 + j) * 72 + p0) * 2, o[j]);
#pragma unroll
    for (int e = 0; e < NCH; ++e) {
      *(LAS u32x2*)(lds + XDT_OFF + ((p0 + e) * 72 + s0) * 2) = (u32x2){pk2(o[0][e] * dts[0], o[1][e] * dts[1]), pk2(o[2][e] * dts[2], o[3][e] * dts[3])};
      *(LAS u32x2*)(lds + XW_OFF + ((p0 + e) * 72 + s0) * 2) = (u32x2){pk2(o[0][e] * wsc[0], o[1][e] * wsc[1]), pk2(o[2][e] * wsc[2], o[3][e] * wsc[3])};
    }
  } else if (oct < 24) {
    const int n0 = (oct - 8) * 8 + chq;
#pragma unroll
    for (int j = 0; j < 4; ++j) conv_store_row<NCH>(lds + BM_OFF + ((s0 + j) * 136 + n0) * 2, o[j]);
#pragma unroll
    for (int e = 0; e < NCH; ++e) *(LAS u32x2*)(lds + BMT_OFF + ((n0 + e) * 72 + s0) * 2) = (u32x2){pk2(o[0][e], o[1][e]), pk2(o[2][e], o[3][e])};
  } else {
    const int n0 = (oct - 24) * 8 + chq;
#pragma unroll
    for (int j = 0; j < 4; ++j) conv_store_row<NCH>(lds + CM_OFF + ((s0 + j) * 136 + n0) * 2, o[j]);
  }
}

__device__ void ssd_item(LAS unsigned char* lds, const Params& p, int l, int b, int h, bool smp) {
  const int tid = otid(), wid = tid >> 6, lane = tid & 63, fr = lane & 15, fq = lane >> 4;
  const int g = h >> 2;
  const int tok0 = smp ? (TP + b * 64) : (b * 2048);
  const int nchunk = smp ? 1 : 32;
  const int NB = smp ? 8 : 16;
  bf16_t* proj = p.proj;
  LAS float* acs_all = (LAS float*)(lds + ACS_OFF);
  LAS float* dtv_all = (LAS float*)(lds + DTV_OFF);
  LAS float* ssq = (LAS float*)(lds + SSQ_OFF);
  const float dtb = p.dt_bias[l * 16 + h];
  const float Aneg = -__expf(p.a_log[l * 16 + h]);
  const float Dh = p.d_ssd[l * 16 + h];

  f32x4 hacc[4];
#pragma unroll
  for (int pt = 0; pt < 4; ++pt) {
    if (smp) hacc[pt] = *(const f32x4*)(p.st_ssd + ((((size_t)l * 8 + b) * 16 + h) * 64 + pt * 16 + fr) * 128 + wid * 16 + fq * 4);
    else hacc[pt] = (f32x4){0.f, 0.f, 0.f, 0.f};
  }

  const float* stc = smp ? (p.st_conv + ((size_t)l * 8 + b) * 3 * 2048) : nullptr;
  int octA, s0A;
  if (tid < 128) { octA = tid & 7; s0A = (tid >> 3) * 4; }
  else if (tid < 384) { const int i = tid - 128; octA = 8 + (i & 15); s0A = (i >> 4) * 4; }
  else { const int i = tid - 384; octA = 24 + (i & 15); s0A = (i >> 4) * 4; }
  const int jB = tid >> 2, octB = 24 + (jB & 15), s0B = (8 + (jB >> 4)) * 4, chqB = (tid & 3) * 2;
  const int cchA = (octA < 8) ? (h * 64 + octA * 8) : (octA < 24) ? (1024 + g * 128 + (octA - 8) * 8) : (1536 + g * 128 + (octA - 24) * 8);
  const int cchB = ((octB < 8) ? (h * 64 + octB * 8) : (octB < 24) ? (1024 + g * 128 + (octB - 8) * 8) : (1536 + g * 128 + (octB - 24) * 8)) + chqB;
  LAS float* cwl = (LAS float*)(lds + CW_OFF);
  {
    const float* cw = p.conv_w + (size_t)l * 4 * 2048;
    const float* cb = p.conv_b + (size_t)l * 2048;
    for (int idx = tid; idx < 1600; idx += 512) {
      const int oc = idx / 40, r = idx % 40, k = r >> 3, e = r & 7;
      const int cc = ((oc < 8) ? (h * 64 + oc * 8) : (oc < 24) ? (1024 + g * 128 + (oc - 8) * 8) : (1536 + g * 128 + (oc - 24) * 8)) + e;
      cwl[idx] = (k < 4) ? cw[k * 2048 + cc] : cb[cc];
    }
  }
  unsigned rowsA[7][4], rowsB[7][1];
  conv_load_rows<8>(rowsA, proj, stc, tok0, 0, s0A, cchA);
  conv_load_rows<2>(rowsB, proj, stc, tok0, 0, s0B, cchB);
  for (int c = wid; c < nchunk; c += 8) {
    const float dtr = bf2f(proj[(size_t)(tok0 + c * 64 + lane) * LDP + C_DT + h]);
    const float xx = dtr + dtb;
    const float dt = xx > 20.f ? xx : log1pf(__expf(xx));
    float cs = dt * Aneg;
#pragma unroll
    for (int o = 1; o < 64; o <<= 1) { const float v = __shfl_up(cs, o); if (lane >= o) cs += v; }
    acs_all[c * 64 + lane] = cs; dtv_all[c * 64 + lane] = dt;
  }
  LDS_BARRIER();
  for (int c = 0; c < nchunk; ++c) {
    const int ctok = tok0 + c * 64;
    const LAS float* acs = acs_all + c * 64;
    const LAS float* dtv = dtv_all + c * 64;
    u32x2 z4v[2];
    {
      const int lt_ = wid >> 1, ptb_ = (wid & 1) * 2;
#pragma unroll
      for (int q = 0; q < 2; ++q) z4v[q] = *(const u32x2*)(proj + (size_t)(ctok + lt_ * 16 + fr) * LDP + C_ZA + h * 64 + (ptb_ + q) * 16 + fq * 4);
    }
    conv_unit<8>(lds, rowsA, cwl + octA * 40, octA, 0, s0A, acs, dtv);
    conv_unit<2>(lds, rowsB, cwl + octB * 40 + chqB, octB, chqB, s0B, acs, dtv);
    if (c + 1 < nchunk) {
      conv_load_rows_fast<8>(rowsA, proj, tok0, c + 1, s0A, cchA);
      conv_load_rows_fast<2>(rowsB, proj, tok0, c + 1, s0B, cchB);
    }
#pragma unroll
    for (int pt = 0; pt < 4; ++pt)
      *(LAS u32x2*)(lds + HB_OFF + ((pt * 16 + fr) * 136 + wid * 16 + fq * 4) * 2) =
          (u32x2){pk2(hacc[pt][0], hacc[pt][1]), pk2(hacc[pt][2], hacc[pt][3])};
    LDS_BARRIER();
    const int lt = wid >> 1, ptb = (wid & 1) * 2;
    {
      const int st = wid >> 1, ltb = (wid & 1) * 2;
      bf16x8 bfr[4];
#pragma unroll
      for (int ks = 0; ks < 4; ++ks) bfr[ks] = ldfrag(lds, BM_OFF, st * 16 + fr, 136, ks * 32 + fq * 8);
#pragma unroll
      for (int q = 0; q < 2; ++q) {
        const int ltq = ltb + q;
        f32x4 a = (f32x4){0.f, 0.f, 0.f, 0.f};
#pragma unroll
        for (int ks = 0; ks < 4; ++ks) a = mfma16(bfr[ks], ldfrag(lds, CM_OFF, ltq * 16 + fr, 136, ks * 32 + fq * 8), a);
        const int l_ = ltq * 16 + fr;
        const float al = acs[l_];
        float mv[4];
#pragma unroll
        for (int r = 0; r < 4; ++r) { const int s_ = st * 16 + fq * 4 + r; const float ex = __expf(al - acs[s_]); mv[r] = (s_ <= l_) ? a[r] * ex : 0.f; }
        *(LAS u32x2*)(lds + MM_OFF + (l_ * 72 + st * 16 + fq * 4) * 2) = (u32x2){pk2(mv[0], mv[1]), pk2(mv[2], mv[3])};
      }
    }
    f32x4 accI[2];
    accI[0] = (f32x4){0.f, 0.f, 0.f, 0.f}; accI[1] = accI[0];
#pragma unroll
    for (int ks = 0; ks < 4; ++ks) {
      const bf16x8 cfr = ldfrag(lds, CM_OFF, lt * 16 + fr, 136, ks * 32 + fq * 8);
#pragma unroll
      for (int q = 0; q < 2; ++q) accI[q] = mfma16(ldfrag(lds, HB_OFF, (ptb + q) * 16 + fr, 136, ks * 32 + fq * 8), cfr, accI[q]);
    }
    {
      const float dec = __expf(acs[63]);
      bf16x8 bt[2];
#pragma unroll
      for (int ks = 0; ks < 2; ++ks) bt[ks] = ldfrag(lds, BMT_OFF, wid * 16 + fr, 72, ks * 32 + fq * 8);
#pragma unroll
      for (int pt = 0; pt < 4; ++pt) {
        hacc[pt] = hacc[pt] * dec;
#pragma unroll
        for (int ks = 0; ks < 2; ++ks) hacc[pt] = mfma16(bt[ks], ldfrag(lds, XW_OFF, pt * 16 + fr, 72, ks * 32 + fq * 8), hacc[pt]);
      }
    }
    LDS_BARRIER();
    {
      f32x4 accY[2];
      accY[0] = (f32x4){0.f, 0.f, 0.f, 0.f}; accY[1] = accY[0];
#pragma unroll
      for (int ks = 0; ks < 2; ++ks) {
        const bf16x8 mf = ldfrag(lds, MM_OFF, lt * 16 + fr, 72, ks * 32 + fq * 8);
#pragma unroll
        for (int q = 0; q < 2; ++q) accY[q] = mfma16(ldfrag(lds, XDT_OFF, (ptb + q) * 16 + fr, 72, ks * 32 + fq * 8), mf, accY[q]);
      }
      const int l_ = lt * 16 + fr;
      const float el = __expf(acs[l_]);
      float sq = 0.f;
#pragma unroll
      for (int q = 0; q < 2; ++q) {
        const int p0 = (ptb + q) * 16 + fq * 4;
        const u32x2 xs4 = *(const LAS u32x2*)(lds + XS_OFF + (l_ * 72 + p0) * 2);
        bf16_t* zp = proj + (size_t)(ctok + l_) * LDP + C_ZA + h * 64 + p0;
        const u32x2 z4 = z4v[q];
        const float y0 = (accY[q][0] + el * accI[q][0] + Dh * lo_f(xs4.x)) * siluf(lo_f(z4.x));
        const float y1 = (accY[q][1] + el * accI[q][1] + Dh * hi_f(xs4.x)) * siluf(hi_f(z4.x));
        const float y2 = (accY[q][2] + el * accI[q][2] + Dh * lo_f(xs4.y)) * siluf(lo_f(z4.y));
        const float y3 = (accY[q][3] + el * accI[q][3] + Dh * hi_f(xs4.y)) * siluf(hi_f(z4.y));
        sq += y0 * y0 + y1 * y1 + y2 * y2 + y3 * y3;
        *(u32x2*)zp = (u32x2){pk2(y0, y1), pk2(y2, y3)};
      }
      sq += __shfl_xor(sq, 16); sq += __shfl_xor(sq, 32);
      if (fq == 0) ssq[(wid & 1) * 64 + l_] = sq;
    }
    LDS_BARRIER();
    if (tid < 64) p.ssqa[(size_t)(ctok + tid) * 16 + h] = ssq[tid] + ssq[64 + tid];
  }
  {
    float* so = p.out + (smp ? O_SSDS : O_SSDP);
#pragma unroll
    for (int pt = 0; pt < 4; ++pt)
      *(f32x4*)(so + ((((size_t)l * NB + b) * 16 + h) * 64 + pt * 16 + fr) * 128 + wid * 16 + fq * 4) = hacc[pt];
    float* co = p.out + (smp ? O_CONVS : O_CONVP);
    const int L = smp ? 64 : 2048;
    for (int i = tid; i < 3 * 320; i += 512) {
      const int r = i / 320, cc = i % 320;
      if (cc >= 64 && (h & 3)) continue;
      const int ch = (cc < 64) ? (h * 64 + cc) : (cc < 192) ? (1024 + g * 128 + (cc - 64)) : (1536 + g * 128 + (cc - 192));
      co[(((size_t)l * NB + b) * 3 + r) * 2048 + ch] = bf2f(proj[(size_t)(tok0 + L - 3 + r) * LDP + C_XBC + ch]);
    }
  }
  __syncthreads();
}

__device__ __forceinline__ float fma_asm(float a, float b, float c) { float d; asm volatile("v_fma_f32 %0, %1, %2, %3" : "=v"(d) : "v"(a), "v"(b), "v"(c)); return d; }
__device__ void s5_seq(LAS unsigned char* lds, const Params& p, int l, int b, int g, bool smp) {
  const int tid_ = otid(); const int wid = tid_ >> 6, lane = tid_ & 63, fr = lane & 15, fq = lane >> 4;
  const int pi = wid & 3, role = wid >> 2;
  LAS float* hbuf = (LAS float*)(lds + pi * 33792);
  const int tok0 = smp ? (TP + b * 64) : (b * 2048);
  const int nblk = smp ? 2 : 64;
  const int NB = smp ? 8 : 16;
  const int lg = l * 64 + g;
  const bf16_t* ubase = p.proj + C_U + g * 16;
  if (role == 0) {
    bf16x8 Bfrag[4];
#pragma unroll
    for (int nt = 0; nt < 4; ++nt) Bfrag[nt] = *(const bf16x8*)(p.BbT + ((size_t)lg * 128 + nt * 32 + (lane & 31)) * 16 + 8 * (lane >> 5));
    const float lr = p.lamb[(size_t)(lg * 64 + lane) * 2], li = p.lamb[(size_t)(lg * 64 + lane) * 2 + 1];
    const float nli = -li;
    float hr = 0.f, hi = 0.f;
    if (smp) { hr = p.st_s5re[(((size_t)l * 8 + b) * 64 + g) * 64 + lane]; hi = p.st_s5im[(((size_t)l * 8 + b) * 64 + g) * 64 + lane]; }
    bf16x8 a_next = *(const bf16x8*)(ubase + (size_t)(tok0 + (lane & 31)) * LDP + 8 * (lane >> 5));
    for (int blk = 0; blk <= nblk; ++blk) {
      if (blk < nblk) {
        LAS float* buf = hbuf + (blk & 1) * 4224;
        const bf16x8 a = a_next;
        if (blk + 1 < nblk) a_next = *(const bf16x8*)(ubase + (size_t)(tok0 + (blk + 1) * 32 + (lane & 31)) * LDP + 8 * (lane >> 5));
        float bre[32], bim[32];
        {
          f32x16 d[4];
#pragma unroll
          for (int nt = 0; nt < 4; ++nt) {
            f32x16 z = {0.f, 0.f, 0.f, 0.f, 0.f, 0.f, 0.f, 0.f, 0.f, 0.f, 0.f, 0.f, 0.f, 0.f, 0.f, 0.f};
            d[nt] = __builtin_amdgcn_mfma_f32_32x32x16_bf16(a, Bfrag[nt], z, 0, 0, 0);
          }
#pragma unroll
          for (int r = 0; r < 16; ++r) {
            const int tA = (r & 3) + 8 * (r >> 2);
            const auto sr = __builtin_amdgcn_permlane32_swap(__float_as_uint(d[0][r]), __float_as_uint(d[1][r]), false, false);
            bre[tA] = __uint_as_float(sr[0]); bre[tA + 4] = __uint_as_float(sr[1]);
            const auto si = __builtin_amdgcn_permlane32_swap(__float_as_uint(d[2][r]), __float_as_uint(d[3][r]), false, false);
            bim[tA] = __uint_as_float(si[0]); bim[tA + 4] = __uint_as_float(si[1]);
          }
        }
#pragma unroll
        for (int t = 0; t < 32; ++t) {
          float nr = fma_asm(lr, hr, bre[t]); nr = fma_asm(nli, hi, nr);
          float ni = fma_asm(lr, hi, bim[t]); ni = fma_asm(li, hr, ni);
          hr = nr; hi = ni;
          buf[t * 132 + lane] = hr; buf[t * 132 + 64 + lane] = hi;
        }
      }
      LDS_BARRIER();
    }
    p.out[(smp ? O_S5RES : O_S5REP) + (((size_t)l * NB + b) * 64 + g) * 64 + lane] = hr;
    p.out[(smp ? O_S5IMS : O_S5IMP) + (((size_t)l * NB + b) * 64 + g) * 64 + lane] = hi;
  } else {
    bf16x8 Cfrag[4];
#pragma unroll
    for (int ks = 0; ks < 4; ++ks) Cfrag[ks] = *(const bf16x8*)(p.CmT + ((size_t)lg * 16 + fr) * 128 + ks * 32 + fq * 8);
    const f32x4 d4 = *(const f32x4*)(p.d_s5 + l * 1024 + g * 16 + fq * 4);
    for (int blk = 0; blk <= nblk; ++blk) {
      if (blk >= 1) {
        const int pb = blk - 1;
        const LAS float* buf = hbuf + (pb & 1) * 4224;
        u32x2 u4v[2];
#pragma unroll
        for (int mt = 0; mt < 2; ++mt) u4v[mt] = *(const u32x2*)(ubase + (size_t)(tok0 + pb * 32 + mt * 16 + fr) * LDP + fq * 4);
#pragma unroll
        for (int mt = 0; mt < 2; ++mt) {
          f32x4 acc = (f32x4){0.f, 0.f, 0.f, 0.f};
#pragma unroll
          for (int ks = 0; ks < 4; ++ks) {
            const LAS float* hp = buf + (mt * 16 + fr) * 132 + ks * 32 + fq * 8;
            const f32x4 h0 = *(const LAS f32x4*)hp, h1 = *(const LAS f32x4*)(hp + 4);
            u32x4 hw = (u32x4){pk2(h0[0], h0[1]), pk2(h0[2], h0[3]), pk2(h1[0], h1[1]), pk2(h1[2], h1[3])};
            bf16x8 hf = __builtin_bit_cast(bf16x8, hw);
            acc = mfma16(Cfrag[ks], hf, acc);
          }
          const size_t trow = (size_t)(tok0 + pb * 32 + mt * 16 + fr);
          const u32x2 u4 = u4v[mt];
          const float y0 = gelu_tanh(acc[0] + d4[0] * lo_f(u4.x));
          const float y1 = gelu_tanh(acc[1] + d4[1] * hi_f(u4.x));
          const float y2 = gelu_tanh(acc[2] + d4[2] * lo_f(u4.y));
          const float y3 = gelu_tanh(acc[3] + d4[3] * hi_f(u4.y));
          *(u32x2*)(p.xb + trow * 1024 + g * 16 + fq * 4) = (u32x2){pk2(y0, y1), pk2(y2, y3)};
        }
      }
      LDS_BARRIER();
    }
  }
}

__device__ void phase_mixer(LAS unsigned char* lds, const Params& p, int l) {
  const int wid = otid() >> 6;
  for (int u = blockIdx.x; u < 768; u += gridDim.x) {
    if (u < 256) {
      const int x = u & 7, j = u >> 3, G = x * 8 + (j >> 2);
      ssd_item(lds, p, l, G >> 2, (G & 3) * 4 + (j & 3), false);
    }
    else if (u < 512) { const int seq = (u - 256) * 4 + (wid & 3); s5_seq(lds, p, l, seq >> 6, seq & 63, false); }
    else if (u < 640) {
      const int v = u - 512, x = v & 7, j = v >> 3, G = x * 4 + (j >> 2);
      ssd_item(lds, p, l, G >> 2, (G & 3) * 4 + (j & 3), true);
    }
    else { const int seq = (u - 640) * 4 + (wid & 3); s5_seq(lds, p, l, seq >> 6, seq & 63, true); }
    __syncthreads();
  }
}

__device__ void norm_unit(const Params& p, int nu) {
  const int tid = otid();
  const int tok = nu * 32 + (tid >> 4), hh = tid & 15, gg = hh >> 2;
  const f32x4 s4 = *(const f32x4*)(p.ssqa + (size_t)tok * 16 + gg * 4);
  const float rs = rsqrtf((s4[0] + s4[1] + s4[2] + s4[3]) * (1.f / 256.f) + 1e-6f);
  bf16_t* q = p.proj + (size_t)tok * LDP + C_ZA + hh * 64;
#pragma unroll
  for (int i = 0; i < 8; ++i) {
    u32x4 v = *(u32x4*)(q + i * 8);
#pragma unroll
    for (int k = 0; k < 4; ++k) v[k] = pk2(lo_f(v[k]) * rs, hi_f(v[k]) * rs);
    *(u32x4*)(q + i * 8) = v;
  }
}

__device__ void final_unit(const Params& p, int unit) {
  const int tid_ = otid(); const int wid = tid_ >> 6, lane = tid_ & 63;
  const int row = unit * 8 + wid;
  const f32x4* sp = (const f32x4*)(p.sumsq + ((size_t)4 * T_TOK + row) * 16);
  const f32x4 s0 = sp[0], s1 = sp[1], s2 = sp[2], s3 = sp[3];
  const float ss = ((s0[0] + s0[1]) + (s0[2] + s0[3])) + ((s1[0] + s1[1]) + (s1[2] + s1[3])) +
                   ((s2[0] + s2[1]) + (s2[2] + s2[3])) + ((s3[0] + s3[1]) + (s3[2] + s3[3]));
  const float rs = rsqrtf(ss * (1.f / 1024.f) + 1e-6f);
  float* xr = p.out + (size_t)row * 1024;
#pragma unroll
  for (int i = 0; i < 4; ++i) {
    const int c = i * 256 + lane * 4;
    const f32x4 v = *(const f32x4*)(xr + c);
    const f32x4 gv = *(const f32x4*)(p.final_g + c);
    *(f32x4*)(xr + c) = v * rs * gv;
  }
}

__device__ __forceinline__ void grid_barrier(cg::grid_group& grid, unsigned* ctr, unsigned target) {
  asm volatile("s_waitcnt vmcnt(0) lgkmcnt(0)" ::: "memory");
  __syncthreads();
  if (target == gridDim.x) grid.sync();
  if (threadIdx.x == 0) {
    __builtin_amdgcn_fence(__ATOMIC_RELEASE, "agent");
    asm volatile("s_waitcnt vmcnt(0)" ::: "memory");
    __hip_atomic_fetch_add(ctr, 1u, __ATOMIC_RELAXED, __HIP_MEMORY_SCOPE_AGENT);
    while (__hip_atomic_load(ctr, __ATOMIC_RELAXED, __HIP_MEMORY_SCOPE_AGENT) < target) __builtin_amdgcn_s_sleep(1);
    __builtin_amdgcn_fence(__ATOMIC_ACQUIRE, "agent");
    asm volatile("s_waitcnt vmcnt(0)" ::: "memory");
  }
  __syncthreads();
}

__global__ void __launch_bounds__(NTHREADS) mega(Params p) {
  __shared__ __attribute__((aligned(1024))) unsigned char shm[LDS_BYTES];
  LAS unsigned char* lds = (LAS unsigned char*)shm;
  cg::grid_group grid = cg::this_grid();
  unsigned nbar = 0;
  phase_prep(lds, p);
  grid_barrier(grid, p.bar, (++nbar) * gridDim.x);
  for (int ph = 1; ph < p.phase_end; ++ph) {
    if (ph == 17) {
      for (int u = blockIdx.x; u < 4160; u += gridDim.x) final_unit(p, u);
    } else {
      const int l = (ph - 1) >> 2, sub = (ph - 1) & 3;
      if (sub == 0) {
        g8::EpiIn8 e{p.proj, p.sumsq + (size_t)l * T_TOK * 16};
        g8::Order S{NMT * 21, 21, 0, 0};
        g8::gemm_phase8(lds, p.xb, 1024, 1 << 30, 0, p.WinT + (size_t)l * 5376 * 1024, 1024, 1024, S, e);
      } else if (sub == 1) {
        phase_mixer(lds, p, l);
      } else if (sub == 2) {
        g8::EpiGlu8 e{p.proj, p.b_glu + l * 1024, p.xb};
        g8::Order S{NMT * 4, 4, 0, 0};
        g8::gemm_phase8(lds, p.xb, 1024, 1 << 30, 0, p.WgluT + (size_t)l * 1024 * 1024, 1024, 1024, S, e);
        for (int u = gridDim.x - 1 - blockIdx.x; u < 1040; u += gridDim.x) norm_unit(p, u);
      } else {
        g8::EpiOut8 e{l == 0 ? p.x_prompt : p.out, l == 0 ? p.x_sample : (p.out + (size_t)TP * 1024), p.out,
                      l == 3 ? (bf16_t*)nullptr : p.xb, p.sumsq + (size_t)(l + 1) * T_TOK * 16};
        g8::Order S{512, 4, 0, 0};
        g8::gemm_phase8(lds, p.proj, LDP, 16, 3072, p.WoutT + (size_t)l * 1024 * 2048, 2048, 2048, S, e);
#pragma unroll 1
        for (int q = 0; q < 4; ++q) {
          const int kt0 = q * 8;
          g8::Order Sq{0, 4, 1, q};
          g8::EpiPart8 ep{p.part + (size_t)q * 512 * 1024};
          g8::gemm_phase8(lds, p.proj + kt0 * 64 + (kt0 >= 16 ? 3072 : 0), LDP, 1 << 30, 0, p.WoutT + (size_t)l * 1024 * 2048 + kt0 * 64, 2048, 512, Sq, ep);
        }
        grid_barrier(grid, p.bar, (++nbar) * gridDim.x);
        {
          const int tid_ = otid(); const int wid = tid_ >> 6, lane = tid_ & 63;
          for (int r = blockIdx.x * 8 + wid; r < 512; r += gridDim.x * 8) {
            const int row = TP + r;
            const float* xr = (l == 0) ? (p.x_sample + (size_t)r * 1024) : (p.out + (size_t)row * 1024);
            float ssum = 0.f;
#pragma unroll
            for (int i = 0; i < 4; ++i) {
              const int c = i * 256 + lane * 4;
              f32x4 v = *(const f32x4*)(xr + c);
#pragma unroll
              for (int q = 0; q < 4; ++q) v += *(const f32x4*)(p.part + ((size_t)q * 512 + r) * 1024 + c);
              *(f32x4*)(p.out + (size_t)row * 1024 + c) = v;
              if (l < 3) { u32x2 o; o.x = pk2(v[0], v[1]); o.y = pk2(v[2], v[3]); *(u32x2*)(p.xb + (size_t)row * 1024 + c) = o; }
              ssum += v[0] * v[0] + v[1] * v[1] + v[2] * v[2] + v[3] * v[3];
            }
#pragma unroll
            for (int o = 32; o >= 1; o >>= 1) ssum += __shfl_xor(ssum, o);
            if (lane < 16) p.sumsq[((size_t)(l + 1) * T_TOK + row) * 16 + lane] = (lane == 0) ? ssum : 0.f;
          }
        }
      }
    }
    if (ph + 1 < p.phase_end) grid_barrier(grid, p.bar, (++nbar) * gridDim.x);
  }
}

extern "C" void kernel_launch(void* const* d_in, const int* in_sizes, int n_in, void* d_out, int out_size, void* d_ws, size_t ws_size,
                              hipStream_t stream) {
  static int grid_blocks = 0;
  if (!grid_blocks) {
    int dev = 0, cus = 0, per_cu = 0;
    hipGetDevice(&dev);
    hipDeviceGetAttribute(&cus, hipDeviceAttributeMultiprocessorCount, dev);
    hipOccupancyMaxActiveBlocksPerMultiprocessor(&per_cu, mega, NTHREADS, 0);
    if (per_cu < 1) per_cu = 1;
    if (per_cu > 1) per_cu = 1;
    grid_blocks = cus * per_cu;
  }
  Params p{};
  const float* const* in = (const float* const*)d_in;
  p.x_prompt = in[0]; p.x_sample = in[1]; p.st_conv = in[2]; p.st_ssd = in[3]; p.st_s5re = in[4]; p.st_s5im = in[5];
  p.norm_g = in[6]; p.w_in = in[7]; p.conv_w = in[8]; p.conv_b = in[9]; p.dt_bias = in[10]; p.a_log = in[11]; p.d_ssd = in[12];
  p.ssd_norm_g = in[13]; p.lam_re = in[14]; p.lam_im = in[15]; p.log_dt = in[16]; p.b_re = in[17]; p.b_im = in[18];
  p.c_re = in[19]; p.c_im = in[20]; p.d_s5 = in[21]; p.w_glu = in[22]; p.b_glu = in[23]; p.w_out = in[24]; p.final_g = in[25];
  p.out = (float*)d_out;
  unsigned char* ws = (unsigned char*)d_ws;
  size_t off = 0;
  auto take = [&](size_t bytes) { unsigned char* r = ws + off; off += (bytes + 1023) & ~(size_t)1023; return r; };
  p.xb = (bf16_t*)take((size_t)T_TOK * 1024 * 2);
  p.proj = (bf16_t*)take((size_t)T_TOK * LDP * 2);
  p.WinT = (bf16_t*)take((size_t)4 * 5376 * 1024 * 2);
  p.WgluT = (bf16_t*)take((size_t)4 * 1024 * 1024 * 2);
  p.WoutT = (bf16_t*)take((size_t)4 * 1024 * 2048 * 2);
  p.BbT = (bf16_t*)take((size_t)256 * 2048 * 2);
  p.CmT = (bf16_t*)take((size_t)256 * 2048 * 2);
  p.sumsq = (float*)take((size_t)5 * T_TOK * 16 * 4);
  p.ssqa = (float*)take((size_t)T_TOK * 16 * 4);
  p.lamb = (float*)take((size_t)256 * 64 * 2 * 4);
  p.part = (float*)take((size_t)4 * 512 * 1024 * 4);
  p.bar = (unsigned*)take(1024);
  hipMemsetAsync(p.bar, 0, 1024, stream);
  if (off > ws_size) { fprintf(stderr, "workspace too small: need %zu have %zu\n", off, ws_size); return; }
  p.phase_begin = 0; p.phase_end = 18;
  void* args[] = {&p};
  hipError_t e = hipLaunchCooperativeKernel((void*)mega, dim3(grid_blocks), dim3(NTHREADS), args, 0, stream);
  if (e != hipSuccess) fprintf(stderr, "cooperative launch failed: %s (grid %d)\n", hipGetErrorString(e), grid_blocks);
}
```

```cpp
#include <hip/hip_runtime.h>
#include <hip/hip_cooperative_groups.h>
#include <cstdio>
namespace cg = cooperative_groups;

#define LAS __attribute__((address_space(3)))
typedef unsigned short bf16_t;
typedef short bf16x8 __attribute__((ext_vector_type(8)));
typedef float f32x4 __attribute__((ext_vector_type(4)));
typedef float f32x16 __attribute__((ext_vector_type(16)));
typedef unsigned u32x4 __attribute__((ext_vector_type(4)));
typedef unsigned u32x2 __attribute__((ext_vector_type(2)));

constexpr int T_TOK = 33280, TP = 32768, NMT = 130;
constexpr int LDP = 5376;
constexpr int C_ZA = 0, C_XBC = 1024, C_U = 3072, C_ZB = 4096, C_DT = 5120;
constexpr int NTHREADS = 512;
constexpr int LDS_BYTES = 139264;

constexpr size_t O_Y = 0, O_CONVP = 34078720, O_SSDP = 34471936, O_S5REP = 42860544, O_S5IMP = 43122688,
                 O_CONVS = 43384832, O_SSDS = 43581440, O_S5RES = 47775744, O_S5IMS = 47906816;

struct Params {
  const float *x_prompt, *x_sample, *st_conv, *st_ssd, *st_s5re, *st_s5im;
  const float *norm_g, *w_in, *conv_w, *conv_b, *dt_bias, *a_log, *d_ssd, *ssd_norm_g;
  const float *lam_re, *lam_im, *log_dt, *b_re, *b_im, *c_re, *c_im, *d_s5, *w_glu, *b_glu, *w_out, *final_g;
  float* out;
  bf16_t *xb, *proj, *WinT, *WgluT, *WoutT, *BbT, *CmT;
  float *sumsq, *ssqa, *lamb, *part;
  unsigned* bar;
  int phase_begin, phase_end;
};

__device__ __forceinline__ float bf2f(unsigned short v) { return __uint_as_float(((unsigned)v) << 16); }
__device__ __forceinline__ float lo_f(unsigned w) { return __uint_as_float(w << 16); }
__device__ __forceinline__ float hi_f(unsigned w) { return __uint_as_float(w & 0xffff0000u); }
__device__ __forceinline__ unsigned pk2(float lo, float hi) { unsigned r; asm("v_cvt_pk_bf16_f32 %0, %1, %2" : "=v"(r) : "v"(lo), "v"(hi)); return r; }
__device__ __forceinline__ float sigm(float x) { return __builtin_amdgcn_rcpf(1.f + __expf(-x)); }
__device__ __forceinline__ float siluf(float x) { return x * sigm(x); }
__device__ __forceinline__ float gelu_tanh(float x) { const float z = 0.7978845608028654f * (x + 0.044715f * x * x * x); return x * sigm(2.f * z); }
__device__ __forceinline__ f32x4 mfma16(bf16x8 a, bf16x8 b, f32x4 c) { return __builtin_amdgcn_mfma_f32_16x16x32_bf16(a, b, c, 0, 0, 0); }
#define WAIT_V0() asm volatile("s_waitcnt vmcnt(0)" ::: "memory")
#define LDS_BARRIER() asm volatile("s_waitcnt lgkmcnt(0)\n\ts_barrier" ::: "memory")
__device__ __forceinline__ int otid() { int t = threadIdx.x; asm volatile("" : "+v"(t)); return t; }

__device__ __forceinline__ void stage_rc(int b, int& R, int& C) {
  const int st = b >> 10, sb = b & 1023, swz = sb ^ (((sb >> 9) & 1) << 5);
  R = (st >> 1) * 16 + swz / 64;
  C = (st & 1) * 32 + (swz % 64) / 2;
}

__device__ __forceinline__ int xcd_remap(int u) {
  const int G = gridDim.x, i = u / G, blk = u % G, per = G >> 3;
  if (G & 7) return u;
  return (i * 8 + (blk & 7)) * per + (blk >> 3);
}
__device__ __forceinline__ void tile_map(int u, int nN, int& pm, int& pn) {
  const int nig = 8 * nN, gid = u / nig, fm = gid * 8, rem = u % nig;
  const int gsz = (NMT - fm) < 8 ? (NMT - fm) : 8;
  pm = fm + rem % gsz; pn = rem / gsz;
}

namespace g8 {
constexpr int HTB = 128 * 64 * 2;
__device__ __forceinline__ int lds_byte(int r, int c) { const int st = (r >> 4) * 2 + (c >> 5), rr = r & 15, cc = c & 31, ob = rr * 64 + cc * 2; return st * 1024 + (ob ^ (((ob >> 9) & 1) << 5)); }
struct Unit { int pm, pn; };
struct Order {
  int ntiles, nN, mode, q;
  __device__ __forceinline__ bool next(int i, Unit& u) const {
    if (mode == 1) {
      if (i != 0 || (int)blockIdx.x >= 32 || ((int)blockIdx.x >> 3) != q) return false;
      tile_map(512 + ((int)blockIdx.x & 7), 4, u.pm, u.pn); return true;
    }
    const int w = xcd_remap((int)blockIdx.x + i * (int)gridDim.x);
    if (w >= ntiles) return false;
    tile_map(w, nN, u.pm, u.pn); return true;
  }
};
__device__ __forceinline__ int perm32(int rho) { const int n = rho >> 4, i = rho & 15; return 8 * (i >> 2) + 4 * n + (i & 3); }
struct EpiIn8 {
  static constexpr bool PERM = true;
  bf16_t* proj; const float* sumsq;
  __device__ __forceinline__ void operator()(const f32x4 (&acc)[2][2][4][2], const Unit& u, int wr, int wc, int fr, int fq) const {
    const int row0 = u.pm * 256 + wr * 64 + fr, col0 = u.pn * 256 + wc * 32 + fq * 8;
#pragma unroll
    for (int ai = 0; ai < 2; ++ai)
#pragma unroll
      for (int m = 0; m < 4; ++m) {
        asm volatile("" ::: "memory");
        const int row = row0 + ai * 128 + m * 16;
        const f32x4* sp = (const f32x4*)(sumsq + (size_t)row * 16);
        const f32x4 s0 = sp[0], s1 = sp[1], s2 = sp[2], s3 = sp[3];
        const float ss = ((s0[0] + s0[1]) + (s0[2] + s0[3])) + ((s1[0] + s1[1]) + (s1[2] + s1[3])) +
                         ((s2[0] + s2[1]) + (s2[2] + s2[3])) + ((s3[0] + s3[1]) + (s3[2] + s3[3]));
        const float rs = rsqrtf(ss * (1.f / 1024.f) + 1e-6f);
        bf16_t* rp = proj + (size_t)row * LDP + col0;
#pragma unroll
        for (int bj = 0; bj < 2; ++bj) {
          const f32x4 v0 = acc[ai][bj][m][0] * rs, v1 = acc[ai][bj][m][1] * rs;
          *(u32x4*)(rp + bj * 128) = (u32x4){pk2(v0[0], v0[1]), pk2(v0[2], v0[3]), pk2(v1[0], v1[1]), pk2(v1[2], v1[3])};
        }
      }
  }
};
struct EpiGlu8 {
  static constexpr bool PERM = true;
  bf16_t* proj; const float* bglu; const bf16_t* ys;
  __device__ __forceinline__ void operator()(const f32x4 (&acc)[2][2][4][2], const Unit& u, int wr, int wc, int fr, int fq) const {
    const int row0 = u.pm * 256 + wr * 64 + fr, col0 = u.pn * 256 + wc * 32 + fq * 8;
#pragma unroll
    for (int ai = 0; ai < 2; ++ai)
#pragma unroll
      for (int m = 0; m < 4; ++m) {
        asm volatile("" ::: "memory");
        const int row = row0 + ai * 128 + m * 16;
        bf16_t* base = proj + (size_t)row * LDP;
#pragma unroll
        for (int bj = 0; bj < 2; ++bj) {
          const int col = col0 + bj * 128;
          const f32x4 g0 = acc[ai][bj][m][0] + *(const f32x4*)(bglu + col), g1 = acc[ai][bj][m][1] + *(const f32x4*)(bglu + col + 4);
          const u32x4 a = *(const u32x4*)(ys + (size_t)row * 1024 + col);
          const u32x4 z = *(const u32x4*)(base + C_ZB + col);
          u32x4 o;
          o[0] = pk2(lo_f(a[0]) * sigm(g0[0]) * siluf(lo_f(z[0])), hi_f(a[0]) * sigm(g0[1]) * siluf(hi_f(z[0])));
          o[1] = pk2(lo_f(a[1]) * sigm(g0[2]) * siluf(lo_f(z[1])), hi_f(a[1]) * sigm(g0[3]) * siluf(hi_f(z[1])));
          o[2] = pk2(lo_f(a[2]) * sigm(g1[0]) * siluf(lo_f(z[2])), hi_f(a[2]) * sigm(g1[1]) * siluf(hi_f(z[2])));
          o[3] = pk2(lo_f(a[3]) * sigm(g1[2]) * siluf(lo_f(z[3])), hi_f(a[3]) * sigm(g1[3]) * siluf(hi_f(z[3])));
          *(u32x4*)(base + C_ZB + col) = o;
        }
      }
  }
};
struct EpiOut8 {
  static constexpr bool PERM = true;
  const float *xin_p, *xin_s; float* xout; bf16_t* xb; float* ssq_next;
  __device__ __forceinline__ void operator()(const f32x4 (&acc)[2][2][4][2], const Unit& u, int wr, int wc, int fr, int fq) const {
    const int row0 = u.pm * 256 + wr * 64 + fr, col0 = u.pn * 256 + wc * 32 + fq * 8;
#pragma unroll
    for (int ai = 0; ai < 2; ++ai)
#pragma unroll
      for (int m = 0; m < 4; ++m) {
        asm volatile("" ::: "memory");
        const int row = row0 + ai * 128 + m * 16;
        const float* xr = (row < TP) ? (xin_p + (size_t)row * 1024) : (xin_s + (size_t)(row - TP) * 1024);
        float s = 0.f;
#pragma unroll
        for (int bj = 0; bj < 2; ++bj) {
          const int col = col0 + bj * 128;
          const f32x4 v0 = acc[ai][bj][m][0] + *(const f32x4*)(xr + col), v1 = acc[ai][bj][m][1] + *(const f32x4*)(xr + col + 4);
          *(f32x4*)(xout + (size_t)row * 1024 + col) = v0;
          *(f32x4*)(xout + (size_t)row * 1024 + col + 4) = v1;
          if (xb) *(u32x4*)(xb + (size_t)row * 1024 + col) = (u32x4){pk2(v0[0], v0[1]), pk2(v0[2], v0[3]), pk2(v1[0], v1[1]), pk2(v1[2], v1[3])};
          s += v0[0] * v0[0] + v0[1] * v0[1] + v0[2] * v0[2] + v0[3] * v0[3] + v1[0] * v1[0] + v1[1] * v1[1] + v1[2] * v1[2] + v1[3] * v1[3];
        }
        s += __shfl_xor(s, 16); s += __shfl_xor(s, 32);
        if (fq == 0) ssq_next[(size_t)row * 16 + u.pn * 4 + wc] = s;
      }
  }
};

struct EpiPart8 {
  static constexpr bool PERM = true;
  float* part;
  __device__ __forceinline__ void operator()(const f32x4 (&acc)[2][2][4][2], const Unit& u, int wr, int wc, int fr, int fq) const {
    const int row0 = u.pm * 256 + wr * 64 + fr - TP, col0 = u.pn * 256 + wc * 32 + fq * 8;
#pragma unroll
    for (int ai = 0; ai < 2; ++ai)
#pragma unroll
      for (int m = 0; m < 4; ++m)
#pragma unroll
        for (int bj = 0; bj < 2; ++bj) {
          float* q0 = part + (size_t)(row0 + ai * 128 + m * 16) * 1024 + col0 + bj * 128;
          *(f32x4*)q0 = acc[ai][bj][m][0]; *(f32x4*)(q0 + 4) = acc[ai][bj][m][1];
        }
  }
};

template <class Epi>
__device__ __forceinline__ void gemm_phase8(LAS unsigned char* lds, const bf16_t* A, int lda, int segkt, int segoff, const bf16_t* Bt, int ldb, int K,
                                            const Order& S, const Epi& E) {
  const int tid = otid(), wid = __builtin_amdgcn_readfirstlane(tid >> 6), lane = tid & 63, wr = wid >> 2, wc = wid & 3, fr = lane & 15, fq = lane >> 4;
  const int nt = K / 64;
  unsigned voffA[2], voffB[2];
#pragma unroll
  for (int i = 0; i < 2; ++i) { int R, C; stage_rc(tid * 16 + i * 8192, R, C); const int Rb = Epi::PERM ? ((R & ~31) + perm32(R & 31)) : R;
    voffA[i] = (unsigned)(R * lda + C) * 2u; voffB[i] = (unsigned)(Rb * ldb + C) * 2u; }
  const size_t kstep = 128;
  const size_t hstepA = (size_t)128 * lda * 2, tstepA = 2 * hstepA;
  const size_t hstepB = (size_t)128 * ldb * 2, tstepB = 2 * hstepB;
  const size_t segB = (size_t)segoff * 2;
#define G8_AK(kt) ((size_t)(kt) * 128 + (((kt) >= segkt) ? segB : (size_t)0))
  const unsigned ldsw = (unsigned)wid * 1024u;
  const int aoff = lds_byte(wr * 64 + fr, fq * 8), boff = lds_byte(wc * 32 + fr, fq * 8);
#define G8_SA(b, h) (((b) * 2 + (h)) * HTB)
#define G8_SB(b, h) ((4 + (b) * 2 + (h)) * HTB)
#define G8_STAGE(bufoff, gbase, voff) do { _Pragma("unroll") for (int _i = 0; _i < 2; ++_i) \
    __builtin_amdgcn_global_load_lds((const unsigned*)((const char*)(gbase) + (voff)[_i]), (LAS unsigned*)(lds + (bufoff) + ldsw + _i * 8192), 16, 0, 0); } while (0)
#define G8_LDA(dst, b, h) do { _Pragma("unroll") for (int m = 0; m < 4; ++m) _Pragma("unroll") for (int k = 0; k < 2; ++k) dst[m][k] = *(const LAS bf16x8*)(lds + G8_SA(b, h) + aoff + m * 2048 + k * 1024); } while (0)
#define G8_LDB(dst, b, h) do { _Pragma("unroll") for (int n = 0; n < 2; ++n) _Pragma("unroll") for (int k = 0; k < 2; ++k) dst[n][k] = *(const LAS bf16x8*)(lds + G8_SB(b, h) + boff + n * 2048 + k * 1024); } while (0)
#define G8_MMA(ai, bj, At, Bt_) do { __builtin_amdgcn_s_setprio(1); _Pragma("unroll") for (int m = 0; m < 4; ++m) _Pragma("unroll") for (int n = 0; n < 2; ++n) _Pragma("unroll") for (int k = 0; k < 2; ++k) \
    acc[ai][bj][m][n] = __builtin_amdgcn_mfma_f32_16x16x32_bf16(Bt_[n][k], At[m][k], acc[ai][bj][m][n], 0, 0, 0); __builtin_amdgcn_s_setprio(0); } while (0)
#define G8_WAIT_V(n) asm volatile("s_waitcnt vmcnt(" #n ")" ::: "memory")
#define G8_WAIT_L(n) asm volatile("s_waitcnt lgkmcnt(" #n ")" ::: "memory")
#define G8_BAR __builtin_amdgcn_s_barrier()
#define G8_SCHED __builtin_amdgcn_sched_barrier(0)
  Unit cur, nxt; int ui = 0;
  if (!S.next(0, cur)) return;
  f32x4 acc[2][2][4][2];
#pragma unroll
  for (int a = 0; a < 2; ++a)
#pragma unroll
    for (int b = 0; b < 2; ++b)
#pragma unroll
      for (int m = 0; m < 4; ++m)
#pragma unroll
        for (int n = 0; n < 2; ++n) acc[a][b][m][n] = (f32x4){0.f, 0.f, 0.f, 0.f};
  bf16x8 At[4][2], B0[2][2], B1[2][2];
  const char* cA = (const char*)A + (size_t)cur.pm * tstepA; const char* cB = (const char*)Bt + (size_t)cur.pn * tstepB;
  G8_STAGE(G8_SB(0, 0), cB, voffB); G8_STAGE(G8_SA(0, 0), cA, voffA); G8_STAGE(G8_SB(0, 1), cB + hstepB, voffB); G8_STAGE(G8_SA(0, 1), cA + hstepA, voffA);
  if (wr == 1) G8_BAR;
  G8_WAIT_V(4); G8_BAR;
  G8_STAGE(G8_SB(1, 0), cB + kstep, voffB); G8_STAGE(G8_SA(1, 0), cA + G8_AK(1), voffA); G8_STAGE(G8_SB(1, 1), cB + hstepB + kstep, voffB);
  G8_WAIT_V(6); G8_BAR;
  for (;;) {
    const bool has_next = S.next(ui + 1, nxt);
    const char* nA = has_next ? (const char*)A + (size_t)nxt.pm * tstepA : cA; const char* nB = has_next ? (const char*)Bt + (size_t)nxt.pn * tstepB : cB;
    for (int t = 0; t < nt; t += 2) {
      const bool last = (t == nt - 2);
      const char* a1 = cA + G8_AK(t + 1);
      const char* a2 = last ? nA : cA + G8_AK(t + 2); const char* b2 = last ? nB : cB + (size_t)(t + 2) * kstep;
      const char* a3 = last ? nA + G8_AK(1) : cA + G8_AK(t + 3); const char* b3 = b2 + kstep;
      G8_LDB(B0, 0, 0); G8_SCHED; G8_LDA(At, 0, 0); G8_STAGE(G8_SA(1, 1), a1 + hstepA, voffA);
      G8_WAIT_L(8); G8_BAR; G8_WAIT_L(0); G8_MMA(0, 0, At, B0); G8_BAR; G8_SCHED;
      G8_LDB(B1, 0, 1); G8_STAGE(G8_SB(0, 0), b2, voffB);
      G8_BAR; G8_WAIT_L(0); G8_MMA(0, 1, At, B1); G8_BAR;
      G8_LDA(At, 0, 1); G8_STAGE(G8_SA(0, 0), a2, voffA);
      G8_BAR; G8_WAIT_L(0); G8_MMA(1, 0, At, B0); G8_BAR; G8_SCHED;
      G8_STAGE(G8_SB(0, 1), b2 + hstepB, voffB);
      G8_WAIT_V(6); G8_BAR; G8_MMA(1, 1, At, B1); G8_BAR;
      G8_LDB(B0, 1, 0); G8_SCHED; G8_LDA(At, 1, 0); G8_STAGE(G8_SA(0, 1), a2 + hstepA, voffA);
      G8_WAIT_L(8); G8_BAR; G8_WAIT_L(0); G8_MMA(0, 0, At, B0); G8_BAR; G8_SCHED;
      G8_LDB(B1, 1, 1); G8_STAGE(G8_SB(1, 0), b3, voffB);
      G8_BAR; G8_WAIT_L(0); G8_MMA(0, 1, At, B1); G8_BAR;
      G8_LDA(At, 1, 1); G8_STAGE(G8_SA(1, 0), a3, voffA);
      G8_BAR; G8_WAIT_L(0); G8_MMA(1, 0, At, B0); G8_BAR; G8_SCHED;
      G8_STAGE(G8_SB(1, 1), b3 + hstepB, voffB);
      G8_WAIT_V(6); G8_BAR; G8_MMA(1, 1, At, B1); G8_BAR;
    }
    E(acc, cur, wr, wc, fr, fq);
    if (!has_next) break;
#pragma unroll
    for (int a = 0; a < 2; ++a)
#pragma unroll
      for (int b = 0; b < 2; ++b)
#pragma unroll
        for (int m = 0; m < 4; ++m)
#pragma unroll
          for (int n = 0; n < 2; ++n) acc[a][b][m][n] = (f32x4){0.f, 0.f, 0.f, 0.f};
    cur = nxt; cA = nA; cB = nB; ++ui;
  }
  G8_WAIT_V(0);
  if (wr == 0) G8_BAR;
  G8_BAR;
#undef G8_AK
#undef G8_SA
#undef G8_SB
#undef G8_STAGE
#undef G8_LDA
#undef G8_LDB
#undef G8_MMA
#undef G8_WAIT_V
#undef G8_WAIT_L
#undef G8_BAR
#undef G8_SCHED
}
}

__device__ void xrow_unit(const Params& p, int unit) {
  const int tid_ = otid(); const int wid = tid_ >> 6, lane = tid_ & 63;
  f32x4 v[2][4];
#pragma unroll
  for (int r = 0; r < 2; ++r) {
    const int row = unit * 16 + r * 8 + wid;
    const float* src = (row < TP) ? (p.x_prompt + (size_t)row * 1024) : (p.x_sample + (size_t)(row - TP) * 1024);
#pragma unroll
    for (int i = 0; i < 2; ++i) { v[r][2 * i] = *(const f32x4*)(src + i * 512 + lane * 8); v[r][2 * i + 1] = *(const f32x4*)(src + i * 512 + lane * 8 + 4); }
  }
#pragma unroll
  for (int r = 0; r < 2; ++r) {
    const int row = unit * 16 + r * 8 + wid;
    float s = 0.f;
#pragma unroll
    for (int i = 0; i < 2; ++i) {
      const f32x4 x0 = v[r][2 * i], x1 = v[r][2 * i + 1];
      s += x0[0] * x0[0] + x0[1] * x0[1] + x0[2] * x0[2] + x0[3] * x0[3] + x1[0] * x1[0] + x1[1] * x1[1] + x1[2] * x1[2] + x1[3] * x1[3];
      *(u32x4*)(p.xb + (size_t)row * 1024 + i * 512 + lane * 8) = (u32x4){pk2(x0[0], x0[1]), pk2(x0[2], x0[3]), pk2(x1[0], x1[1]), pk2(x1[2], x1[3])};
    }
#pragma unroll
    for (int o = 32; o >= 1; o >>= 1) s += __shfl_xor(s, o);
    if (lane < 16) p.sumsq[(size_t)row * 16 + lane] = (lane == 0) ? s : 0.f;
  }
}

__device__ void transpose_unit(LAS unsigned char* lds, const float* src, int ldsrc, const float* scale, int nscale,
                               bf16_t* dst, int ldd, int kt, int ntile, int mode) {
  LAS float* tl = (LAS float*)lds;
  const int tid = otid();
  const int k0 = kt * 64, n0 = ntile * 64;
  f32x4 v[2];
#pragma unroll
  for (int i = 0; i < 2; ++i) {
    const int idx = tid + i * 512, kk = idx >> 4, n4 = (idx & 15) * 4;
    const int np = n0 + n4;
    int sc = np;
    if (mode == 0) { sc = (np < 3072) ? np : (np < 5120) ? (np + 16) : (np < 5136) ? (np - 5120 + 3072) : -1; }
    f32x4 x = (f32x4){0.f, 0.f, 0.f, 0.f};
    if (sc >= 0) {
      x = *(const f32x4*)(src + (size_t)(k0 + kk) * ldsrc + sc);
      if (scale && (k0 + kk) < nscale) x = x * scale[k0 + kk];
    }
    v[i] = x;
  }
#pragma unroll
  for (int i = 0; i < 2; ++i) {
    const int idx = tid + i * 512, kk = idx >> 4, n4 = (idx & 15) * 4;
#pragma unroll
    for (int j = 0; j < 4; ++j) tl[kk * 65 + n4 + j] = v[i][j];
  }
  __syncthreads();
  {
    const int nn = tid >> 3, kk0 = (tid & 7) * 8;
    float t[8];
#pragma unroll
    for (int j = 0; j < 8; ++j) t[j] = tl[(kk0 + j) * 65 + nn];
    *(u32x4*)(dst + (size_t)(n0 + nn) * ldd + k0 + kk0) = (u32x4){pk2(t[0], t[1]), pk2(t[2], t[3]), pk2(t[4], t[5]), pk2(t[6], t[7])};
  }
  __syncthreads();
}

__device__ __forceinline__ double exp_d(double x) {
  const double k = rint(x * 1.4426950408889634);
  const double r = fma(-k, 0.6931471805599453, x) - k * 2.3190468138462996e-17;
  double s = 1.0 / 6227020800.0;
  s = fma(s, r, 1.0 / 479001600.0); s = fma(s, r, 1.0 / 39916800.0); s = fma(s, r, 1.0 / 3628800.0);
  s = fma(s, r, 1.0 / 362880.0); s = fma(s, r, 1.0 / 40320.0); s = fma(s, r, 1.0 / 5040.0);
  s = fma(s, r, 1.0 / 720.0); s = fma(s, r, 1.0 / 120.0); s = fma(s, r, 1.0 / 24.0);
  s = fma(s, r, 1.0 / 6.0); s = fma(s, r, 0.5); s = fma(s, r, 1.0); s = fma(s, r, 1.0);
  return ldexp(s, (int)k);
}
__device__ __forceinline__ void sincos_d(double x, double& sn, double& cs) {
  const double k = rint(x * 0.6366197723675814);
  double r = fma(-k, 1.5707963267948966, x); r = fma(-k, 6.123233995736766e-17, r);
  const int q = ((int)k) & 3;
  const double r2 = r * r;
  double sp = 1.0 / 1307674368000.0;
  sp = fma(sp, r2, -1.0 / 6227020800.0); sp = fma(sp, r2, 1.0 / 39916800.0); sp = fma(sp, r2, -1.0 / 362880.0);
  sp = fma(sp, r2, 1.0 / 5040.0); sp = fma(sp, r2, -1.0 / 120.0); sp = fma(sp, r2, 1.0 / 6.0);
  sp = r - r * r2 * sp;
  double cp = 1.0 / 20922789888000.0;
  cp = fma(cp, r2, -1.0 / 87178291200.0); cp = fma(cp, r2, 1.0 / 479001600.0); cp = fma(cp, r2, -1.0 / 3628800.0);
  cp = fma(cp, r2, 1.0 / 40320.0); cp = fma(cp, r2, -1.0 / 720.0); cp = fma(cp, r2, 1.0 / 24.0); cp = fma(cp, r2, -0.5);
  cp = fma(cp, r2, 1.0);
  sn = (q == 0) ? sp : (q == 1) ? cp : (q == 2) ? -sp : -cp;
  cs = (q == 0) ? cp : (q == 1) ? -sp : (q == 2) ? -cp : sp;
}

__device__ void s5prep_unit(LAS unsigned char* lds, const Params& p, int l, int g) {
  LAS float* cf = (LAS float*)lds;
  const int tid = otid();
  const int lg = l * 64 + g;
  if (tid < 64) {
    const double dt = exp_d((double)p.log_dt[lg]);
    const double lr = (double)p.lam_re[lg * 64 + tid], li = (double)p.lam_im[lg * 64 + tid];
    const double e = exp_d(lr * dt);
    double sn, cs; sincos_d(li * dt, sn, cs);
    const double lbr = e * cs, lbi = e * sn;
    const double nr = lbr - 1.0, ni = lbi;
    const double den = lr * lr + li * li;
    const double cr = (nr * lr + ni * li) / den, ci = (ni * lr - nr * li) / den;
    p.lamb[(size_t)(lg * 64 + tid) * 2 + 0] = (float)lbr;
    p.lamb[(size_t)(lg * 64 + tid) * 2 + 1] = (float)lbi;
    cf[tid * 2 + 0] = (float)cr; cf[tid * 2 + 1] = (float)ci;
  }
  __syncthreads();
#pragma unroll
  for (int i = 0; i < 4; ++i) {
    const int idx = tid * 4 + i;
    {
      const int pp = idx >> 4, c = idx & 15, st = pp & 63;
      const float br = p.b_re[((size_t)lg * 64 + st) * 16 + c], bi = p.b_im[((size_t)lg * 64 + st) * 16 + c];
      const float cr = cf[st * 2], ci = cf[st * 2 + 1];
      const float v = (pp < 64) ? (cr * br - ci * bi) : (cr * bi + ci * br);
      p.BbT[(size_t)lg * 2048 + idx] = (bf16_t)(pk2(v, v) & 0xffffu);
    }
    {
      const int c = idx >> 7, pp = idx & 127, st = pp & 63;
      const float v = (pp < 64) ? p.c_re[((size_t)lg * 16 + c) * 64 + st] : -p.c_im[((size_t)lg * 16 + c) * 64 + st];
      p.CmT[(size_t)lg * 2048 + idx] = (bf16_t)(pk2(v, v) & 0xffffu);
    }
  }
  __syncthreads();
}

__device__ void phase_prep(LAS unsigned char* lds, const Params& p) {
  constexpr int U_X = 2080, U_WIN = 5376, U_WGLU = 1024, U_WOUT = 2048, U_S5 = 256;
  constexpr int TOTAL = U_X + U_WIN + U_WGLU + U_WOUT + U_S5;
  for (int u = blockIdx.x; u < TOTAL; u += gridDim.x) {
    int idx = u;
    if (idx < U_X) { xrow_unit(p, idx); continue; }
    idx -= U_X;
    if (idx < U_WIN) {
      const int l = idx / 1344, r = idx % 1344, ntile = r / 16, kt = r % 16;
      transpose_unit(lds, p.w_in + (size_t)l * 1024 * 5136, 5136, p.norm_g + l * 1024, 1024,
                     p.WinT + (size_t)l * 5376 * 1024, 1024, kt, ntile, 0);
      continue;
    }
    idx -= U_WIN;
    if (idx < U_WGLU) {
      const int l = idx / 256, r = idx % 256, ntile = r / 16, kt = r % 16;
      transpose_unit(lds, p.w_glu + (size_t)l * 1024 * 1024, 1024, nullptr, 0, p.WgluT + (size_t)l * 1024 * 1024, 1024, kt, ntile, 1);
      continue;
    }
    idx -= U_WGLU;
    if (idx < U_WOUT) {
      const int l = idx / 512, r = idx % 512, ntile = r / 32, kt = r % 32;
      transpose_unit(lds, p.w_out + (size_t)l * 2048 * 1024, 1024, p.ssd_norm_g + l * 1024, 1024,
                     p.WoutT + (size_t)l * 1024 * 2048, 2048, kt, ntile, 2);
      continue;
    }
    idx -= U_WOUT;
    s5prep_unit(lds, p, idx / 64, idx % 64);
  }
}

constexpr int CM_OFF = 0, BM_OFF = 17408, BMT_OFF = 34816, XDT_OFF = 53248, XW_OFF = 62464, MM_OFF = 71680,
              HB_OFF = 80896, XS_OFF = 98304, ACS_OFF = 107520, DTV_OFF = 115712, SSQ_OFF = 123904, CW_OFF = 124416;

__device__ __forceinline__ bf16x8 ldfrag(LAS unsigned char* lds, int off, int row, int stride, int col) {
  return *(const LAS bf16x8*)(lds + off + (row * stride + col) * 2);
}

template <int NCH>
__device__ __forceinline__ void conv_load_rows(unsigned (&rows)[7][NCH / 2], const bf16_t* proj, const float* stc, int tok0, int c, int s0, int ccol) {
#pragma unroll
  for (int i = 0; i < 7; ++i) {
    const int pos = c * 64 + s0 - 3 + i;
    if (pos >= 0) {
      const bf16_t* q = proj + (size_t)(tok0 + pos) * LDP + C_XBC + ccol;
      if (NCH == 8) { const u32x4 v = *(const u32x4*)q; rows[i][0] = v[0]; rows[i][1] = v[1]; rows[i][NCH / 2 - 2] = v[2]; rows[i][NCH / 2 - 1] = v[3]; }
      else rows[i][0] = *(const unsigned*)q;
    } else if (stc) {
      const float* sp = stc + (size_t)(3 + pos) * 2048 + ccol;
#pragma unroll
      for (int k = 0; k < NCH / 2; ++k) rows[i][k] = pk2(sp[2 * k], sp[2 * k + 1]);
    } else {
#pragma unroll
      for (int k = 0; k < NCH / 2; ++k) rows[i][k] = 0u;
    }
  }
}
template <int NCH>
__device__ __forceinline__ void conv_load_rows_fast(unsigned (&rows)[7][NCH / 2], const bf16_t* proj, int tok0, int c, int s0, int ccol) {
  const bf16_t* q0 = proj + (size_t)(tok0 + c * 64 + s0 - 3) * LDP + C_XBC + ccol;
#pragma unroll
  for (int i = 0; i < 7; ++i) {
    const bf16_t* q = q0 + (size_t)i * LDP;
    if (NCH == 8) { const u32x4 v = *(const u32x4*)q; rows[i][0] = v[0]; rows[i][1] = v[1]; rows[i][NCH / 2 - 2] = v[2]; rows[i][NCH / 2 - 1] = v[3]; }
    else rows[i][0] = *(const unsigned*)q;
  }
}
template <int NCH>
__device__ __forceinline__ void conv_store_row(LAS unsigned char* addr, const float* o) {
  if (NCH == 8) *(LAS u32x4*)addr = (u32x4){pk2(o[0], o[1]), pk2(o[2], o[3]), pk2(o[NCH - 4], o[NCH - 3]), pk2(o[NCH - 2], o[NCH - 1])};
  else *(LAS unsigned*)addr = pk2(o[0], o[1]);
}
template <int NCH>
__device__ __forceinline__ void conv_unit(LAS unsigned char* lds, const unsigned (&rows)[7][NCH / 2], const LAS float* wl,
                                          int oct, int chq, int s0, const LAS float* acs, const LAS float* dtv) {
  float o[4][NCH];
  float w[4][NCH], bs[NCH];
#pragma unroll
  for (int e = 0; e < NCH; ++e) { bs[e] = wl[32 + e];
#pragma unroll
    for (int k = 0; k < 4; ++k) w[k][e] = wl[k * 8 + e]; }
#pragma unroll
  for (int e = 0; e < NCH; ++e) {
    float xv[7];
#pragma unroll
    for (int i = 0; i < 7; ++i) xv[i] = (e & 1) ? hi_f(rows[i][e >> 1]) : lo_f(rows[i][e >> 1]);
#pragma unroll
    for (int j = 0; j < 4; ++j) o[j][e] = siluf(bs[e] + w[0][e] * xv[j] + w[1][e] * xv[j + 1] + w[2][e] * xv[j + 2] + w[3][e] * xv[j + 3]);
  }
  if (oct < 8) {
    float dts[4], wsc[4];
    const float aend = acs[63];
#pragma unroll
    for (int j = 0; j < 4; ++j) { dts[j] = dtv[s0 + j]; wsc[j] = dts[j] * __expf(aend - acs[s0 + j]); }
    const int p0 = oct * 8 + chq;
#pragma unroll
    for (int j = 0; j < 4; ++j) conv_store_row<NCH>(lds + XS_OFF + ((s0 + j) * 72 + p0) * 2, o[j]);
#pragma unroll
    for (int e = 0; e < NCH; ++e) {
      *(LAS u32x2*)(lds + XDT_OFF + ((p0 + e) * 72 + s0) * 2) = (u32x2){pk2(o[0][e] * dts[0], o[1][e] * dts[1]), pk2(o[2][e] * dts[2], o[3][e] * dts[3])};
      *(LAS u32x2*)(lds + XW_OFF + ((p0 + e) * 72 + s0) * 2) = (u32x2){pk2(o[0][e] * wsc[0], o[1][e] * wsc[1]), pk2(o[2][e] * wsc[2], o[3][e] * wsc[3])};
    }
  } else if (oct < 24) {
    const int n0 = (oct - 8) * 8 + chq;
#pragma unroll
    for (int j = 0; j < 4; ++j) conv_store_row<NCH>(lds + BM_OFF + ((s0 + j) * 136 + n0) * 2, o[j]);
#pragma unroll
    for (int e = 0; e < NCH; ++e) *(LAS u32x2*)(lds + BMT_OFF + ((n0 + e) * 72 + s0) * 2) = (u32x2){pk2(o[0][e], o[1][e]), pk2(o[2][e], o[3][e])};
  } else {
    const int n0 = (oct - 24) * 8 + chq;
#pragma unroll
    for (int j = 0; j < 4; ++j) conv_store_row<NCH>(lds + CM_OFF + ((s0 + j) * 136 + n0) * 2, o[j]);
  }
}

__device__ void ssd_item(LAS unsigned char* lds, const Params& p, int l, int b, int h, bool smp) {
  const int tid = otid(), wid = tid >> 6, lane = tid & 63, fr = lane & 15, fq = lane >> 4;
  const int g = h >> 2;
  const int tok0 = smp ? (TP + b * 64) : (b * 2048);
  const int nchunk = smp ? 1 : 32;
  const int NB = smp ? 8 : 16;
  bf16_t* proj = p.proj;
  LAS float* acs_all = (LAS float*)(lds + ACS_OFF);
  LAS float* dtv_all = (LAS float*)(lds + DTV_OFF);
  LAS float* ssq = (LAS float*)(lds + SSQ_OFF);
  const float dtb = p.dt_bias[l * 16 + h];
  const float Aneg = -__expf(p.a_log[l * 16 + h]);
  const float Dh = p.d_ssd[l * 16 + h];

  f32x4 hacc[4];
#pragma unroll
  for (int pt = 0; pt < 4; ++pt) {
    if (smp) hacc[pt] = *(const f32x4*)(p.st_ssd + ((((size_t)l * 8 + b) * 16 + h) * 64 + pt * 16 + fr) * 128 + wid * 16 + fq * 4);
    else hacc[pt] = (f32x4){0.f, 0.f, 0.f, 0.f};
  }

  const float* stc = smp ? (p.st_conv + ((size_t)l * 8 + b) * 3 * 2048) : nullptr;
  int octA, s0A;
  if (tid < 128) { octA = tid & 7; s0A = (tid >> 3) * 4; }
  else if (tid < 384) { const int i = tid - 128; octA = 8 + (i & 15); s0A = (i >> 4) * 4; }
  else { const int i = tid - 384; octA = 24 + (i & 15); s0A = (i >> 4) * 4; }
  const int jB = tid >> 2, octB = 24 + (jB & 15), s0B = (8 + (jB >> 4)) * 4, chqB = (tid & 3) * 2;
  const int cchA = (octA < 8) ? (h * 64 + octA * 8) : (octA < 24) ? (1024 + g * 128 + (octA - 8) * 8) : (1536 + g * 128 + (octA - 24) * 8);
  const int cchB = ((octB < 8) ? (h * 64 + octB * 8) : (octB < 24) ? (1024 + g * 128 + (octB - 8) * 8) : (1536 + g * 128 + (octB - 24) * 8)) + chqB;
  LAS float* cwl = (LAS float*)(lds + CW_OFF);
  {
    const float* cw = p.conv_w + (size_t)l * 4 * 2048;
    const float* cb = p.conv_b + (size_t)l * 2048;
    for (int idx = tid; idx < 1600; idx += 512) {
      const int oc = idx / 40, r = idx % 40, k = r >> 3, e = r & 7;
      const int cc = ((oc < 8) ? (h * 64 + oc * 8) : (oc < 24) ? (1024 + g * 128 + (oc - 8) * 8) : (1536 + g * 128 + (oc - 24) * 8)) + e;
      cwl[idx] = (k < 4) ? cw[k * 2048 + cc] : cb[cc];
    }
  }
  unsigned rowsA[7][4], rowsB[7][1];
  conv_load_rows<8>(rowsA, proj, stc, tok0, 0, s0A, cchA);
  conv_load_rows<2>(rowsB, proj, stc, tok0, 0, s0B, cchB);
  for (int c = wid; c < nchunk; c += 8) {
    const float dtr = bf2f(proj[(size_t)(tok0 + c * 64 + lane) * LDP + C_DT + h]);
    const float xx = dtr + dtb;
    const float dt = xx > 20.f ? xx : log1pf(__expf(xx));
    float cs = dt * Aneg;
#pragma unroll
    for (int o = 1; o < 64; o <<= 1) { const float v = __shfl_up(cs, o); if (lane >= o) cs += v; }
    acs_all[c * 64 + lane] = cs; dtv_all[c * 64 + lane] = dt;
  }
  LDS_BARRIER();
  for (int c = 0; c < nchunk; ++c) {
    const int ctok = tok0 + c * 64;
    const LAS float* acs = acs_all + c * 64;
    const LAS float* dtv = dtv_all + c * 64;
    u32x2 z4v[2];
    {
      const int lt_ = wid >> 1, ptb_ = (wid & 1) * 2;
#pragma unroll
      for (int q = 0; q < 2; ++q) z4v[q] = *(const u32x2*)(proj + (size_t)(ctok + lt_ * 16 + fr) * LDP + C_ZA + h * 64 + (ptb_ + q) * 16 + fq * 4);
    }
    conv_unit<8>(lds, rowsA, cwl + octA * 40, octA, 0, s0A, acs, dtv);
    conv_unit<2>(lds, rowsB, cwl + octB * 40 + chqB, octB, chqB, s0B, acs, dtv);
    if (c + 1 < nchunk) {
      conv_load_rows_fast<8>(rowsA, proj, tok0, c + 1, s0A, cchA);
      conv_load_rows_fast<2>(rowsB, proj, tok0, c + 1, s0B, cchB);
    }
#pragma unroll
    for (int pt = 0; pt < 4; ++pt)
      *(LAS u32x2*)(lds + HB_OFF + ((pt * 16 + fr) * 136 + wid * 16 + fq * 4) * 2) =
          (u32x2){pk2(hacc[pt][0], hacc[pt][1]), pk2(hacc[pt][2], hacc[pt][3])};
    LDS_BARRIER();
    const int lt = wid >> 1, ptb = (wid & 1) * 2;
    {
      const int st = wid >> 1, ltb = (wid & 1) * 2;
      bf16x8 bfr[4];
#pragma unroll
      for (int ks = 0; ks < 4; ++ks) bfr[ks] = ldfrag(lds, BM_OFF, st * 16 + fr, 136, ks * 32 + fq * 8);
#pragma unroll
      for (int q = 0; q < 2; ++q) {
        const int ltq = ltb + q;
        f32x4 a = (f32x4){0.f, 0.f, 0.f, 0.f};
#pragma unroll
        for (int ks = 0; ks < 4; ++ks) a = mfma16(bfr[ks], ldfrag(lds, CM_OFF, ltq * 16 + fr, 136, ks * 32 + fq * 8), a);
        const int l_ = ltq * 16 + fr;
        const float al = acs[l_];
        float mv[4];
#pragma unroll
        for (int r = 0; r < 4; ++r) { const int s_ = st * 16 + fq * 4 + r; const float ex = __expf(al - acs[s_]); mv[r] = (s_ <= l_) ? a[r] * ex : 0.f; }
        *(LAS u32x2*)(lds + MM_OFF + (l_ * 72 + st * 16 + fq * 4) * 2) = (u32x2){pk2(mv[0], mv[1]), pk2(mv[2], mv[3])};
      }
    }
    f32x4 accI[2];
    accI[0] = (f32x4){0.f, 0.f, 0.f, 0.f}; accI[1] = accI[0];
#pragma unroll
    for (int ks = 0; ks < 4; ++ks) {
      const bf16x8 cfr = ldfrag(lds, CM_OFF, lt * 16 + fr, 136, ks * 32 + fq * 8);
#pragma unroll
      for (int q = 0; q < 2; ++q) accI[q] = mfma16(ldfrag(lds, HB_OFF, (ptb + q) * 16 + fr, 136, ks * 32 + fq * 8), cfr, accI[q]);
    }
    {
      const float dec = __expf(acs[63]);
      bf16x8 bt[2];
#pragma unroll
      for (int ks = 0; ks < 2; ++ks) bt[ks] = ldfrag(lds, BMT_OFF, wid * 16 + fr, 72, ks * 32 + fq * 8);
#pragma unroll
      for (int pt = 0; pt < 4; ++pt) {
        hacc[pt] = hacc[pt] * dec;
#pragma unroll
        for (int ks = 0; ks < 2; ++ks) hacc[pt] = mfma16(bt[ks], ldfrag(lds, XW_OFF, pt * 16 + fr, 72, ks * 32 + fq * 8), hacc[pt]);
      }
    }
    LDS_BARRIER();
    {
      f32x4 accY[2];
      accY[0] = (f32x4){0.f, 0.f, 0.f, 0.f}; accY[1] = accY[0];
#pragma unroll
      for (int ks = 0; ks < 2; ++ks) {
        const bf16x8 mf = ldfrag(lds, MM_OFF, lt * 16 + fr, 72, ks * 32 + fq * 8);
#pragma unroll
        for (int q = 0; q < 2; ++q) accY[q] = mfma16(ldfrag(lds, XDT_OFF, (ptb + q) * 16 + fr, 72, ks * 32 + fq * 8), mf, accY[q]);
      }
      const int l_ = lt * 16 + fr;
      const float el = __expf(acs[l_]);
      float sq = 0.f;
#pragma unroll
      for (int q = 0; q < 2; ++q) {
        const int p0 = (ptb + q) * 16 + fq * 4;
        const u32x2 xs4 = *(const LAS u32x2*)(lds + XS_OFF + (l_ * 72 + p0) * 2);
        bf16_t* zp = proj + (size_t)(ctok + l_) * LDP + C_ZA + h * 64 + p0;
        const u32x2 z4 = z4v[q];
        const float y0 = (accY[q][0] + el * accI[q][0] + Dh * lo_f(xs4.x)) * siluf(lo_f(z4.x));
        const float y1 = (accY[q][1] + el * accI[q][1] + Dh * hi_f(xs4.x)) * siluf(hi_f(z4.x));
        const float y2 = (accY[q][2] + el * accI[q][2] + Dh * lo_f(xs4.y)) * siluf(lo_f(z4.y));
        const float y3 = (accY[q][3] + el * accI[q][3] + Dh * hi_f(xs4.y)) * siluf(hi_f(z4.y));
        sq += y0 * y0 + y1 * y1 + y2 * y2 + y3 * y3;
        *(u32x2*)zp = (u32x2){pk2(y0, y1), pk2(y2, y3)};
      }
      sq += __shfl_xor(sq, 16); sq += __shfl_xor(sq, 32);
      if (fq == 0) ssq[(wid & 1) * 64 + l_] = sq;
    }
    LDS_BARRIER();
    if (tid < 64) p.ssqa[(size_t)(ctok + tid) * 16 + h] = ssq[tid] + ssq[64 + tid];
  }
  {
    float* so = p.out + (smp ? O_SSDS : O_SSDP);
#pragma unroll
    for (int pt = 0; pt < 4; ++pt)
      *(f32x4*)(so + ((((size_t)l * NB + b) * 16 + h) * 64 + pt * 16 + fr) * 128 + wid * 16 + fq * 4) = hacc[pt];
    float* co = p.out + (smp ? O_CONVS : O_CONVP);
    const int L = smp ? 64 : 2048;
    for (int i = tid; i < 3 * 320; i += 512) {
      const int r = i / 320, cc = i % 320;
      if (cc >= 64 && (h & 3)) continue;
      const int ch = (cc < 64) ? (h * 64 + cc) : (cc < 192) ? (1024 + g * 128 + (cc - 64)) : (1536 + g * 128 + (cc - 192));
      co[(((size_t)l * NB + b) * 3 + r) * 2048 + ch] = bf2f(proj[(size_t)(tok0 + L - 3 + r) * LDP + C_XBC + ch]);
    }
  }
  __syncthreads();
}

__device__ __forceinline__ float fma_asm(float a, float b, float c) { float d; asm volatile("v_fma_f32 %0, %1, %2, %3" : "=v"(d) : "v"(a), "v"(b), "v"(c)); return d; }
__device__ void s5_seq(LAS unsigned char* lds, const Params& p, int l, int b, int g, bool smp) {
  const int tid_ = otid(); const int wid = tid_ >> 6, lane = tid_ & 63, fr = lane & 15, fq = lane >> 4;
  const int pi = wid & 3, role = wid >> 2;
  LAS float* hbuf = (LAS float*)(lds + pi * 33792);
  const int tok0 = smp ? (TP + b * 64) : (b * 2048);
  const int nblk = smp ? 2 : 64;
  const int NB = smp ? 8 : 16;
  const int lg = l * 64 + g;
  const bf16_t* ubase = p.proj + C_U + g * 16;
  if (role == 0) {
    __builtin_amdgcn_s_setprio(3);
    bf16x8 Bfrag[4];
#pragma unroll
    for (int nt = 0; nt < 4; ++nt) Bfrag[nt] = *(const bf16x8*)(p.BbT + ((size_t)lg * 128 + nt * 32 + (lane & 31)) * 16 + 8 * (lane >> 5));
    const float lr = p.lamb[(size_t)(lg * 64 + lane) * 2], li = p.lamb[(size_t)(lg * 64 + lane) * 2 + 1];
    const float nli = -li;
    float hr = 0.f, hi = 0.f;
    if (smp) { hr = p.st_s5re[(((size_t)l * 8 + b) * 64 + g) * 64 + lane]; hi = p.st_s5im[(((size_t)l * 8 + b) * 64 + g) * 64 + lane]; }
    bf16x8 a_next = *(const bf16x8*)(ubase + (size_t)(tok0 + (lane & 31)) * LDP + 8 * (lane >> 5));
    for (int blk = 0; blk <= nblk; ++blk) {
      if (blk < nblk) {
        LAS float* buf = hbuf + (blk & 1) * 4224;
        const bf16x8 a = a_next;
        if (blk + 1 < nblk) a_next = *(const bf16x8*)(ubase + (size_t)(tok0 + (blk + 1) * 32 + (lane & 31)) * LDP + 8 * (lane >> 5));
        float bre[32], bim[32];
        {
          f32x16 d[4];
#pragma unroll
          for (int nt = 0; nt < 4; ++nt) {
            f32x16 z = {0.f, 0.f, 0.f, 0.f, 0.f, 0.f, 0.f, 0.f, 0.f, 0.f, 0.f, 0.f, 0.f, 0.f, 0.f, 0.f};
            d[nt] = __builtin_amdgcn_mfma_f32_32x32x16_bf16(a, Bfrag[nt], z, 0, 0, 0);
          }
#pragma unroll
          for (int r = 0; r < 16; ++r) {
            const int tA = (r & 3) + 8 * (r >> 2);
            const auto sr = __builtin_amdgcn_permlane32_swap(__float_as_uint(d[0][r]), __float_as_uint(d[1][r]), false, false);
            bre[tA] = __uint_as_float(sr[0]); bre[tA + 4] = __uint_as_float(sr[1]);
            const auto si = __builtin_amdgcn_permlane32_swap(__float_as_uint(d[2][r]), __float_as_uint(d[3][r]), false, false);
            bim[tA] = __uint_as_float(si[0]); bim[tA + 4] = __uint_as_float(si[1]);
          }
        }
#pragma unroll
        for (int t = 0; t < 32; ++t) {
          float nr = fma_asm(lr, hr, bre[t]); nr = fma_asm(nli, hi, nr);
          float ni = fma_asm(lr, hi, bim[t]); ni = fma_asm(li, hr, ni);
          hr = nr; hi = ni;
          buf[t * 132 + lane] = hr; buf[t * 132 + 64 + lane] = hi;
        }
      }
      LDS_BARRIER();
    }
    p.out[(smp ? O_S5RES : O_S5REP) + (((size_t)l * NB + b) * 64 + g) * 64 + lane] = hr;
    p.out[(smp ? O_S5IMS : O_S5IMP) + (((size_t)l * NB + b) * 64 + g) * 64 + lane] = hi;
    __builtin_amdgcn_s_setprio(0);
  } else {
    bf16x8 Cfrag[4];
#pragma unroll
    for (int ks = 0; ks < 4; ++ks) Cfrag[ks] = *(const bf16x8*)(p.CmT + ((size_t)lg * 16 + fr) * 128 + ks * 32 + fq * 8);
    const f32x4 d4 = *(const f32x4*)(p.d_s5 + l * 1024 + g * 16 + fq * 4);
    for (int blk = 0; blk <= nblk; ++blk) {
      if (blk >= 1) {
        const int pb = blk - 1;
        const LAS float* buf = hbuf + (pb & 1) * 4224;
        u32x2 u4v[2];
#pragma unroll
        for (int mt = 0; mt < 2; ++mt) u4v[mt] = *(const u32x2*)(ubase + (size_t)(tok0 + pb * 32 + mt * 16 + fr) * LDP + fq * 4);
#pragma unroll
        for (int mt = 0; mt < 2; ++mt) {
          f32x4 acc = (f32x4){0.f, 0.f, 0.f, 0.f};
#pragma unroll
          for (int ks = 0; ks < 4; ++ks) {
            const LAS float* hp = buf + (mt * 16 + fr) * 132 + ks * 32 + fq * 8;
            const f32x4 h0 = *(const LAS f32x4*)hp, h1 = *(const LAS f32x4*)(hp + 4);
            u32x4 hw = (u32x4){pk2(h0[0], h0[1]), pk2(h0[2], h0[3]), pk2(h1[0], h1[1]), pk2(h1[2], h1[3])};
            bf16x8 hf = __builtin_bit_cast(bf16x8, hw);
            acc = mfma16(Cfrag[ks], hf, acc);
          }
          const size_t trow = (size_t)(tok0 + pb * 32 + mt * 16 + fr);
          const u32x2 u4 = u4v[mt];
          const float y0 = gelu_tanh(acc[0] + d4[0] * lo_f(u4.x));
          const float y1 = gelu_tanh(acc[1] + d4[1] * hi_f(u4.x));
          const float y2 = gelu_tanh(acc[2] + d4[2] * lo_f(u4.y));
          const float y3 = gelu_tanh(acc[3] + d4[3] * hi_f(u4.y));
          *(u32x2*)(p.xb + trow * 1024 + g * 16 + fq * 4) = (u32x2){pk2(y0, y1), pk2(y2, y3)};
        }
      }
      LDS_BARRIER();
    }
  }
}

__device__ void phase_mixer(LAS unsigned char* lds, const Params& p, int l) {
  const int wid = otid() >> 6;
  for (int u = blockIdx.x; u < 768; u += gridDim.x) {
    if (u < 256) {
      const int x = u & 7, j = u >> 3, G = x * 8 + (j >> 2);
      ssd_item(lds, p, l, G >> 2, (G & 3) * 4 + (j & 3), false);
    }
    else if (u < 512) { const int seq = (u - 256) * 4 + (wid & 3); s5_seq(lds, p, l, seq >> 6, seq & 63, false); }
    else if (u < 640) {
      const int v = u - 512, x = v & 7, j = v >> 3, G = x * 4 + (j >> 2);
      ssd_item(lds, p, l, G >> 2, (G & 3) * 4 + (j & 3), true);
    }
    else { const int seq = (u - 640) * 4 + (wid & 3); s5_seq(lds, p, l, seq >> 6, seq & 63, true); }
    __syncthreads();
  }
}

__device__ void norm_unit(const Params& p, int nu) {
  const int tid = otid();
  const int tok = nu * 32 + (tid >> 4), hh = tid & 15, gg = hh >> 2;
  const f32x4 s4 = *(const f32x4*)(p.ssqa + (size_t)tok * 16 + gg * 4);
  const float rs = rsqrtf((s4[0] + s4[1] + s4[2] + s4[3]) * (1.f / 256.f) + 1e-6f);
  bf16_t* q = p.proj + (size_t)tok * LDP + C_ZA + hh * 64;
#pragma unroll
  for (int i = 0; i < 8; ++i) {
    u32x4 v = *(u32x4*)(q + i * 8);
#pragma unroll
    for (int k = 0; k < 4; ++k) v[k] = pk2(lo_f(v[k]) * rs, hi_f(v[k]) * rs);
    *(u32x4*)(q + i * 8) = v;
  }
}

__device__ void final_unit(const Params& p, int unit) {
  const int tid_ = otid(); const int wid = tid_ >> 6, lane = tid_ & 63;
  const int row = unit * 8 + wid;
  const f32x4* sp = (const f32x4*)(p.sumsq + ((size_t)4 * T_TOK + row) * 16);
  const f32x4 s0 = sp[0], s1 = sp[1], s2 = sp[2], s3 = sp[3];
  const float ss = ((s0[0] + s0[1]) + (s0[2] + s0[3])) + ((s1[0] + s1[1]) + (s1[2] + s1[3])) +
                   ((s2[0] + s2[1]) + (s2[2] + s2[3])) + ((s3[0] + s3[1]) + (s3[2] + s3[3]));
  const float rs = rsqrtf(ss * (1.f / 1024.f) + 1e-6f);
  float* xr = p.out + (size_t)row * 1024;
#pragma unroll
  for (int i = 0; i < 4; ++i) {
    const int c = i * 256 + lane * 4;
    const f32x4 v = *(const f32x4*)(xr + c);
    const f32x4 gv = *(const f32x4*)(p.final_g + c);
    *(f32x4*)(xr + c) = v * rs * gv;
  }
}

__device__ __forceinline__ void grid_barrier(cg::grid_group& grid, unsigned* ctr, unsigned target) {
  asm volatile("s_waitcnt vmcnt(0) lgkmcnt(0)" ::: "memory");
  __syncthreads();
  if (target == gridDim.x) grid.sync();
  if (threadIdx.x == 0) {
    __builtin_amdgcn_fence(__ATOMIC_RELEASE, "agent");
    asm volatile("s_waitcnt vmcnt(0)" ::: "memory");
    __hip_atomic_fetch_add(ctr, 1u, __ATOMIC_RELAXED, __HIP_MEMORY_SCOPE_AGENT);
    while (__hip_atomic_load(ctr, __ATOMIC_RELAXED, __HIP_MEMORY_SCOPE_AGENT) < target) __builtin_amdgcn_s_sleep(1);
    __builtin_amdgcn_fence(__ATOMIC_ACQUIRE, "agent");
    asm volatile("s_waitcnt vmcnt(0)" ::: "memory");
  }
  __syncthreads();
}

__global__ void __launch_bounds__(NTHREADS) mega(Params p) {
  __shared__ __attribute__((aligned(1024))) unsigned char shm[LDS_BYTES];
  LAS unsigned char* lds = (LAS unsigned char*)shm;
  cg::grid_group grid = cg::this_grid();
  unsigned nbar = 0;
  phase_prep(lds, p);
  grid_barrier(grid, p.bar, (++nbar) * gridDim.x);
  for (int ph = 1; ph < p.phase_end; ++ph) {
    if (ph == 17) {
      for (int u = blockIdx.x; u < 4160; u += gridDim.x) final_unit(p, u);
    } else {
      const int l = (ph - 1) >> 2, sub = (ph - 1) & 3;
      if (sub == 0) {
        g8::EpiIn8 e{p.proj, p.sumsq + (size_t)l * T_TOK * 16};
        g8::Order S{NMT * 21, 21, 0, 0};
        g8::gemm_phase8(lds, p.xb, 1024, 1 << 30, 0, p.WinT + (size_t)l * 5376 * 1024, 1024, 1024, S, e);
      } else if (sub == 1) {
        phase_mixer(lds, p, l);
      } else if (sub == 2) {
        g8::EpiGlu8 e{p.proj, p.b_glu + l * 1024, p.xb};
        g8::Order S{NMT * 4, 4, 0, 0};
        g8::gemm_phase8(lds, p.xb, 1024, 1 << 30, 0, p.WgluT + (size_t)l * 1024 * 1024, 1024, 1024, S, e);
        for (int u = gridDim.x - 1 - blockIdx.x; u < 1040; u += gridDim.x) norm_unit(p, u);
      } else {
        g8::EpiOut8 e{l == 0 ? p.x_prompt : p.out, l == 0 ? p.x_sample : (p.out + (size_t)TP * 1024), p.out,
                      l == 3 ? (bf16_t*)nullptr : p.xb, p.sumsq + (size_t)(l + 1) * T_TOK * 16};
        g8::Order S{512, 4, 0, 0};
        g8::gemm_phase8(lds, p.proj, LDP, 16, 3072, p.WoutT + (size_t)l * 1024 * 2048, 2048, 2048, S, e);
#pragma unroll 1
        for (int q = 0; q < 4; ++q) {
          const int kt0 = q * 8;
          g8::Order Sq{0, 4, 1, q};
          g8::EpiPart8 ep{p.part + (size_t)q * 512 * 1024};
          g8::gemm_phase8(lds, p.proj + kt0 * 64 + (kt0 >= 16 ? 3072 : 0), LDP, 1 << 30, 0, p.WoutT + (size_t)l * 1024 * 2048 + kt0 * 64, 2048, 512, Sq, ep);
        }
        grid_barrier(grid, p.bar, (++nbar) * gridDim.x);
        {
          const int tid_ = otid(); const int wid = tid_ >> 6, lane = tid_ & 63;
          for (int r = blockIdx.x * 8 + wid; r < 512; r += gridDim.x * 8) {
            const int row = TP + r;
            const float* xr = (l == 0) ? (p.x_sample + (size_t)r * 1024) : (p.out + (size_t)row * 1024);
            float ssum = 0.f;
#pragma unroll
            for (int i = 0; i < 4; ++i) {
              const int c = i * 256 + lane * 4;
              f32x4 v = *(const f32x4*)(xr + c);
#pragma unroll
              for (int q = 0; q < 4; ++q) v += *(const f32x4*)(p.part + ((size_t)q * 512 + r) * 1024 + c);
              *(f32x4*)(p.out + (size_t)row * 1024 + c) = v;
              if (l < 3) { u32x2 o; o.x = pk2(v[0], v[1]); o.y = pk2(v[2], v[3]); *(u32x2*)(p.xb + (size_t)row * 1024 + c) = o; }
              ssum += v[0] * v[0] + v[1] * v[1] + v[2] * v[2] + v[3] * v[3];
            }
#pragma unroll
            for (int o = 32; o >= 1; o >>= 1) ssum += __shfl_xor(ssum, o);
            if (lane < 16) p.sumsq[((size_t)(l + 1) * T_TOK + row) * 16 + lane] = (lane == 0) ? ssum : 0.f;
          }
        }
      }
    }
    if (ph + 1 < p.phase_end) grid_barrier(grid, p.bar, (++nbar) * gridDim.x);
  }
}

extern "C" void kernel_launch(void* const* d_in, const int* in_sizes, int n_in, void* d_out, int out_size, void* d_ws, size_t ws_size,
                              hipStream_t stream) {
  static int grid_blocks = 0;
  if (!grid_blocks) {
    int dev = 0, cus = 0, per_cu = 0;
    hipGetDevice(&dev);
    hipDeviceGetAttribute(&cus, hipDeviceAttributeMultiprocessorCount, dev);
    hipOccupancyMaxActiveBlocksPerMultiprocessor(&per_cu, mega, NTHREADS, 0);
    if (per_cu < 1) per_cu = 1;
    if (per_cu > 1) per_cu = 1;
    grid_blocks = cus * per_cu;
  }
  Params p{};
  const float* const* in = (const float* const*)d_in;
  p.x_prompt = in[0]; p.x_sample = in[1]; p.st_conv = in[2]; p.st_ssd = in[3]; p.st_s5re = in[4]; p.st_s5im = in[5];
  p.norm_g = in[6]; p.w_in = in[7]; p.conv_w = in[8]; p.conv_b = in[9]; p.dt_bias = in[10]; p.a_log = in[11]; p.d_ssd = in[12];
  p.ssd_norm_g = in[13]; p.lam_re = in[14]; p.lam_im = in[15]; p.log_dt = in[16]; p.b_re = in[17]; p.b_im = in[18];
  p.c_re = in[19]; p.c_im = in[20]; p.d_s5 = in[21]; p.w_glu = in[22]; p.b_glu = in[23]; p.w_out = in[24]; p.final_g = in[25];
  p.out = (float*)d_out;
  unsigned char* ws = (unsigned char*)d_ws;
  size_t off = 0;
  auto take = [&](size_t bytes) { unsigned char* r = ws + off; off += (bytes + 1023) & ~(size_t)1023; return r; };
  p.xb = (bf16_t*)take((size_t)T_TOK * 1024 * 2);
  p.proj = (bf16_t*)take((size_t)T_TOK * LDP * 2);
  p.WinT = (bf16_t*)take((size_t)4 * 5376 * 1024 * 2);
  p.WgluT = (bf16_t*)take((size_t)4 * 1024 * 1024 * 2);
  p.WoutT = (bf16_t*)take((size_t)4 * 1024 * 2048 * 2);
  p.BbT = (bf16_t*)take((size_t)256 * 2048 * 2);
  p.CmT = (bf16_t*)take((size_t)256 * 2048 * 2);
  p.sumsq = (float*)take((size_t)5 * T_TOK * 16 * 4);
  p.ssqa = (float*)take((size_t)T_TOK * 16 * 4);
  p.lamb = (float*)take((size_t)256 * 64 * 2 * 4);
  p.part = (float*)take((size_t)4 * 512 * 1024 * 4);
  p.bar = (unsigned*)take(1024);
  hipMemsetAsync(p.bar, 0, 1024, stream);
  if (off > ws_size) { fprintf(stderr, "workspace too small: need %zu have %zu\n", off, ws_size); return; }
  p.phase_begin = 0; p.phase_end = 18;
  void* args[] = {&p};
  hipError_t e = hipLaunchCooperativeKernel((void*)mega, dim3(grid_blocks), dim3(NTHREADS), args, 0, stream);
  if (e != hipSuccess) fprintf(stderr, "cooperative launch failed: %s (grid %d)\n", hipGetErrorString(e), grid_blocks);
}
```
